# Optimizing an MI355X kernel written in HIP

```python
import jax, jax.numpy as jnp
from jax import lax
import numpy as np

D_MODEL = 1024
BATCH = 4
SEQ = 4096
DEPTH = 1

GRID_W = 64
CTX_LEN = 256
FF_HALF = 2816
F_GROUPS = 4
F_GROUP_DIM = 128
F_WIDTH = F_GROUPS * F_GROUP_DIM
M_HEADS = 4
M_HEAD_DIM = 256
M_WIDTH = M_HEADS * M_HEAD_DIM
CONV_K = 3
CHUNK = 128
N_ADA = 9
EPS = 1e-6

COL_F = 0
COL_Q = COL_F + F_WIDTH
COL_K = COL_Q + M_WIDTH
COL_V = COL_K + M_WIDTH
COL_O = COL_V + M_WIDTH
COL_GATES = COL_O + M_WIDTH
COL_BR = COL_GATES + 4 * M_HEADS
IN_WIDTH = COL_BR + 2 * D_MODEL

kernel_name = "hybrid_fourier_mlstm_dit_layer"


def rmsnorm(x, g):
    xf = x.astype(jnp.float32)
    y = xf * lax.rsqrt(jnp.mean(xf * xf, axis=-1, keepdims=True) + EPS)
    return (y * g.astype(jnp.float32)).astype(x.dtype)


def modulate(x, shift, scale):
    return x * (1 + scale) + shift


def ada_params(cvec, w, b):
    m = jax.nn.silu(cvec) @ w + b
    return m.reshape(cvec.shape[0], N_ADA, 1, D_MODEL)


def swiglu(u, w13, w2):
    a, b = jnp.split(u @ w13, 2, axis=-1)
    return (jax.nn.silu(a) * b) @ w2


def half_ffn(h, shift, scale, gate, g_pre, g_post, w13, w2):
    u = modulate(rmsnorm(h, g_pre), shift, scale)
    return h + 0.5 * gate * rmsnorm(swiglu(u, w13, w2), g_post)


def dwconv(x, w, b):
    y = lax.conv_general_dilated(
        x, w[:, None, :].astype(x.dtype), window_strides=(1,),
        padding=[(CONV_K // 2, CONV_K // 2)],
        dimension_numbers=("NWC", "WIO", "NWC"),
        feature_group_count=x.shape[-1])
    return y + b


def to_heads(x):
    B, T, _ = x.shape
    return x.reshape(B, T, M_HEADS, M_HEAD_DIM).transpose(0, 2, 1, 3)


def fourier_latent(xf):
    B, T, _ = xf.shape
    rows = T // GRID_W
    z = xf.astype(jnp.float32).reshape(B, rows, GRID_W, F_GROUPS, F_GROUP_DIM)
    y = jnp.fft.fftn(z, axes=(1, 2, 4), norm="ortho").real
    return y.reshape(B, T, F_WIDTH).astype(xf.dtype)


def fourier_context(xf):
    B, T, _ = xf.shape
    z = xf.astype(jnp.float32).reshape(B, T, F_GROUPS, F_GROUP_DIM)
    y = jnp.fft.fftn(z, axes=(1, 3), norm="ortho").real
    return y.reshape(B, T, F_WIDTH).astype(xf.dtype)


def project(u, w_in, b_in, conv_w, conv_b):
    B, T, _ = u.shape
    p = u @ w_in + b_in
    xf = p[..., COL_F:COL_Q]
    qk = jax.nn.silu(dwconv(p[..., COL_Q:COL_V], conv_w, conv_b))
    q = to_heads(qk[..., :M_WIDTH])
    k = to_heads(qk[..., M_WIDTH:])
    v = to_heads(p[..., COL_V:COL_O])
    o = p[..., COL_O:COL_GATES]
    gates = p[..., COL_GATES:COL_BR].astype(jnp.float32)
    gates = gates.reshape(B, T, 4, M_HEADS).transpose(2, 0, 3, 1)
    gate_pre = (gates[0], jax.nn.log_sigmoid(gates[1]), gates[2], jax.nn.log_sigmoid(gates[3]))
    g_f = p[..., COL_BR:COL_BR + D_MODEL]
    g_m = p[..., COL_BR + D_MODEL:]
    return xf, q, k, v, o, gate_pre, g_f, g_m


def mlstm_scan(q, k, v, li, lf, state):
    B, H, T, DK = q.shape
    NC = T // CHUNK

    def chunks(a):
        a = a.astype(jnp.float32).reshape(B, H, NC, CHUNK, *a.shape[3:])
        return jnp.moveaxis(a, 2, 0)

    qc, kc, vc, lic, lfc = map(chunks, (q, k * (DK ** -0.5), v, li, lf))
    lower = jnp.tril(jnp.ones((CHUNK, CHUNK), dtype=bool))

    def step(carry, inp):
        C, n, m = carry
        qx, kx, vx, lix, lfx = inp
        b = jnp.cumsum(lfx, axis=-1)
        dmat = b[..., :, None] - b[..., None, :] + lix[..., None, :]
        dmat = jnp.where(lower, dmat, -jnp.inf)
        inter = b + m[..., None]
        m_t = jnp.maximum(inter, jnp.max(dmat, axis=-1))
        w = jnp.exp(dmat - m_t[..., None])
        a = jnp.exp(inter - m_t)
        s = jnp.einsum("bhtd,bhsd->bhts", qx, kx) * w
        num = a[..., None] * jnp.einsum("bhtd,bhde->bhte", qx, C) + jnp.einsum("bhts,bhse->bhte", s, vx)
        den = a * jnp.einsum("bhtd,bhd->bht", qx, n) + jnp.sum(s, axis=-1)
        h = num / jnp.maximum(jnp.abs(den), jnp.exp(-m_t))[..., None]
        bL = b[..., -1]
        g = bL[..., None] - b + lix
        m_new = jnp.maximum(bL + m, jnp.max(g, axis=-1))
        decay = jnp.exp(bL + m - m_new)
        wk = jnp.exp(g - m_new[..., None])
        C_new = decay[..., None, None] * C + jnp.einsum("bhsd,bhse->bhde", kx * wk[..., None], vx)
        n_new = decay[..., None] * n + jnp.einsum("bhs,bhsd->bhd", wk, kx)
        return (C_new, n_new, m_new), h

    state_out, hs = lax.scan(step, state, (qc, kc, vc, lic, lfc))
    h = jnp.moveaxis(hs, 0, 2).reshape(B, H, T, -1)
    return h.astype(q.dtype), state_out


def bidir_mlstm(q, k, v, gate_pre, state_f, state_b):
    li_f, lf_f, li_b, lf_b = gate_pre
    h_f, s_f = mlstm_scan(q, k, v, li_f, lf_f, state_f)
    flip = lambda a: jnp.flip(a, axis=2)
    h_b, s_b = mlstm_scan(flip(q), flip(k), flip(v), flip(li_b), flip(lf_b), state_b)
    return h_f + flip(h_b), s_f, s_b


def merge(y_fourier, h, o, g_f, g_m, head_g, w_four, w_mproj, w_out):
    B, H, T, dh = h.shape
    hn = rmsnorm(h.transpose(0, 2, 1, 3), head_g.reshape(M_HEADS, M_HEAD_DIM)).reshape(B, T, M_WIDTH)
    hm = jax.nn.sigmoid(o) * hn
    y = jax.nn.sigmoid(g_f) * (y_fourier @ w_four) + jax.nn.sigmoid(g_m) * (hm @ w_mproj)
    return y @ w_out


def token_mixing(h_lat, h_ctx, mod_l, mod_c, g_pre, g_post, w_in, b_in, conv_w, conv_b,
                 head_g, w_four, w_mproj, w_out, update_ctx):
    sh_l, sc_l, gt_l = mod_l
    sh_c, sc_c, gt_c = mod_c
    pl = project(modulate(rmsnorm(h_lat, g_pre), sh_l, sc_l), w_in, b_in, conv_w, conv_b)
    pc = project(modulate(rmsnorm(h_ctx, g_pre), sh_c, sc_c), w_in, b_in, conv_w, conv_b)
    B = h_ctx.shape[0]
    zero = (jnp.zeros((B, M_HEADS, M_HEAD_DIM, M_HEAD_DIM), jnp.float32),
            jnp.zeros((B, M_HEADS, M_HEAD_DIM), jnp.float32),
            jnp.zeros((B, M_HEADS), jnp.float32))
    h_c, s_f, s_b = bidir_mlstm(pc[1], pc[2], pc[3], pc[5], zero, zero)
    h_l, _, _ = bidir_mlstm(pl[1], pl[2], pl[3], pl[5], s_f, s_b)
    out_l = merge(fourier_latent(pl[0]), h_l, pl[4], pl[6], pl[7], head_g, w_four, w_mproj, w_out)
    new_lat = h_lat + gt_l * rmsnorm(out_l, g_post)
    new_ctx = None
    if update_ctx:
        out_c = merge(fourier_context(pc[0]), h_c, pc[4], pc[6], pc[7], head_g, w_four, w_mproj, w_out)
        new_ctx = h_ctx + gt_c * rmsnorm(out_c, g_post)
    return new_lat, new_ctx


def setup_inputs(seed: int = 0) -> dict:
    key = jax.random.key(seed)
    ks = jax.random.split(key, 20)
    nrm = lambda k, shape, s: jax.random.normal(k, shape, jnp.float32) * s
    D = D_MODEL
    b_in = nrm(ks[10], (DEPTH, IN_WIDTH), 0.02)
    f_bias = jnp.linspace(3.0, 6.0, M_HEADS, dtype=jnp.float32)
    b_in = b_in.at[:, COL_GATES + M_HEADS:COL_GATES + 2 * M_HEADS].add(f_bias)
    b_in = b_in.at[:, COL_GATES + 3 * M_HEADS:COL_GATES + 4 * M_HEADS].add(f_bias)
    return {
        "x": nrm(ks[0], (BATCH, SEQ, D), 1.0),
        "c": nrm(ks[1], (BATCH, D), 1.0),
        "ctx": nrm(ks[2], (BATCH, CTX_LEN, D), 1.0),
        "c_ctx": nrm(ks[3], (D,), 1.0),
        "w_ada": nrm(ks[4], (DEPTH, D, N_ADA * D), D ** -0.5),
        "b_ada": nrm(ks[5], (DEPTH, N_ADA * D), 0.02),
        "norm_g": 1.0 + nrm(ks[6], (DEPTH, 6, D), 0.05),
        "w13_a": nrm(ks[7], (DEPTH, D, 2 * FF_HALF), D ** -0.5),
        "w2_a": nrm(ks[8], (DEPTH, FF_HALF, D), FF_HALF ** -0.5),
        "w_in": nrm(ks[9], (DEPTH, D, IN_WIDTH), D ** -0.5),
        "b_in": b_in,
        "conv_w": nrm(ks[11], (DEPTH, CONV_K, 2 * M_WIDTH), CONV_K ** -0.5),
        "conv_b": nrm(ks[12], (DEPTH, 2 * M_WIDTH), 0.02),
        "head_g": 1.0 + nrm(ks[13], (DEPTH, M_WIDTH), 0.05),
        "w_four": nrm(ks[14], (DEPTH, F_WIDTH, D), F_WIDTH ** -0.5),
        "w_mproj": nrm(ks[15], (DEPTH, M_WIDTH, D), M_WIDTH ** -0.5),
        "w_out": nrm(ks[16], (DEPTH, D, D), D ** -0.5),
        "w13_b": nrm(ks[17], (DEPTH, D, 2 * FF_HALF), D ** -0.5),
        "w2_b": nrm(ks[18], (DEPTH, FF_HALF, D), FF_HALF ** -0.5),
    }


def reference(x, c, ctx, c_ctx, w_ada, b_ada, norm_g, w13_a, w2_a, w_in, b_in, conv_w, conv_b,
              head_g, w_four, w_mproj, w_out, w13_b, w2_b):
    h_lat = x
    h_ctx = ctx
    for l in range(DEPTH):
        last = l == DEPTH - 1
        ml = ada_params(c, w_ada[l], b_ada[l])
        mc = ada_params(c_ctx[None], w_ada[l], b_ada[l])
        g = norm_g[l]
        h_lat = half_ffn(h_lat, ml[:, 0], ml[:, 1], ml[:, 2], g[0], g[1], w13_a[l], w2_a[l])
        h_ctx = half_ffn(h_ctx, mc[:, 0], mc[:, 1], mc[:, 2], g[0], g[1], w13_a[l], w2_a[l])
        h_lat, h_ctx_new = token_mixing(
            h_lat, h_ctx, (ml[:, 3], ml[:, 4], ml[:, 5]), (mc[:, 3], mc[:, 4], mc[:, 5]),
            g[2], g[3], w_in[l], b_in[l], conv_w[l], conv_b[l], head_g[l],
            w_four[l], w_mproj[l], w_out[l], not last)
        h_lat = half_ffn(h_lat, ml[:, 6], ml[:, 7], ml[:, 8], g[4], g[5], w13_b[l], w2_b[l])
        if not last:
            h_ctx = half_ffn(h_ctx_new, mc[:, 6], mc[:, 7], mc[:, 8], g[4], g[5], w13_b[l], w2_b[l])
    return h_lat
```

```cpp
#include <hip/hip_runtime.h>
#include <hip/hip_cooperative_groups.h>
#include <cstdio>
#include <cstdint>
namespace cg = cooperative_groups;

#define LAS __attribute__((address_space(3)))
typedef unsigned short bf16;
typedef short bf16x8 __attribute__((ext_vector_type(8)));
typedef float f32x4 __attribute__((ext_vector_type(4)));
typedef float f32x2 __attribute__((ext_vector_type(2)));
typedef unsigned u32x4 __attribute__((ext_vector_type(4)));
typedef unsigned u32x2 __attribute__((ext_vector_type(2)));

constexpr int D = 1024, NB = 4, SEQ = 4096, CTXL = 256, FF = 2816, NH = 4, DH = 256, CH = 128;
constexpr int TLAT = NB * SEQ;
constexpr int TCTX = NB * CTXL;
constexpr int MTOK = TLAT + TCTX;
constexpr int INW = 6672;
constexpr int PLEN = CTXL + SEQ;
constexpr int NCHK = PLEN / CH;
constexpr float EPS = 1e-6f;
constexpr int NTHR = 512, NWAVE = 8;
constexpr int LDS_BYTES = 147456;

constexpr size_t MiB = 1u << 20;
constexpr size_t WS_MOD = 0;
constexpr size_t WS_BAR = 256 * 1024;
constexpr size_t WS_GATES = 512 * 1024;
constexpr size_t WS_TOKSC = 2 * MiB;
constexpr size_t WS_CHSC = 5 * MiB;
constexpr size_t WS_WG = 7 * MiB;
constexpr size_t WS_XCH = 6 * MiB;
constexpr size_t WS_XCNT = WS_BAR + 16 * 1024;
constexpr size_t WS_W13 = 8 * MiB, WS_W2 = 19 * MiB, WS_WIN = 25 * MiB, WS_WFOUR = 38 * MiB, WS_WMPROJ = 40 * MiB, WS_WOUT = 42 * MiB;
constexpr size_t WS_XFT = 8 * MiB;
constexpr size_t WS_U = 44 * MiB;
constexpr size_t WS_ACT = 78 * MiB;
constexpr size_t WS_Y1 = 172 * MiB;
constexpr size_t WS_Y1C = 208 * MiB;
constexpr size_t WS_QPRE = 78 * MiB;
constexpr size_t WS_KPRE = 110 * MiB;
constexpr size_t WS_VT = 144 * MiB;
constexpr size_t WS_Q = 178 * MiB;
constexpr size_t WS_UF = 210 * MiB;
constexpr size_t WS_KT = 44 * MiB;
constexpr size_t WS_HF = 78 * MiB, WS_HB = 110 * MiB;
constexpr size_t WS_HM = 144 * MiB;
constexpr size_t WS_TF = 176 * MiB;
constexpr size_t WS_TM = 78 * MiB;
constexpr size_t WS_OUTL = 110 * MiB;
constexpr size_t WS_D12 = 44 * MiB;
constexpr size_t WS_ACT2 = 76 * MiB;
constexpr size_t WS_Y3 = 164 * MiB;
constexpr size_t WS_NEED = 256 * MiB;
constexpr size_t DO_D1 = 0, DO_P = 32 * MiB, DO_U3 = 32 * MiB;

constexpr int COL_F = 0, COL_Q = 512, COL_K = 1536, COL_V = 2560, COL_O = 3584, COL_GATES = 4608, COL_GF = 4624, COL_GM = 5648;
constexpr int ROW_Q = 0, ROW_K = 1024, ROW_V = 2048, ROW_F = 3072, ROW_O = 3584, ROW_GF = 4608, ROW_GM = 5632, WIN_ROWS = 6656;

struct Params {
    const float *x, *c, *ctx, *c_ctx, *w_ada, *b_ada, *norm_g, *w13_a, *w2_a, *w_in, *b_in, *conv_w, *conv_b, *head_g, *w_four, *w_mproj, *w_out, *w13_b, *w2_b;
    float* out; unsigned char* ws;
};

typedef __bf16 bf16x2_t __attribute__((ext_vector_type(2)));
__device__ __forceinline__ unsigned f2bf(float f) { return (unsigned)__builtin_bit_cast(unsigned short, (__bf16)f); }
__device__ __forceinline__ unsigned pk2(float lo, float hi) { bf16x2_t v; v[0] = (__bf16)lo; v[1] = (__bf16)hi; return __builtin_bit_cast(unsigned, v); }
__device__ __forceinline__ float bf2f(unsigned b) { return __builtin_bit_cast(float, b << 16); }
__device__ __forceinline__ float bflo(unsigned w) { return __builtin_bit_cast(float, w << 16); }
__device__ __forceinline__ float bfhi(unsigned w) { return __builtin_bit_cast(float, w & 0xffff0000u); }
__device__ __forceinline__ unsigned cvt_pk_bf16(float lo, float hi) { return pk2(lo, hi); }
#define DPP_F(v, ctrl) __builtin_bit_cast(float, __builtin_amdgcn_update_dpp(0, __builtin_bit_cast(int, (v)), (ctrl), 0xf, 0xf, false))
__device__ __forceinline__ float row16_sum(float v) {
    v += DPP_F(v, 0xB1);
    v += DPP_F(v, 0x4E);
    v += DPP_F(v, 0x141);
    v += DPP_F(v, 0x140);
    return v;
}
__device__ __forceinline__ float rlane(float v, int l) { return __builtin_bit_cast(float, __builtin_amdgcn_readlane(__builtin_bit_cast(int, v), l)); }
__device__ __forceinline__ float wave_sum(float v) { v = row16_sum(v); return (rlane(v, 0) + rlane(v, 16)) + (rlane(v, 32) + rlane(v, 48)); }
__device__ __forceinline__ float sigmoidf_(float x) { return __builtin_amdgcn_rcpf(1.0f + __expf(-x)); }
__device__ __forceinline__ float siluf_(float x) { return x * __builtin_amdgcn_rcpf(1.0f + __expf(-x)); }
#define LDS_WAIT() asm volatile("s_waitcnt lgkmcnt(0)" ::: "memory")
#define VM_WAIT() asm volatile("s_waitcnt vmcnt(0)" ::: "memory")

namespace pg8 {
constexpr int BM = 256, BK = 64, HALF = 128, HTB = HALF * BK * 2, STAGE_BYTES = 8 * HTB, NXCD = 8, WGM = 8;
__host__ __device__ __forceinline__ int lds_byte(int r, int c) { const int st = (r >> 4) * 2 + (c >> 5), rr = r & 15, cc = c & 31, ob = rr * 64 + cc * 2; return st * 1024 + (ob ^ (((ob >> 9) & 1) << 5)); }
__host__ __device__ __forceinline__ void stage_rc(int b, int& R, int& C) { const int st = b / 1024, sb = b % 1024, swz = sb ^ (((sb >> 9) & 1) << 5); R = (st >> 1) * 16 + swz / 64; C = (st & 1) * 32 + (swz % 64) / 2; }
__host__ __device__ __forceinline__ int perm32(int rho) { const int n = rho >> 4, i = rho & 15; return 8 * (i >> 2) + 4 * n + (i & 3); }

struct Unit { const char* A; const char* B; int kind, pm, pn, nt, kq; };
struct Seg { const char* A0; const char* B0; int nM, nN, kind, ksplit; };
struct Sched {
    Seg s[4]; int G, c; size_t tstep;
    int ntk;
    __device__ __forceinline__ bool pick(const Seg& sg, long& L, Unit& u) const {
        const int nwg = sg.nM * sg.nN * sg.ksplit;
        if (L >= nwg) { L -= nwg; return false; }
        if (sg.ksplit > 1) { const int tiles = sg.nM * sg.nN, kq = (int)L / tiles, tl = (int)L % tiles; u.pm = tl % sg.nM; u.pn = tl / sg.nM; u.kind = sg.kind;
            const int kt0 = kq * 6 - (kq > 6 ? 2 : 0); u.nt = kq < 6 ? 6 : 4; u.kq = kq;
            u.A = sg.A0 + (size_t)u.pm * tstep + kt0 * 128; u.B = sg.B0 + (size_t)u.pn * tstep + kt0 * 128; return true; }
        u.nt = ntk; u.kq = 0;
        int wgid = (int)L; { const int q = nwg / NXCD, r = nwg % NXCD, xcd = wgid % NXCD, off = wgid / NXCD; wgid = (xcd < r ? xcd * (q + 1) : r * (q + 1) + (xcd - r) * q) + off; }
        const int nig = WGM * sg.nN, gid = wgid / nig, fm = gid * WGM, gsz = (sg.nM - fm) < WGM ? (sg.nM - fm) : WGM;
        u.pm = fm + ((wgid % nig) % gsz); u.pn = (wgid % nig) / gsz; u.kind = sg.kind;
        u.A = sg.A0 + (size_t)u.pm * tstep; u.B = sg.B0 + (size_t)u.pn * tstep; return true;
    }
    __device__ __forceinline__ bool next(int i, Unit& u) const {
        long L = (long)i * G + c;
        if (pick(s[0], L, u)) return true;
        if (pick(s[1], L, u)) return true;
        if (pick(s[2], L, u)) return true;
        if (pick(s[3], L, u)) return true;
        return false;
    }
};

struct SchedY {
    Sched base; const char* Ag; const char* Bg;
    __device__ __forceinline__ bool next(int i, Unit& u) const {
        if (i > 2) return false;
        long L = base.c; Unit t; base.pick(base.s[0], L, t);
        if (i == 0) { u = t; return true; }
        u.kind = 0; u.pm = t.pm; u.pn = 2 * t.pn + (i - 1); u.nt = base.ntk; u.kq = 0;
        u.A = Ag + (size_t)u.pm * base.tstep; u.B = Bg + (size_t)u.pn * base.tstep; return true;
    }
};
template <class Epi, class SchedT>
__device__ __forceinline__ void gemm_phase(LAS unsigned char* lds, const int K, const SchedT& S, const Epi& E) {
    int tid_ = threadIdx.x; asm volatile("" : "+v"(tid_));
    const int tid = tid_, wid = __builtin_amdgcn_readfirstlane(tid >> 6), lane = tid & 63, wr = wid >> 2, wc = wid & 3, fr = lane & 15, fq = lane >> 4;
    unsigned voffA[2], voffB[2];
#pragma unroll
    for (int i = 0; i < 2; ++i) { int R, C; stage_rc(tid * 16 + i * 8192, R, C); const int Rb = (R & ~31) + perm32(R & 31);
        voffA[i] = (unsigned)(R * K + C) * 2u; voffB[i] = (unsigned)(Rb * K + C) * 2u; }
    const size_t kstep = (size_t)(BK * 2);
    const size_t hstep = (size_t)HALF * K * 2;
    const unsigned ldsw = (unsigned)wid * 1024u;
    const int aoff = lds_byte(wr * 64 + fr, fq * 8), boff = lds_byte(wc * 32 + fr, fq * 8);
#define PG8_SA(b, h) (((b) * 2 + (h)) * HTB)
#define PG8_SB(b, h) ((4 + (b) * 2 + (h)) * HTB)
#define PG8_STAGE(bufoff, gbase, voff) do { _Pragma("unroll") for (int _i = 0; _i < 2; ++_i) \
        __builtin_amdgcn_global_load_lds((const unsigned*)((const char*)(gbase) + (voff)[_i]), (LAS unsigned*)(lds + (bufoff) + ldsw + _i * 8192), 16, 0, 0); } while (0)
#define PG8_LDA(dst, b, h) do { _Pragma("unroll") for (int m = 0; m < 4; ++m) _Pragma("unroll") for (int k = 0; k < 2; ++k) dst[m][k] = *(const LAS bf16x8*)(lds + PG8_SA(b, h) + aoff + m * 2048 + k * 1024); } while (0)
#define PG8_LDB(dst, b, h) do { _Pragma("unroll") for (int n = 0; n < 2; ++n) _Pragma("unroll") for (int k = 0; k < 2; ++k) dst[n][k] = *(const LAS bf16x8*)(lds + PG8_SB(b, h) + boff + n * 2048 + k * 1024); } while (0)
#define PG8_MMA(ai, bj, At, Bt) do { __builtin_amdgcn_s_setprio(1); _Pragma("unroll") for (int m = 0; m < 4; ++m) _Pragma("unroll") for (int n = 0; n < 2; ++n) _Pragma("unroll") for (int k = 0; k < 2; ++k) \
        acc[ai][bj][m][n] = __builtin_amdgcn_mfma_f32_16x16x32_bf16(Bt[n][k], At[m][k], acc[ai][bj][m][n], 0, 0, 0); __builtin_amdgcn_s_setprio(0); } while (0)
#define PG8_WAIT_V(n) asm volatile("s_waitcnt vmcnt(" #n ")" ::: "memory")
#define PG8_WAIT_L(n) asm volatile("s_waitcnt lgkmcnt(" #n ")" ::: "memory")
#define PG8_BAR __builtin_amdgcn_s_barrier()
#define PG8_SCHED __builtin_amdgcn_sched_barrier(0)
    Unit cur, nxt; int ui = 0;
    if (!S.next(0, cur)) return;
    f32x4 acc[2][2][4][2];
#pragma unroll
    for (int a = 0; a < 2; ++a)
#pragma unroll
        for (int b = 0; b < 2; ++b)
#pragma unroll
            for (int m = 0; m < 4; ++m)
#pragma unroll
                for (int n = 0; n < 2; ++n) acc[a][b][m][n] = (f32x4){0.f, 0.f, 0.f, 0.f};
    bf16x8 At[4][2], B0[2][2], B1[2][2];
    const char* cA = cur.A; const char* cB = cur.B;
    PG8_STAGE(PG8_SB(0, 0), cB, voffB); PG8_STAGE(PG8_SB(0, 1), cB + hstep, voffB); PG8_STAGE(PG8_SA(0, 0), cA, voffA); PG8_STAGE(PG8_SA(0, 1), cA + hstep, voffA);
    if (wr == 1) PG8_BAR;
    PG8_WAIT_V(2); PG8_BAR;
    PG8_STAGE(PG8_SB(1, 0), cB + kstep, voffB); PG8_STAGE(PG8_SA(1, 0), cA + kstep, voffA); PG8_STAGE(PG8_SB(1, 1), cB + hstep + kstep, voffB);
    PG8_WAIT_V(6); PG8_BAR;
    for (;;) {
        const bool has_next = S.next(ui + 1, nxt);
        const char* nA = has_next ? nxt.A : cA; const char* nB = has_next ? nxt.B : cB;
        const int nt = cur.nt;
        for (int t = 0; t < nt; t += 2) {
            const bool last = (t == nt - 2);
            const char* a1 = cA + (size_t)(t + 1) * kstep;
            const char* a2 = last ? nA : cA + (size_t)(t + 2) * kstep; const char* b2 = last ? nB : cB + (size_t)(t + 2) * kstep;
            const char* a3 = a2 + kstep; const char* b3 = b2 + kstep;
            PG8_LDB(B0, 0, 0); PG8_LDB(B1, 0, 1); PG8_SCHED; PG8_LDA(At, 0, 0); PG8_STAGE(PG8_SA(1, 1), a1 + hstep, voffA);
            PG8_WAIT_V(8); PG8_WAIT_L(0); PG8_BAR; PG8_MMA(0, 0, At, B0); PG8_MMA(0, 1, At, B1); PG8_BAR; PG8_SCHED;
            PG8_LDA(At, 0, 1); PG8_STAGE(PG8_SB(0, 0), b2, voffB); PG8_STAGE(PG8_SB(0, 1), b2 + hstep, voffB); PG8_STAGE(PG8_SA(0, 0), a2, voffA);
            PG8_WAIT_V(8); PG8_WAIT_L(0); PG8_BAR; PG8_MMA(1, 0, At, B0); PG8_MMA(1, 1, At, B1); PG8_BAR; PG8_SCHED;
            PG8_LDB(B0, 1, 0); PG8_LDB(B1, 1, 1); PG8_SCHED; PG8_LDA(At, 1, 0); PG8_STAGE(PG8_SA(0, 1), a2 + hstep, voffA);
            PG8_WAIT_V(8); PG8_WAIT_L(0); PG8_BAR; PG8_MMA(0, 0, At, B0); PG8_MMA(0, 1, At, B1); PG8_BAR; PG8_SCHED;
            PG8_LDA(At, 1, 1); PG8_STAGE(PG8_SB(1, 0), b3, voffB); PG8_STAGE(PG8_SB(1, 1), b3 + hstep, voffB); PG8_STAGE(PG8_SA(1, 0), a3, voffA);
            PG8_WAIT_V(8); PG8_WAIT_L(0); PG8_BAR; PG8_MMA(1, 0, At, B0); PG8_MMA(1, 1, At, B1); PG8_BAR; PG8_SCHED;
        }
        if (wr == 0) PG8_BAR;
        { int fr2 = fr, fq2 = fq; asm volatile("" : "+v"(fr2), "+v"(fq2));
          E(acc, cur, wr, wc, fr2, fq2); }
        if (!has_next) break;
#pragma unroll
        for (int a = 0; a < 2; ++a)
#pragma unroll
            for (int b = 0; b < 2; ++b)
#pragma unroll
                for (int m = 0; m < 4; ++m)
#pragma unroll
                    for (int n = 0; n < 2; ++n) acc[a][b][m][n] = (f32x4){0.f, 0.f, 0.f, 0.f};
        cur = nxt; cA = nA; cB = nB; ++ui;
        if (wr == 1) PG8_BAR;
    }
    PG8_WAIT_V(0);
    PG8_BAR;
#undef PG8_SA
#undef PG8_SB
#undef PG8_STAGE
#undef PG8_LDA
#undef PG8_LDB
#undef PG8_MMA
#undef PG8_WAIT_V
#undef PG8_WAIT_L
#undef PG8_BAR
#undef PG8_SCHED
}
}

#define ACC_T const f32x4 (&acc)[2][2][4][2]
template <class T> __device__ __forceinline__ T ldg(const void* base, unsigned boff) { return *(const T*)((const char*)base + boff); }
#ifndef WT_STORES
#define WT_STORES 0
#endif
template <class T> __device__ __forceinline__ void stg(void* base, unsigned boff, const T& v) {
    static_assert(sizeof(T) == 16, "16-byte stores only");
#if WT_STORES
    const __amdgpu_buffer_rsrc_t rs = __builtin_amdgcn_make_buffer_rsrc(base, (short)0, 0x7fffffff, 0x00020000);
    __builtin_amdgcn_raw_buffer_store_b128(__builtin_bit_cast(u32x4, v), rs, boff, 0, 16);
#else
    *(T*)((char*)base + boff) = v;
#endif
}
__device__ __forceinline__ u32x4 pack8(const f32x4& v0, const f32x4& v1) { u32x4 w; w.x = cvt_pk_bf16(v0[0], v0[1]); w.y = cvt_pk_bf16(v0[2], v0[3]); w.z = cvt_pk_bf16(v1[0], v1[1]); w.w = cvt_pk_bf16(v1[2], v1[3]); return w; }
#define ROWGROUPS(ai, m) _Pragma("unroll") for (int ai = 0; ai < 2; ++ai) _Pragma("unroll") for (int m = 0; m < 4; ++m)

struct EpiSwiglu {
    bf16* O;
    __device__ __forceinline__ void operator()(ACC_T, const pg8::Unit& u, int wr, int wc, int fr, int fq) const {
        const unsigned off0 = (unsigned)((u.pm * 256 + wr * 64 + fr) * FF + u.pn * 128 + wc * 32 + 8 * fq) * 2u;
        ROWGROUPS(ai, m) {
            const f32x4 a0 = acc[ai][0][m][0], a1 = acc[ai][0][m][1], b0 = acc[ai][1][m][0], b1 = acc[ai][1][m][1];
            f32x4 h0, h1;
#pragma unroll
            for (int j = 0; j < 4; ++j) { h0[j] = a0[j] * b0[j] * __builtin_amdgcn_rcpf(1.0f + __builtin_amdgcn_exp2f(-a0[j])); h1[j] = a1[j] * b1[j] * __builtin_amdgcn_rcpf(1.0f + __builtin_amdgcn_exp2f(-a1[j])); }
            stg(O, off0 + (unsigned)((ai * 128 + m * 16) * FF * 2), pack8(h0, h1));
        }
    }
};

struct EpiProjA {
    bf16 *Oq, *Ok, *Ovt, *Oxt; const float* b_in; float* G;
    __device__ __forceinline__ void operator()(ACC_T, const pg8::Unit& u, int wr, int wc, int fr, int fq) const {
        const int row0 = u.pm * 256 + wr * 64 + fr, col0 = u.pn * 256 + wc * 32 + 8 * fq;
        if (u.kind == 4) {
            if (wc == 0 && fq < 2) { const f32x4 b0 = ldg<f32x4>(b_in, (unsigned)(COL_GATES + 8 * fq) * 4u), b1 = ldg<f32x4>(b_in, (unsigned)(COL_GATES + 8 * fq + 4) * 4u);
                const unsigned g0 = (unsigned)(row0 * 16 + 8 * fq) * 4u;
                ROWGROUPS(ai, m) { stg(G, g0 + (unsigned)((ai * 128 + m * 16) * 64), acc[ai][0][m][0] + b0); stg(G, g0 + (unsigned)((ai * 128 + m * 16) * 64) + 16, acc[ai][0][m][1] + b1); } }
            return; }
        if (u.kind == 0) {
            const bool isk = u.pn >= 4; if (!isk && u.pm >= TLAT / 256) return;
            bf16* O = isk ? Ok : Oq; const int colq = col0 - (isk ? 1024 : 0); const unsigned boff = (unsigned)((isk ? COL_K : COL_Q) + colq) * 4u;
            const unsigned off0 = (unsigned)(row0 * D + colq) * 2u;
#pragma unroll
            for (int bj = 0; bj < 2; ++bj) {
                const f32x4 bv0 = ldg<f32x4>(b_in, boff + bj * 512), bv1 = ldg<f32x4>(b_in, boff + bj * 512 + 16);
                ROWGROUPS(ai, m) stg(O, off0 + (unsigned)((ai * 128 + m * 16) * D * 2) + bj * 256, pack8(acc[ai][bj][m][0] + bv0, acc[ai][bj][m][1] + bv1));
            }
        } else {
            bf16* O = u.kind == 2 ? Ovt : Oxt; const int ldc = u.kind == 2 ? MTOK : TLAT; const unsigned boff = (unsigned)((u.kind == 2 ? COL_V : COL_F) + row0) * 4u;
            const unsigned off0 = (unsigned)(row0 * ldc + col0) * 2u;
            ROWGROUPS(ai, m) { const float bb = ldg<float>(b_in, boff + (unsigned)((ai * 128 + m * 16) * 4)); const unsigned o = off0 + (unsigned)((ai * 128 + m * 16) * ldc * 2);
#pragma unroll
                for (int bj = 0; bj < 2; ++bj) stg(O, o + bj * 256, pack8(acc[ai][bj][m][0] + bb, acc[ai][bj][m][1] + bb)); }
        }
    }
};
__device__ __forceinline__ void store_bf16_tile(bf16* O, ACC_T, const pg8::Unit& u, int wr, int wc, int fr, int fq) {
    const unsigned off0 = (unsigned)((u.pm * 256 + wr * 64 + fr) * D + u.pn * 256 + wc * 32 + 8 * fq) * 2u;
    ROWGROUPS(ai, m) { const unsigned o = off0 + (unsigned)((ai * 128 + m * 16) * D * 2);
#pragma unroll
        for (int bj = 0; bj < 2; ++bj) stg(O, o + bj * 256, pack8(acc[ai][bj][m][0], acc[ai][bj][m][1])); }
}
struct EpiBf16 { bf16* O; __device__ __forceinline__ void operator()(ACC_T, const pg8::Unit& u, int wr, int wc, int fr, int fq) const { store_bf16_tile(O, acc, u, wr, wc, fr, fq); } };
struct EpiDownA { bf16* Y1; float* Y1C;
    __device__ __forceinline__ void operator()(ACC_T, const pg8::Unit& u, int wr, int wc, int fr, int fq) const {
        if (u.kind == 0) { store_bf16_tile(Y1, acc, u, wr, wc, fr, fq); return; }
        const unsigned off0 = (unsigned)(((u.kq * TCTX + u.pm * 256 + wr * 64 + fr) * D) + u.pn * 256 + wc * 32 + 8 * fq) * 4u;
        ROWGROUPS(ai, m) { const unsigned o = off0 + (unsigned)((ai * 128 + m * 16) * D * 4);
#pragma unroll
            for (int bj = 0; bj < 2; ++bj) { stg(Y1C, o + bj * 512, acc[ai][bj][m][0]); stg(Y1C, o + bj * 512 + 16, acc[ai][bj][m][1]); } }
    }
};
struct EpiX {
    bf16 *HM, *TF; const bf16 *HF, *HB; const float *b_in, *head_g; LAS float* red;
    __device__ __forceinline__ void operator()(ACC_T, const pg8::Unit& u, int wr, int wc, int fr, int fq) const {
        if (u.kind == 1) { store_bf16_tile(TF, acc, u, wr, wc, fr, fq); return; }
        const int col0 = u.pn * 256 + wc * 32 + 8 * fq, rt0 = wr * 64 + fr;
        const unsigned off0 = (unsigned)((u.pm * 256 + rt0) * D + col0) * 2u;
#pragma unroll
        for (int am = 0; am < 4; ++am) { const int ai = am >> 1, mb = (am & 1) * 2;
            u32x4 hp[4][2];
#pragma unroll
            for (int m = mb; m < mb + 2; ++m) { const unsigned o = off0 + (unsigned)((ai * 128 + m * 16) * D * 2); float s = 0.f;
#pragma unroll
                for (int bj = 0; bj < 2; ++bj) { const u32x4 a = ldg<u32x4>(HF, o + bj * 256), b = ldg<u32x4>(HB, o + bj * 256); u32x4 hq;
#pragma unroll
                    for (int q = 0; q < 4; ++q) { const float h0 = bflo(a[q]) + bflo(b[q]), h1 = bfhi(a[q]) + bfhi(b[q]); hq[q] = pk2(h0, h1); const float g0 = bflo(hq[q]), g1 = bfhi(hq[q]); s += g0 * g0 + g1 * g1; }
                    hp[m][bj] = hq; }
                s += __shfl_xor(s, 16); s += __shfl_xor(s, 32);
                if (fq == 0) red[(ai * 128 + m * 16 + rt0) * 4 + wc] = s; }
            LDS_WAIT(); __builtin_amdgcn_s_barrier(); asm volatile("" ::: "memory");
#pragma unroll
            for (int bj = 0; bj < 2; ++bj) {
                const unsigned cb = (unsigned)(col0 + bj * 128) * 4u;
                const f32x4 bo0 = ldg<f32x4>(b_in, COL_O * 4 + cb), bo1 = ldg<f32x4>(b_in, COL_O * 4 + cb + 16), hg0 = ldg<f32x4>(head_g, cb), hg1 = ldg<f32x4>(head_g, cb + 16);
#pragma unroll
                for (int m = mb; m < mb + 2; ++m) { const f32x4 ps = *(const LAS f32x4*)(red + (ai * 128 + m * 16 + rt0) * 4);
                    const float rstd = rsqrtf(((ps[0] + ps[1]) + (ps[2] + ps[3])) * (1.0f / 256.0f) + EPS);
                    const unsigned o = off0 + (unsigned)((ai * 128 + m * 16) * D * 2) + bj * 256;
                    const u32x4 hq = hp[m][bj];
                    const f32x4 v0 = acc[ai][bj][m][0] + bo0, v1 = acc[ai][bj][m][1] + bo1;
                    f32x4 r0, r1;
                    r0[0] = sigmoidf_(v0[0]) * bflo(hq[0]) * rstd * hg0[0]; r0[1] = sigmoidf_(v0[1]) * bfhi(hq[0]) * rstd * hg0[1];
                    r0[2] = sigmoidf_(v0[2]) * bflo(hq[1]) * rstd * hg0[2]; r0[3] = sigmoidf_(v0[3]) * bfhi(hq[1]) * rstd * hg0[3];
                    r1[0] = sigmoidf_(v1[0]) * bflo(hq[2]) * rstd * hg1[0]; r1[1] = sigmoidf_(v1[1]) * bfhi(hq[2]) * rstd * hg1[1];
                    r1[2] = sigmoidf_(v1[2]) * bflo(hq[3]) * rstd * hg1[2]; r1[3] = sigmoidf_(v1[3]) * bfhi(hq[3]) * rstd * hg1[3];
                    stg(HM, o, pack8(r0, r1)); } }
            asm volatile("" ::: "memory");
        }
    }
};
struct EpiY {
    bf16 *TF, *TM; const float* b_in;
    __device__ __forceinline__ void operator()(ACC_T, const pg8::Unit& u, int wr, int wc, int fr, int fq) const {
        if (u.kind == 1) { store_bf16_tile(TM, acc, u, wr, wc, fr, fq); return; }
        const int ch0 = u.pn * 128 + wc * 32 + 8 * fq;
        const unsigned off0 = (unsigned)((u.pm * 256 + wr * 64 + fr) * D + ch0) * 2u;
        const f32x4 bf0 = ldg<f32x4>(b_in, (unsigned)(COL_GF + ch0) * 4u), bf1 = ldg<f32x4>(b_in, (unsigned)(COL_GF + ch0) * 4u + 16);
        const f32x4 bm0 = ldg<f32x4>(b_in, (unsigned)(COL_GM + ch0) * 4u), bm1 = ldg<f32x4>(b_in, (unsigned)(COL_GM + ch0) * 4u + 16);
        ROWGROUPS(ai, m) { const unsigned o = off0 + (unsigned)((ai * 128 + m * 16) * D * 2);
            const u32x4 t = ldg<u32x4>(TF, o), tm = ldg<u32x4>(TM, o);
            const f32x4 f0 = acc[ai][0][m][0] + bf0, f1 = acc[ai][0][m][1] + bf1, g0 = acc[ai][1][m][0] + bm0, g1 = acc[ai][1][m][1] + bm1;
            f32x4 r0, r1;
            r0[0] = sigmoidf_(f0[0]) * bflo(t[0]) + sigmoidf_(g0[0]) * bflo(tm[0]); r0[1] = sigmoidf_(f0[1]) * bfhi(t[0]) + sigmoidf_(g0[1]) * bfhi(tm[0]);
            r0[2] = sigmoidf_(f0[2]) * bflo(t[1]) + sigmoidf_(g0[2]) * bflo(tm[1]); r0[3] = sigmoidf_(f0[3]) * bfhi(t[1]) + sigmoidf_(g0[3]) * bfhi(tm[1]);
            r1[0] = sigmoidf_(f1[0]) * bflo(t[2]) + sigmoidf_(g1[0]) * bflo(tm[2]); r1[1] = sigmoidf_(f1[1]) * bfhi(t[2]) + sigmoidf_(g1[1]) * bfhi(tm[2]);
            r1[2] = sigmoidf_(f1[2]) * bflo(t[3]) + sigmoidf_(g1[2]) * bflo(tm[3]); r1[3] = sigmoidf_(f1[3]) * bfhi(t[3]) + sigmoidf_(g1[3]) * bfhi(tm[3]);
            stg(TM, o, pack8(r0, r1));
            asm volatile("" ::: "memory"); }
    }
};

struct PanelRms {
    float* xbuf; unsigned* cnt;
    __device__ __forceinline__ void run(const f32x4 (&v)[2][2][4][2], const pg8::Unit& u, int wr, int wc, int fr, int fq, LAS float* Pt, LAS float* S, int wid, int lane) const {
        ROWGROUPS(ai, m) { float s = 0.f;
#pragma unroll
            for (int bj = 0; bj < 2; ++bj)
#pragma unroll
                for (int n = 0; n < 2; ++n) { const f32x4 x = v[ai][bj][m][n]; s += (x[0] * x[0] + x[1] * x[1]) + (x[2] * x[2] + x[3] * x[3]); }
            s += __shfl_xor(s, 16); s += __shfl_xor(s, 32);
            if (fq == 0) Pt[(ai * 128 + wr * 64 + m * 16 + fr) * 4 + wc] = s; }
        LDS_WAIT(); __builtin_amdgcn_s_barrier(); asm volatile("" ::: "memory");
        const int row = wid * 32 + (lane & 31);
        if (lane < 32) { const f32x4 a = *(const LAS f32x4*)(Pt + row * 4);
            __hip_atomic_store(xbuf + (size_t)(u.pm * 256 + row) * 4 + u.pn, (a[0] + a[1]) + (a[2] + a[3]), __ATOMIC_RELAXED, __HIP_MEMORY_SCOPE_AGENT); }
        asm volatile("s_waitcnt vmcnt(0)" ::: "memory");
        if (lane == 0) __hip_atomic_fetch_add(cnt + 64 * u.pm, 1u, __ATOMIC_RELAXED, __HIP_MEMORY_SCOPE_AGENT);
        if (wid == 0) { unsigned sp = 0;
            while ((unsigned)__builtin_amdgcn_readfirstlane(__hip_atomic_load(cnt + 64 * u.pm, __ATOMIC_RELAXED, __HIP_MEMORY_SCOPE_AGENT)) < 32u) { __builtin_amdgcn_s_sleep(2); if (++sp > (1u << 22)) break; }
            __builtin_amdgcn_fence(__ATOMIC_ACQUIRE, "agent"); }
        asm volatile("s_waitcnt vmcnt(0) lgkmcnt(0)" ::: "memory"); __builtin_amdgcn_s_barrier(); asm volatile("" ::: "memory");
        if (lane < 32) { const float* sl = xbuf + (size_t)(u.pm * 256 + row) * 4; float t = 0.f;
#pragma unroll
            for (int k = 0; k < 4; ++k) t += __hip_atomic_load(sl + k, __ATOMIC_RELAXED, __HIP_MEMORY_SCOPE_AGENT);
            S[row] = rsqrtf(t * (1.0f / 1024.0f) + EPS); }
        LDS_WAIT(); __builtin_amdgcn_s_barrier(); asm volatile("" ::: "memory");
    }
};
struct EpiFinal {
    const float *x, *g5, *mod; const bf16* D12; float* out; PanelRms st; LAS float* tab;
    __device__ __forceinline__ void operator()(ACC_T, const pg8::Unit& u, int wr, int wc, int fr, int fq) const {
        const int wid = wr * 4 + wc, lane = fq * 16 + fr; LAS float* S = tab + 1024;
        st.run(acc, u, wr, wc, fr, fq, tab, S, wid, lane);
        const int col0 = u.pn * 256 + wc * 32 + 8 * fq, rt0 = wr * 64 + fr, v = (u.pm * 256) >> 12;
        const unsigned e0 = (unsigned)((u.pm * 256 + rt0) * D + col0);
        const float* gate = mod + (size_t)v * 9216 + 8 * 1024;
#pragma unroll
        for (int bj = 0; bj < 2; ++bj) {
            const unsigned cb = (unsigned)(col0 + bj * 128) * 4u;
            f32x4 g0 = ldg<f32x4>(g5, cb), g1 = ldg<f32x4>(g5, cb + 16); const f32x4 t0 = ldg<f32x4>(gate, cb), t1 = ldg<f32x4>(gate, cb + 16);
            g0 = g0 * t0 * 0.5f; g1 = g1 * t1 * 0.5f;
            ROWGROUPS(ai, m) { const float rs = S[ai * 128 + m * 16 + rt0]; const unsigned e = e0 + (unsigned)((ai * 128 + m * 16) * D) + bj * 128;
                const f32x4 x0 = ldg<f32x4>(x, e * 4u), x1 = ldg<f32x4>(x, e * 4u + 16); const u32x4 dd = ldg<u32x4>(D12, e * 2u);
                f32x4 o0, o1;
                o0[0] = x0[0] + bflo(dd[0]); o0[1] = x0[1] + bfhi(dd[0]); o0[2] = x0[2] + bflo(dd[1]); o0[3] = x0[3] + bfhi(dd[1]);
                o1[0] = x1[0] + bflo(dd[2]); o1[1] = x1[1] + bfhi(dd[2]); o1[2] = x1[2] + bflo(dd[3]); o1[3] = x1[3] + bfhi(dd[3]);
                o0 = o0 + acc[ai][bj][m][0] * rs * g0; o1 = o1 + acc[ai][bj][m][1] * rs * g1;
                stg(out, e * 4u, o0); stg(out, e * 4u + 16, o1);
                asm volatile("" ::: "memory"); } }
    }
};
struct EpiMix {
    const float *x, *g3, *g4, *mod; const bf16* D1; bf16 *D12, *U3; PanelRms st1, st2; LAS float* tab;
    __device__ __forceinline__ void operator()(f32x4 (&acc)[2][2][4][2], const pg8::Unit& u, int wr, int wc, int fr, int fq) const {
        const int wid = wr * 4 + wc, lane = fq * 16 + fr; LAS float* S = tab + 1024;
        st1.run(acc, u, wr, wc, fr, fq, tab, S, wid, lane);
        const int col0 = u.pn * 256 + wc * 32 + 8 * fq, rt0 = wr * 64 + fr, v = (u.pm * 256) >> 12;
        const unsigned e0 = (unsigned)((u.pm * 256 + rt0) * D + col0);
        const float* mv = mod + (size_t)v * 9216;
#pragma unroll
        for (int bj = 0; bj < 2; ++bj) {
            const unsigned cb = (unsigned)(col0 + bj * 128) * 4u;
            f32x4 g0 = ldg<f32x4>(g3, cb), g1 = ldg<f32x4>(g3, cb + 16); const f32x4 t0 = ldg<f32x4>(mv + 5 * 1024, cb), t1 = ldg<f32x4>(mv + 5 * 1024, cb + 16);
            g0 = g0 * t0; g1 = g1 * t1;
            ROWGROUPS(ai, m) { const float rs = S[ai * 128 + m * 16 + rt0]; const unsigned e = e0 + (unsigned)((ai * 128 + m * 16) * D) + bj * 128;
                const u32x4 dd = ldg<u32x4>(D1, e * 2u);
                f32x4 d0, d1;
                d0[0] = bflo(dd[0]); d0[1] = bfhi(dd[0]); d0[2] = bflo(dd[1]); d0[3] = bfhi(dd[1]); d1[0] = bflo(dd[2]); d1[1] = bfhi(dd[2]); d1[2] = bflo(dd[3]); d1[3] = bfhi(dd[3]);
                d0 = d0 + acc[ai][bj][m][0] * rs * g0; d1 = d1 + acc[ai][bj][m][1] * rs * g1;
                const u32x4 pk = pack8(d0, d1); stg(D12, e * 2u, pk);
                const f32x4 x0 = ldg<f32x4>(x, e * 4u), x1 = ldg<f32x4>(x, e * 4u + 16);
                f32x4 h0, h1;
                h0[0] = x0[0] + bflo(pk[0]); h0[1] = x0[1] + bfhi(pk[0]); h0[2] = x0[2] + bflo(pk[1]); h0[3] = x0[3] + bfhi(pk[1]);
                h1[0] = x1[0] + bflo(pk[2]); h1[1] = x1[1] + bfhi(pk[2]); h1[2] = x1[2] + bflo(pk[3]); h1[3] = x1[3] + bfhi(pk[3]);
                acc[ai][bj][m][0] = h0; acc[ai][bj][m][1] = h1;
                asm volatile("" ::: "memory"); } }
        st2.run(acc, u, wr, wc, fr, fq, tab, S, wid, lane);
#pragma unroll
        for (int bj = 0; bj < 2; ++bj) {
            const unsigned cb = (unsigned)(col0 + bj * 128) * 4u;
            f32x4 g0 = ldg<f32x4>(g4, cb), g1 = ldg<f32x4>(g4, cb + 16); const f32x4 c0 = ldg<f32x4>(mv + 7 * 1024, cb), c1 = ldg<f32x4>(mv + 7 * 1024, cb + 16);
            const f32x4 s0 = ldg<f32x4>(mv + 6 * 1024, cb), s1 = ldg<f32x4>(mv + 6 * 1024, cb + 16);
            g0 = g0 * (c0 + 1.0f); g1 = g1 * (c1 + 1.0f);
            ROWGROUPS(ai, m) { const float rs = S[ai * 128 + m * 16 + rt0]; const unsigned e = e0 + (unsigned)((ai * 128 + m * 16) * D) + bj * 128;
                stg(U3, e * 2u, pack8(acc[ai][bj][m][0] * rs * g0 + s0, acc[ai][bj][m][1] * rs * g1 + s1)); } }
    }
};

struct Frame { LAS unsigned char* lds; int tid, lane, wave, gw, ngw; };

__device__ __forceinline__ void transpose_item(const float* W, int K, int Nsrc, bf16* WT, int dst_row0, int src_col0, int k0, LAS float* scr, int lane, float scale = 1.0f) {
    float tv[32];
    { const float* wp = W + (size_t)(k0 + (lane >> 5)) * Nsrc + src_col0 + (lane & 31);
#pragma unroll
      for (int i = 0; i < 32; ++i) tv[i] = __builtin_nontemporal_load(wp + (size_t)(2 * i) * Nsrc); }
#pragma unroll
    for (int i = 0; i < 32; ++i) scr[(2 * i + (lane >> 5)) * 33 + (lane & 31)] = tv[i] * scale;
    LDS_WAIT(); asm volatile("" ::: "memory");
    const int c = lane & 7;
#pragma unroll
    for (int j = 0; j < 4; ++j) { const int n = (lane >> 3) + 8 * j; const LAS float* s = scr + (8 * c) * 33 + n;
        u32x4 o; o.x = pk2(s[0 * 33], s[1 * 33]); o.y = pk2(s[2 * 33], s[3 * 33]); o.z = pk2(s[4 * 33], s[5 * 33]); o.w = pk2(s[6 * 33], s[7 * 33]);
        *(u32x4*)(WT + (size_t)(dst_row0 + n) * K + k0 + 8 * c) = o; }
    LDS_WAIT(); asm volatile("" ::: "memory");
}
__device__ __forceinline__ void conv_w13(const Frame& F, const float* w13, bf16* dst, int it0, int its) {
    LAS float* scr = (LAS float*)(F.lds + F.wave * 16384);
    for (int it = it0 + F.gw; it < it0 + its; it += F.ngw) { const int r = it, kb = r / 176, nb = r % 176, n0 = 32 * nb, j = n0 >> 8, s = (n0 >> 7) & 1, i0 = n0 & 127;
        transpose_item(w13, D, 2 * FF, dst, n0, s * FF + 128 * j + i0, 64 * kb, scr, F.lane, s ? 0.6931471805599453f : 1.4426950408889634f); }
}
__device__ __forceinline__ void conv_plain(const Frame& F, const float* W, int K, int N, bf16* dst, int it0, int its) {
    LAS float* scr = (LAS float*)(F.lds + F.wave * 16384);
    const int nblk = N / 32;
    for (int it = it0 + F.gw; it < it0 + its; it += F.ngw) { const int r = it, kb = r / nblk, nb = r % nblk;
        transpose_item(W, K, N, dst, 32 * nb, 32 * nb, 64 * kb, scr, F.lane); }
}
__device__ __forceinline__ int win_src_col(int n0) {
    if (n0 < ROW_K) return COL_Q + n0;
    if (n0 < ROW_V) return COL_K + (n0 - ROW_K);
    if (n0 < ROW_F) return COL_V + (n0 - ROW_V);
    if (n0 < ROW_O) return COL_F + (n0 - ROW_F);
    if (n0 < ROW_GF) return COL_O + (n0 - ROW_O);
    { const int r = n0 - ROW_GF, j = r >> 8, sg = (r >> 7) & 1, i0 = r & 127; return (sg ? COL_GM : COL_GF) + 128 * j + i0; }
}
__device__ __forceinline__ void conv_win(const Frame& F, const float* w_in, bf16* dst, int it0, int its) {
    LAS float* scr = (LAS float*)(F.lds + F.wave * 16384);
    constexpr int nblk = WIN_ROWS / 32;
    for (int it = it0 + F.gw; it < it0 + its; it += F.ngw) { const int r = it, kb = r / nblk, nb = r % nblk;
        transpose_item(w_in, D, INW, dst, 32 * nb, win_src_col(32 * nb), 64 * kb, scr, F.lane); }
}

__device__ __forceinline__ void ada_phase(const Frame& F, const Params& p) {
    LAS float* sc = (LAS float*)F.lds;
    LAS float* part = sc + 5 * 1024;
    float* mod = (float*)(p.ws + WS_MOD);
    for (int i = F.tid; i < 5 * 1024; i += NTHR) { const int v = i >> 10, k = i & 1023; const float cv = v < 4 ? p.c[v * 1024 + k] : p.c_ctx[k]; sc[i] = siluf_(cv); }
    __syncthreads();
    for (int tile = blockIdx.x; tile < 144; tile += gridDim.x) {
        const int col = 64 * tile + F.lane;
        float a0 = 0.f, a1 = 0.f, a2 = 0.f, a3 = 0.f, a4 = 0.f;
#pragma unroll 32
        for (int it = 0; it < 128; ++it) { const int k = 128 * F.wave + it; const float w = __builtin_nontemporal_load(p.w_ada + (size_t)k * 9216 + col);
            a0 += sc[k] * w; a1 += sc[1024 + k] * w; a2 += sc[2048 + k] * w; a3 += sc[3072 + k] * w; a4 += sc[4096 + k] * w; }
        { LAS float* pp = part + F.wave * 320 + F.lane; pp[0] = a0; pp[64] = a1; pp[128] = a2; pp[192] = a3; pp[256] = a4; }
        __syncthreads();
        if (F.tid < 320) { float s = 0.f;
#pragma unroll
            for (int w = 0; w < 8; ++w) s += part[w * 320 + F.tid];
            const int v = F.tid >> 6, cc = 64 * tile + (F.tid & 63); mod[v * 9216 + cc] = s + p.b_ada[cc]; }
        __syncthreads();
    }
}
__device__ __forceinline__ void wfour_phase(const Frame& F, const Params& p) {
    LAS float* ct = (LAS float*)(F.lds + 32768);
    if (F.tid < 128) ct[F.tid] = cosf((float)F.tid * (6.283185307179586f / 128.0f));
    __syncthreads();
    bf16* WF = (bf16*)(p.ws + WS_WFOUR);
    for (int task = blockIdx.x * NTHR + F.tid; task < 1024 * 128; task += gridDim.x * NTHR) {
        const int n = task & 1023, jg = task >> 10, i = jg >> 1, pq = jg & 1, f0 = 8 * i, g = f0 >> 7, ch0 = f0 & 127;
        float a[8];
#pragma unroll
        for (int t = 0; t < 8; ++t) a[t] = 0.f;
        const float* wp = p.w_four + (size_t)(g * 128) * 1024 + n;
        const int sh = pq ? 96 : 0;
#pragma unroll 8
        for (int k3 = 0; k3 < 128; ++k3) { const float w = wp[(size_t)k3 * 1024];
#pragma unroll
            for (int t = 0; t < 8; ++t) a[t] += ct[(k3 * (ch0 + t) + sh) & 127] * w; }
        const float scl = pq ? -0.08838834764831845f : 0.08838834764831845f;
        u32x4 o; o.x = pk2(a[0] * scl, a[1] * scl); o.y = pk2(a[2] * scl, a[3] * scl); o.z = pk2(a[4] * scl, a[5] * scl); o.w = pk2(a[6] * scl, a[7] * scl);
        *(u32x4*)(WF + (size_t)n * 1024 + 8 * jg) = o;
    }
    __syncthreads();
}

struct Row { f32x4 v[4]; };
__device__ __forceinline__ Row ld_row_f32(const float* r, int lane) { Row o; const f32x4* q = (const f32x4*)r + lane;
#pragma unroll
    for (int j = 0; j < 4; ++j) o.v[j] = q[64 * j]; return o; }
__device__ __forceinline__ Row ld_row_bf16(const bf16* r, int lane) { Row o; const u32x2* q = (const u32x2*)r + lane;
#pragma unroll
    for (int j = 0; j < 4; ++j) { const u32x2 w = q[64 * j]; o.v[j] = (f32x4){bflo(w.x), bfhi(w.x), bflo(w.y), bfhi(w.y)}; } return o; }
__device__ __forceinline__ void st_row_bf16(bf16* r, int lane, const Row& a) { u32x2* q = (u32x2*)r + lane;
#pragma unroll
    for (int j = 0; j < 4; ++j) { u32x2 w; w.x = pk2(a.v[j][0], a.v[j][1]); w.y = pk2(a.v[j][2], a.v[j][3]); q[64 * j] = w; } }
__device__ __forceinline__ void st_row_f32(float* r, int lane, const Row& a) { f32x4* q = (f32x4*)r + lane;
#pragma unroll
    for (int j = 0; j < 4; ++j) q[64 * j] = a.v[j]; }
__device__ __forceinline__ float row_rstd(const Row& a) { float s = 0.f;
#pragma unroll
    for (int j = 0; j < 4; ++j) s += (a.v[j][0] * a.v[j][0] + a.v[j][1] * a.v[j][1]) + (a.v[j][2] * a.v[j][2] + a.v[j][3] * a.v[j][3]);
    return rsqrtf(wave_sum(s) * (1.0f / 1024.0f) + EPS); }
__device__ __forceinline__ Row round_bf16(const Row& a) { Row o;
#pragma unroll
    for (int j = 0; j < 4; ++j)
#pragma unroll
        for (int e = 0; e < 4; ++e) o.v[j][e] = bf2f(f2bf(a.v[j][e]));
    return o; }
__device__ __forceinline__ Row modnorm2(const Row& h, const Row& gs, const Row& sh) {
    const float rs = row_rstd(h); Row o;
#pragma unroll
    for (int j = 0; j < 4; ++j) o.v[j] = h.v[j] * rs * gs.v[j] + sh.v[j];
    return o; }
__device__ __forceinline__ Row gated_norm2(const Row& y, const Row& gg) {
    const float rs = row_rstd(y); Row o;
#pragma unroll
    for (int j = 0; j < 4; ++j) o.v[j] = y.v[j] * rs * gg.v[j];
    return o; }
__device__ __forceinline__ Row rmul(const Row& a, const Row& b) { Row o;
#pragma unroll
    for (int j = 0; j < 4; ++j) o.v[j] = a.v[j] * b.v[j]; return o; }
__device__ __forceinline__ Row rmul1p(const Row& g, const Row& sc) { Row o;
#pragma unroll
    for (int j = 0; j < 4; ++j) o.v[j] = g.v[j] * (sc.v[j] + 1.0f); return o; }
__device__ __forceinline__ Row rscale(const Row& a, float c) { Row o;
#pragma unroll
    for (int j = 0; j < 4; ++j) o.v[j] = a.v[j] * c; return o; }
__device__ __forceinline__ Row radd(const Row& a, const Row& b) { Row o;
#pragma unroll
    for (int j = 0; j < 4; ++j) o.v[j] = a.v[j] + b.v[j]; return o; }
__device__ __forceinline__ const float* modp(const Params& p, int v, int i) { return (const float*)(p.ws + WS_MOD) + (size_t)v * 9216 + i * 1024; }
__device__ __forceinline__ const float* xrow(const Params& p, int r) { return r < TLAT ? p.x + (size_t)r * D : p.ctx + (size_t)(r - TLAT) * D; }
__device__ __forceinline__ int rowvar(int r) { return r < TLAT ? (r >> 12) : 4; }

__device__ __forceinline__ int row_of(const Frame& F, int it) {
    const int per = F.ngw >> 2, nl = (SEQ + per - 1) / per;
    if (it < nl) { const int rl = (F.gw >> 2) + it * per; if (rl < SEQ) return (F.gw & 3) * SEQ + rl; it = nl; }
    const int rc = F.gw + (it - nl) * F.ngw; return rc < TCTX ? TLAT + rc : -1;
}
__device__ __forceinline__ int lat_row(const Frame& F, int k) { const int rl = (F.gw >> 2) + k * (F.ngw >> 2); return rl < SEQ ? (F.gw & 3) * SEQ + rl : -1; }
__device__ __forceinline__ void phase_u1(const Frame& F, const Params& p) {
    bf16* U = (bf16*)(p.ws + WS_U);
    { const int v = F.gw & 3; const Row gs = rmul1p(ld_row_f32(p.norm_g, F.lane), ld_row_f32(modp(p, v, 1), F.lane)), sh = ld_row_f32(modp(p, v, 0), F.lane);
      for (int k0 = 0; lat_row(F, k0) >= 0; k0 += 4) { Row xr[4]; int rr[4];
#pragma unroll
          for (int q = 0; q < 4; ++q) { rr[q] = lat_row(F, k0 + q); if (rr[q] >= 0) xr[q] = ld_row_f32(p.x + (size_t)rr[q] * D, F.lane); }
#pragma unroll
          for (int q = 0; q < 4; ++q) if (rr[q] >= 0) st_row_bf16(U + (size_t)rr[q] * D, F.lane, modnorm2(xr[q], gs, sh)); } }
    { const Row gs = rmul1p(ld_row_f32(p.norm_g, F.lane), ld_row_f32(modp(p, 4, 1), F.lane)), sh = ld_row_f32(modp(p, 4, 0), F.lane);
      for (int rc = F.gw; rc < TCTX; rc += F.ngw) st_row_bf16(U + (size_t)(TLAT + rc) * D, F.lane, modnorm2(ld_row_f32(p.ctx + (size_t)rc * D, F.lane), gs, sh)); }
}
__device__ __forceinline__ void phase_post_ffn_a(const Frame& F, const Params& p) {
    bf16* U = (bf16*)(p.ws + WS_U); bf16* D1 = (bf16*)((unsigned char*)p.out + DO_D1); const bf16* Y1 = (const bf16*)(p.ws + WS_Y1);
    { const int v = F.gw & 3; const Row gg = rscale(rmul(ld_row_f32(p.norm_g + 1 * D, F.lane), ld_row_f32(modp(p, v, 2), F.lane)), 0.5f);
      const Row gs = rmul1p(ld_row_f32(p.norm_g + 2 * D, F.lane), ld_row_f32(modp(p, v, 4), F.lane)), sh = ld_row_f32(modp(p, v, 3), F.lane);
      for (int k0 = 0; lat_row(F, k0) >= 0; k0 += 4) { Row xr[4], yr[4]; int rr[4];
#pragma unroll
          for (int q = 0; q < 4; ++q) { rr[q] = lat_row(F, k0 + q); if (rr[q] >= 0) { yr[q] = ld_row_bf16(Y1 + (size_t)rr[q] * D, F.lane); xr[q] = ld_row_f32(p.x + (size_t)rr[q] * D, F.lane); } }
#pragma unroll
          for (int q = 0; q < 4; ++q) if (rr[q] >= 0) { const Row dl = round_bf16(gated_norm2(yr[q], gg)); st_row_bf16(D1 + (size_t)rr[q] * D, F.lane, dl);
              st_row_bf16(U + (size_t)rr[q] * D, F.lane, modnorm2(radd(xr[q], dl), gs, sh)); } } }
    { const Row gg = rscale(rmul(ld_row_f32(p.norm_g + 1 * D, F.lane), ld_row_f32(modp(p, 4, 2), F.lane)), 0.5f);
      const Row gs = rmul1p(ld_row_f32(p.norm_g + 2 * D, F.lane), ld_row_f32(modp(p, 4, 4), F.lane)), sh = ld_row_f32(modp(p, 4, 3), F.lane);
      for (int rc = F.gw; rc < TCTX; rc += F.ngw) { const float* yc = (const float*)(p.ws + WS_Y1C) + (size_t)rc * D;
          Row y = radd(radd(ld_row_f32(yc, F.lane), ld_row_f32(yc + (size_t)TCTX * D, F.lane)), radd(ld_row_f32(yc + (size_t)2 * TCTX * D, F.lane), ld_row_f32(yc + (size_t)3 * TCTX * D, F.lane)));
          y = radd(y, radd(radd(ld_row_f32(yc + (size_t)4 * TCTX * D, F.lane), ld_row_f32(yc + (size_t)5 * TCTX * D, F.lane)), radd(ld_row_f32(yc + (size_t)6 * TCTX * D, F.lane), ld_row_f32(yc + (size_t)7 * TCTX * D, F.lane))));
          const Row dl = round_bf16(gated_norm2(y, gg));
          st_row_bf16(U + (size_t)(TLAT + rc) * D, F.lane, modnorm2(radd(ld_row_f32(p.ctx + (size_t)rc * D, F.lane), dl), gs, sh)); } }
}
__device__ __forceinline__ void phase_u2_again(const Frame& F, const Params& p) {
    bf16* U = (bf16*)(p.ws + WS_U); const bf16* D1 = (const bf16*)((unsigned char*)p.out + DO_D1);
    const int v = F.gw & 3; const Row gs = rmul1p(ld_row_f32(p.norm_g + 2 * D, F.lane), ld_row_f32(modp(p, v, 4), F.lane)), sh = ld_row_f32(modp(p, v, 3), F.lane);
    for (int k0 = 0; lat_row(F, k0) >= 0; k0 += 4) { Row xr[4], dr[4]; int rr[4];
#pragma unroll
        for (int q = 0; q < 4; ++q) { rr[q] = lat_row(F, k0 + q); if (rr[q] >= 0) { xr[q] = ld_row_f32(p.x + (size_t)rr[q] * D, F.lane); dr[q] = ld_row_bf16(D1 + (size_t)rr[q] * D, F.lane); } }
#pragma unroll
        for (int q = 0; q < 4; ++q) if (rr[q] >= 0) st_row_bf16(U + (size_t)rr[q] * D, F.lane, modnorm2(radd(xr[q], dr[q]), gs, sh)); }
}

constexpr int SQK_STRIDE = 544;
constexpr int M1_SQ = 0, M1_SK = 128 * SQK_STRIDE, M1_TAB = 2 * 128 * SQK_STRIDE;
__device__ __forceinline__ float logsigmoidf_(float x) { return fminf(x, 0.f) - log1pf(__expf(-fabsf(x))); }

__device__ __forceinline__ void m1_item(const Frame& F, const Params& p, int bh, int cp) {
    const int b = bh >> 2, h = bh & 3; const bool is_lat = cp >= 2;
    const int seqlen = is_lat ? SEQ : CTXL, t0 = is_lat ? CH * (cp - 2) : CH * cp, rowbase = is_lat ? b * SEQ : TLAT + b * CTXL, pbase = CH * cp;
    const bf16* QPRE = (const bf16*)(p.ws + WS_QPRE); const bf16* KPRE = (const bf16*)(p.ws + WS_KPRE);
    LAS unsigned char* sQ = F.lds + M1_SQ; LAS unsigned char* sK = F.lds + M1_SK; LAS float* tab = (LAS float*)(F.lds + M1_TAB);
    const int lane = F.lane, w = F.wave, fr = lane & 15, fq = lane >> 4;
    {
        const int ch = 8 * (F.tid & 31), rb = 8 * (F.tid >> 5);
#define M1_CONV(SRC, CCH, SCALE, DST) do { \
        float w0[8], w1[8], w2[8], bb[8]; \
        _Pragma("unroll") for (int e = 0; e < 8; ++e) { const int cc = (CCH) + h * 256 + ch + e; w0[e] = p.conv_w[cc]; w1[e] = p.conv_w[2048 + cc]; w2[e] = p.conv_w[4096 + cc]; bb[e] = p.conv_b[cc]; } \
        u32x4 xr[10]; const bf16* base = (SRC) + (size_t)(rowbase + t0 + rb) * D + h * 256 + ch; \
        _Pragma("unroll") for (int i = 0; i < 10; ++i) { const int sq = t0 + rb + i - 1; xr[i] = (sq >= 0 && sq < seqlen) ? *(const u32x4*)(base + (ptrdiff_t)(i - 1) * D) : (u32x4){0u, 0u, 0u, 0u}; } \
        _Pragma("unroll") for (int i = 0; i < 8; ++i) { float o[8]; \
            _Pragma("unroll") for (int q = 0; q < 4; ++q) { \
                const float y0 = w0[2 * q] * bflo(xr[i][q]) + w1[2 * q] * bflo(xr[i + 1][q]) + w2[2 * q] * bflo(xr[i + 2][q]) + bb[2 * q]; \
                const float y1 = w0[2 * q + 1] * bfhi(xr[i][q]) + w1[2 * q + 1] * bfhi(xr[i + 1][q]) + w2[2 * q + 1] * bfhi(xr[i + 2][q]) + bb[2 * q + 1]; \
                o[2 * q] = siluf_(y0) * (SCALE); o[2 * q + 1] = siluf_(y1) * (SCALE); } \
            u32x4 wv; wv.x = pk2(o[0], o[1]); wv.y = pk2(o[2], o[3]); wv.z = pk2(o[4], o[5]); wv.w = pk2(o[6], o[7]); \
            *(LAS u32x4*)((DST) + (rb + i) * SQK_STRIDE + ch * 2) = wv; } } while (0)
        M1_CONV(KPRE, 1024, 0.0625f, sK);
        if (is_lat) M1_CONV(QPRE, 0, 1.0f, sQ);
#undef M1_CONV
    }
    if (w < 2) {
        const int dir = w; const float* G = (const float*)(p.ws + WS_GATES);
        const int i0 = 2 * lane, i1 = 2 * lane + 1, ta = dir ? 127 - i0 : i0, tb = dir ? 127 - i1 : i1;
        const float li0 = G[(size_t)(rowbase + t0 + ta) * 16 + dir * 8 + h], li1 = G[(size_t)(rowbase + t0 + tb) * 16 + dir * 8 + h];
        const float lf0 = logsigmoidf_(G[(size_t)(rowbase + t0 + ta) * 16 + dir * 8 + 4 + h]), lf1 = logsigmoidf_(G[(size_t)(rowbase + t0 + tb) * 16 + dir * 8 + 4 + h]);
        float ps = lf0 + lf1;
#pragma unroll
        for (int o = 1; o < 64; o <<= 1) { const float v = __shfl_up(ps, o); if (lane >= o) ps += v; }
        const float ex = ps - (lf0 + lf1), b0 = ex + lf0, b1 = ex + lf0 + lf1;
        const float r0 = li0 - b0, r1 = li1 - b1;
        float pm = fmaxf(r0, r1);
#pragma unroll
        for (int o = 1; o < 64; o <<= 1) { const float v = __shfl_up(pm, o); if (lane >= o) pm = fmaxf(pm, v); }
        const float pmex = __shfl_up(pm, 1); const float m0 = lane ? fmaxf(pmex, r0) : r0, m1 = pm;
        LAS float* tb_ = tab + dir * 384;
        tb_[ta] = b0; tb_[128 + ta] = r0; tb_[256 + ta] = m0; tb_[tb] = b1; tb_[128 + tb] = r1; tb_[256 + tb] = m1;
        float* TS = (float*)(p.ws + WS_TOKSC) + ((size_t)(dir * 16 + bh) * PLEN + pbase) * 4;
        TS[ta * 4 + 0] = b0; TS[ta * 4 + 1] = li0; TS[ta * 4 + 2] = b0 + m0; TS[tb * 4 + 0] = b1; TS[tb * 4 + 1] = li1; TS[tb * 4 + 2] = b1 + m1;
        if (lane == 63) { float* CS = (float*)(p.ws + WS_CHSC) + ((size_t)(dir * 16 + bh) * NCHK + cp) * 2; CS[0] = b1; CS[1] = b1 + m1; }
    }
    __syncthreads();
    {
        u32x4* KT = (u32x4*)(p.ws + WS_KT) + ((size_t)bh * NCHK + cp) * 4096;
        const int d = F.tid & 255, sgp = F.tid >> 8;
#pragma unroll
        for (int it = 0; it < 8; ++it) { const int sg = 2 * it + sgp; unsigned short e[8];
#pragma unroll
            for (int j = 0; j < 8; ++j) e[j] = *(const LAS unsigned short*)(sK + (8 * sg + j) * SQK_STRIDE + d * 2);
            u32x4 o; o.x = e[0] | ((unsigned)e[1] << 16); o.y = e[2] | ((unsigned)e[3] << 16); o.z = e[4] | ((unsigned)e[5] << 16); o.w = e[6] | ((unsigned)e[7] << 16);
            KT[((((d >> 5) * 2 + ((d >> 4) & 1)) * 4 + (sg >> 2)) * 64) + (sg & 3) * 16 + (d & 15)] = o; }
        if (is_lat) { u32x4* Q = (u32x4*)(p.ws + WS_Q) + ((size_t)bh * 32 + (cp - 2)) * 4096;
#pragma unroll
            for (int it = 0; it < 8; ++it) { const int piece = F.tid + 512 * it, row = piece >> 5, c16 = piece & 31;
                Q[((row >> 4) * 8 + (c16 >> 2)) * 64 + (c16 & 3) * 16 + (row & 15)] = *(const LAS u32x4*)(sQ + row * SQK_STRIDE + c16 * 16); } }
    }
    if (is_lat) {
        bf16x8 bq[8];
#pragma unroll
        for (int k = 0; k < 8; ++k) bq[k] = *(const LAS bf16x8*)(sQ + (16 * w + fr) * SQK_STRIDE + (32 * k + 8 * fq) * 2);
        f32x4 acc[8];
#pragma unroll
        for (int mt = 0; mt < 8; ++mt) { acc[mt] = (f32x4){0.f, 0.f, 0.f, 0.f};
#pragma unroll
            for (int k = 0; k < 8; ++k) { const bf16x8 a = *(const LAS bf16x8*)(sK + (16 * mt + fr) * SQK_STRIDE + (32 * k + 8 * fq) * 2);
                acc[mt] = __builtin_amdgcn_mfma_f32_16x16x32_bf16(a, bq[k], acc[mt], 0, 0, 0); } }
        const int t = 16 * w + fr, c = cp - 2;
        bf16* P = (bf16*)((unsigned char*)p.out + DO_P);
#pragma unroll
        for (int dir = 0; dir < 2; ++dir) {
            const LAS float* tb_ = tab + dir * 384; const float mx = tb_[256 + t]; float dsum = 0.f;
            unsigned char* pblk = (unsigned char*)(P + ((size_t)(dir * 16 + bh) * 32 + c) * 128 * 128);
#pragma unroll
            for (int mt = 0; mt < 8; ++mt) { const int s0 = 16 * mt + 4 * fq; const f32x4 rs = *(const LAS f32x4*)(tb_ + 128 + s0); float pv[4];
#pragma unroll
                for (int r = 0; r < 4; ++r) { const int s = s0 + r; const bool valid = dir ? (s >= t) : (s <= t);
                    const float wgt = valid ? __expf(fminf(rs[r] - mx, 0.f)) : 0.f; pv[r] = bf2f(f2bf(acc[mt][r] * wgt)); dsum += pv[r]; }
                u32x2 o; o.x = pk2(pv[0], pv[1]); o.y = pk2(pv[2], pv[3]); const int s8 = 2 * mt + (fq >> 1);
                *(u32x2*)(pblk + ((w * 4 + (s8 >> 2)) * 64 + (s8 & 3) * 16 + fr) * 16 + (fq & 1) * 8) = o; }
            dsum += __shfl_xor(dsum, 16); dsum += __shfl_xor(dsum, 32);
            if (fq == 0) ((float*)(p.ws + WS_TOKSC))[((size_t)(dir * 16 + bh) * PLEN + pbase + t) * 4 + 3] = dsum;
        }
    }
    __syncthreads();
}

constexpr int FO_TAB = 131072;
__device__ __forceinline__ int fo_off(int R, int r) { return R * 128 + ((((r >> 3) ^ ((R >> 1) & 7))) << 4) + (r & 7) * 2; }
__device__ __forceinline__ void fourier_item(const Frame& F, const Params& p, int item) {
    const int b = item >> 6, i = item & 63; const int lane = F.lane, w = F.wave, fr = lane & 15, fq = lane >> 4;
    LAS unsigned char* sPQ = F.lds; LAS float* ct = (LAS float*)(F.lds + FO_TAB);
    if (F.tid < 64) ct[F.tid] = cosf((float)F.tid * (6.283185307179586f / 64.0f));
    __syncthreads();
    const bf16* XT = (const bf16*)(p.ws + WS_XFT);
    {
        const bf16* xrow_ = XT + (size_t)(8 * i + w) * TLAT + b * SEQ;
        bf16x8 xv[4][2];
#pragma unroll
        for (int nt = 0; nt < 4; ++nt) { const int r = 16 * nt + fr; xv[nt][0] = *(const bf16x8*)(xrow_ + r * 64 + 8 * fq); xv[nt][1] = *(const bf16x8*)(xrow_ + r * 64 + 32 + 8 * fq); }
#pragma unroll 1
        for (int mt = 0; mt < 8; ++mt) {
            bf16x8 WA[2];
#pragma unroll
            for (int k = 0; k < 2; ++k) { const int kc = (16 * mt + fr) & 63, sh = (mt >> 2) * 48; bf16x8 v;
#pragma unroll
                for (int j = 0; j < 8; ++j) { const int c = 32 * k + 8 * fq + j; v[j] = (short)f2bf(ct[(kc * c + sh) & 63]); }
                WA[k] = v; }
#pragma unroll
            for (int nt = 0; nt < 4; ++nt) { const int r = 16 * nt + fr; f32x4 a = (f32x4){0.f, 0.f, 0.f, 0.f};
                a = __builtin_amdgcn_mfma_f32_16x16x32_bf16(WA[0], xv[nt][0], a, 0, 0, 0); a = __builtin_amdgcn_mfma_f32_16x16x32_bf16(WA[1], xv[nt][1], a, 0, 0, 0);
#pragma unroll
                for (int rg = 0; rg < 4; ++rg) { const int kcp = 16 * mt + 4 * fq + rg; *(LAS unsigned short*)(sPQ + fo_off(kcp * 8 + w, r)) = (unsigned short)f2bf(a[rg]); } } }
    }
    __syncthreads();
    {
        bf16x8 WB[4];
        const int kr = (16 * w + fr) & 63, half = w >> 2;
#pragma unroll
        for (int ks = 0; ks < 4; ++ks) { const int pq = ks >> 1; unsigned short e[8];
#pragma unroll
            for (int j = 0; j < 8; ++j) { const int r = 32 * (ks & 1) + 8 * fq + j;
                float v; if (half == pq) v = ct[(kr * r) & 63]; else { v = ct[(kr * r + 48) & 63]; if (half == 0) v = -v; }
                e[j] = (unsigned short)f2bf(v * 0.015625f); }
            bf16x8 v; v[0] = (short)e[0]; v[1] = (short)e[1]; v[2] = (short)e[2]; v[3] = (short)e[3]; v[4] = (short)e[4]; v[5] = (short)e[5]; v[6] = (short)e[6]; v[7] = (short)e[7]; WB[ks] = v; }
        bf16* UF = (bf16*)(p.ws + WS_UF) + (size_t)(b * SEQ + (16 * (w & 3) + fr) * 64) * D + 16 * i + 8 * half + 4 * (fq & 1);
#pragma unroll 2
        for (int nt = 0; nt < 32; ++nt) { f32x4 a = (f32x4){0.f, 0.f, 0.f, 0.f};
#pragma unroll
            for (int ks = 0; ks < 4; ++ks) { const int R = (ks >> 1) * 512 + 16 * nt + fr, q = 4 * (ks & 1) + fq;
                const bf16x8 bb = *(const LAS bf16x8*)(sPQ + R * 128 + ((q ^ ((R >> 1) & 7)) << 4));
                a = __builtin_amdgcn_mfma_f32_16x16x32_bf16(bb, WB[ks], a, 0, 0, 0); }
            u32x2 o; o.x = pk2(a[0], a[1]); o.y = pk2(a[2], a[3]);
            *(u32x2*)(UF + (size_t)(2 * nt + (fq >> 1)) * D) = o; }
    }
    __syncthreads();
}

constexpr int M2_CT = 0, M2_CTB = 48 * 544, M2_VT = 2 * M2_CTB, M2_VTB = 32 * 288, M2_VW = M2_VT + 2 * M2_VTB, M2_VWB = 48 * 288, M2_TAB = M2_VW + 2 * M2_VWB, M2_TABB = 5 * 512, M2_SC = M2_TAB + 3 * M2_TABB, M2_HS = M2_SC + 1024;
struct M2Step { int cp, is_lat, p0, tl0, tokrow0; };
__device__ __forceinline__ M2Step m2_step(int dir, int b, int j) {
    M2Step s; const int jj = j < NCHK ? j : NCHK - 1;
    s.cp = dir ? (jj == 0 ? 1 : (jj == 1 ? 0 : 35 - jj)) : jj; s.is_lat = s.cp >= 2; s.p0 = CH * s.cp; s.tl0 = s.is_lat ? CH * (s.cp - 2) : 0;
    s.tokrow0 = s.is_lat ? b * SEQ + s.tl0 : TLAT + b * CTXL + CH * s.cp; return s;
}
__device__ __forceinline__ void m2_stream(const Frame& F, const Params& p, int sid) {
    const int x = sid & 7, jj_ = sid >> 3, gl = jj_ >> 3, slice = jj_ & 7, g = x + 8 * gl, dir = g >> 4, bh = g & 15, b = bh >> 2, h = bh & 3;
    int tid = F.tid; asm volatile("" : "+v"(tid)); const int lane = tid & 63, w = F.wave, fr = lane & 15, fq = lane >> 4, wa = w & 3, tr = tid & 255;
    const bool roleA = w < 4;
    LAS unsigned char* L = F.lds;
    LAS float* smst = (LAS float*)(L + M2_SC); LAS float* smnw = smst + 34; LAS float* sdec = smst + 68; LAS float* scs = smst + 102;
    const float* TS = (const float*)(p.ws + WS_TOKSC) + (size_t)(dir * 16 + bh) * PLEN * 4;
    const float* CS = (const float*)(p.ws + WS_CHSC) + (size_t)(dir * 16 + bh) * NCHK * 2;
    const bf16* VT = (const bf16*)(p.ws + WS_VT) + (size_t)(h * 256 + slice * 32 + (tr >> 4)) * MTOK + 8 * (tr & 15);
    const bf16x8* KT = (const bf16x8*)(p.ws + WS_KT) + (size_t)bh * NCHK * 4096 + wa * 1024 + lane;
    const bf16x8* Q = (const bf16x8*)(p.ws + WS_Q) + (size_t)bh * 32 * 4096 + wa * 1024 + lane;
    const bf16x8* P = (const bf16x8*)((const unsigned char*)p.out + DO_P) + (size_t)(dir * 16 + bh) * 32 * 2048 + wa * 512 + lane;
    bf16* H = (bf16*)(p.ws + (dir ? WS_HB : WS_HF)) + (size_t)(b * SEQ) * D + h * 256 + slice * 32;
    for (int i = tid; i < M2_TAB / 4; i += NTHR) ((LAS unsigned*)L)[i] = 0u;
    if (tid < 2 * NCHK) scs[tid] = CS[tid];
    __syncthreads();
    if (tid == 0) { float m = 0.f;
        for (int j = 0; j < NCHK; ++j) { const M2Step st = m2_step(dir, b, j); const float bL = scs[st.cp * 2], gmax = scs[st.cp * 2 + 1];
            const float mn = fmaxf(bL + m, gmax); smst[j] = m; smnw[j] = mn; sdec[j] = __expf(bL + m - mn); m = mn; } }
    __syncthreads();
#define M2_TABLES(jj, stp, sc) do { if (tr < 128 && (jj) < NCHK) { LAS float* tb_ = (LAS float*)(L + M2_TAB + ((jj) % 3) * M2_TABB); const float bL = scs[(stp).cp * 2], mst_ = smst[jj], mnw_ = smnw[jj]; \
        tb_[512 + tr] = __expf(fminf(bL - (sc)[0] + (sc)[1] - mnw_, 0.f)); \
        const float mt_ = fmaxf((sc)[0] + mst_, (sc)[2]); const float c_ = __expf((sc)[2] - mt_); \
        *(LAS f32x4*)(tb_ + 4 * tr) = (f32x4){__expf((sc)[0] + mst_ - mt_), c_, c_ * (sc)[3], __expf(-mt_)}; } } while (0)
#define M2_VSTAGE(jj, va, vb) do { if ((jj) < NCHK) { const LAS float* tb_ = (const LAS float*)(L + M2_TAB + ((jj) % 3) * M2_TABB); const int e = tr >> 4, sg = tr & 15; \
        const f32x4 wa_ = *(const LAS f32x4*)(tb_ + 512 + 8 * sg), wb_ = *(const LAS f32x4*)(tb_ + 516 + 8 * sg); u32x4 o_; \
        *(LAS u32x4*)(L + M2_VT + ((jj) & 1) * M2_VTB + e * 288 + sg * 16) = (va); *(LAS u32x4*)(L + M2_VT + ((jj) & 1) * M2_VTB + (e + 16) * 288 + sg * 16) = (vb); \
        o_[0] = pk2(bflo((va)[0]) * wa_[0], bfhi((va)[0]) * wa_[1]); o_[1] = pk2(bflo((va)[1]) * wa_[2], bfhi((va)[1]) * wa_[3]); o_[2] = pk2(bflo((va)[2]) * wb_[0], bfhi((va)[2]) * wb_[1]); o_[3] = pk2(bflo((va)[3]) * wb_[2], bfhi((va)[3]) * wb_[3]); \
        *(LAS u32x4*)(L + M2_VW + ((jj) & 1) * M2_VWB + e * 288 + sg * 16) = o_; \
        o_[0] = pk2(bflo((vb)[0]) * wa_[0], bfhi((vb)[0]) * wa_[1]); o_[1] = pk2(bflo((vb)[1]) * wa_[2], bfhi((vb)[1]) * wa_[3]); o_[2] = pk2(bflo((vb)[2]) * wb_[0], bfhi((vb)[2]) * wb_[1]); o_[3] = pk2(bflo((vb)[3]) * wb_[2], bfhi((vb)[3]) * wb_[3]); \
        *(LAS u32x4*)(L + M2_VW + ((jj) & 1) * M2_VWB + (e + 16) * 288 + sg * 16) = o_; \
        if (tr < 16) { u32x4 o2; o2[0] = pk2(wa_[0], wa_[1]); o2[1] = pk2(wa_[2], wa_[3]); o2[2] = pk2(wb_[0], wb_[1]); o2[3] = pk2(wb_[2], wb_[3]); \
            *(LAS u32x4*)(L + M2_VW + ((jj) & 1) * M2_VWB + 32 * 288 + tr * 16) = o2; } } } while (0)
#define M2_LDQ(QQ, st) do { const bf16x8* q_ = Q + (size_t)((st).is_lat ? (st).cp - 2 : 0) * 4096; _Pragma("unroll") for (int k = 0; k < 8; ++k) { (QQ)[0][k] = q_[k * 64]; (QQ)[1][k] = q_[(8 + k) * 64]; } } while (0)
#define M2_LDP(st) do { const bf16x8* p_ = P + (size_t)((st).is_lat ? (st).cp - 2 : 0) * 2048; _Pragma("unroll") for (int k = 0; k < 4; ++k) { pa[0][k] = p_[k * 64]; pa[1][k] = p_[(4 + k) * 64]; } } while (0)
#define M2_LDK(KK, st) do { const bf16x8* k_ = KT + (size_t)(st).cp * 4096; _Pragma("unroll") for (int mt = 0; mt < 4; ++mt) _Pragma("unroll") for (int k = 0; k < 4; ++k) (KK)[mt][k] = k_[(mt * 4 + k) * 64]; } while (0)
    const M2Step s0 = m2_step(dir, b, 0), s1 = m2_step(dir, b, 1);
    if (!roleA) { const f32x4 t0 = *(const f32x4*)(TS + (size_t)(s0.p0 + (tr & 127)) * 4), t1 = *(const f32x4*)(TS + (size_t)(s1.p0 + (tr & 127)) * 4);
        M2_TABLES(0, s0, t0); M2_TABLES(1, s1, t1); }
    __syncthreads();
    if (!roleA) { const u32x4 v0a = *(const u32x4*)(VT + s0.tokrow0), v0b = *(const u32x4*)(VT + (size_t)16 * MTOK + s0.tokrow0); M2_VSTAGE(0, v0a, v0b); }
    if (roleA) {
        bf16x8 qa[2][2][8], pa[2][4];
        M2_LDQ(qa[0], s0); M2_LDP(s0);
        __syncthreads();
        for (int jj = 0; jj < NCHK; jj += 2) {
#pragma unroll
          for (int u = 0; u < 2; ++u) { const int j = jj + u;
            const M2Step sj = m2_step(dir, b, j), sn = m2_step(dir, b, j + 1);
            M2_LDQ(qa[u ^ 1], sn);
            if (j > 0) { const M2Step sp = m2_step(dir, b, j - 1);
                if (sp.is_lat) {
#pragma unroll
                    for (int i2 = 0; i2 < 2; ++i2) { const int pc = tr + 256 * i2; const u32x4 hv = *(const LAS u32x4*)(L + M2_HS + ((j - 1) & 1) * 8192 + pc * 16);
                        *(u32x4*)(H + (size_t)(sp.tl0 + (pc >> 2)) * D + (pc & 3) * 8) = hv; } } }
            if (sj.is_lat) {
                const LAS unsigned char* sCT = L + M2_CT + (j & 1) * M2_CTB; const LAS unsigned char* sVT = L + M2_VT + (j & 1) * M2_VTB;
                const LAS float* tb = (const LAS float*)(L + M2_TAB + (j % 3) * M2_TABB);
                f32x4 aI[2][3], aA[2][2];
#pragma unroll
                for (int mt = 0; mt < 2; ++mt) {
#pragma unroll
                    for (int nt = 0; nt < 3; ++nt) aI[mt][nt] = (f32x4){0.f, 0.f, 0.f, 0.f};
                    aA[mt][0] = (f32x4){0.f, 0.f, 0.f, 0.f}; aA[mt][1] = (f32x4){0.f, 0.f, 0.f, 0.f}; }
#pragma unroll
                for (int k = 0; k < 8; ++k)
#pragma unroll
                    for (int nt = 0; nt < 3; ++nt) { const bf16x8 bb = *(const LAS bf16x8*)(sCT + (16 * nt + fr) * 544 + (32 * k + 8 * fq) * 2);
                        aI[0][nt] = __builtin_amdgcn_mfma_f32_16x16x32_bf16(qa[u][0][k], bb, aI[0][nt], 0, 0, 0);
                        aI[1][nt] = __builtin_amdgcn_mfma_f32_16x16x32_bf16(qa[u][1][k], bb, aI[1][nt], 0, 0, 0); }
#pragma unroll
                for (int k = 0; k < 4; ++k)
#pragma unroll
                    for (int nt = 0; nt < 2; ++nt) { const bf16x8 bb = *(const LAS bf16x8*)(sVT + (16 * nt + fr) * 288 + (32 * k + 8 * fq) * 2);
                        aA[0][nt] = __builtin_amdgcn_mfma_f32_16x16x32_bf16(pa[0][k], bb, aA[0][nt], 0, 0, 0);
                        aA[1][nt] = __builtin_amdgcn_mfma_f32_16x16x32_bf16(pa[1][k], bb, aA[1][nt], 0, 0, 0); }
                M2_LDP(sn);
                LAS unsigned short* sH = (LAS unsigned short*)(L + M2_HS + (j & 1) * 8192);
#pragma unroll
                for (int mt = 0; mt < 2; ++mt)
#pragma unroll
                    for (int rg = 0; rg < 4; ++rg) { const int t = 32 * wa + 16 * mt + 4 * fq + rg;
                        const float qn_ = __shfl(aI[mt][2][rg], lane & 48);
                        const f32x4 tv = *(const LAS f32x4*)(tb + 4 * t);
                        const float inv = __builtin_amdgcn_rcpf(fmaxf(fabsf(tv[0] * qn_ + tv[2]), tv[3]));
                        const unsigned hp = pk2((tv[0] * aI[mt][0][rg] + tv[1] * aA[mt][0][rg]) * inv, (tv[0] * aI[mt][1][rg] + tv[1] * aA[mt][1][rg]) * inv);
                        sH[t * 32 + fr] = (unsigned short)hp; sH[t * 32 + 16 + fr] = (unsigned short)(hp >> 16); }
            } else { M2_LDP(sn); }
            __syncthreads();
          }
        }
        { const M2Step sp = m2_step(dir, b, NCHK - 1);
          if (sp.is_lat) {
#pragma unroll
            for (int i2 = 0; i2 < 2; ++i2) { const int pc = tr + 256 * i2; const u32x4 hv = *(const LAS u32x4*)(L + M2_HS + ((NCHK - 1) & 1) * 8192 + pc * 16);
                *(u32x4*)(H + (size_t)(sp.tl0 + (pc >> 2)) * D + (pc & 3) * 8) = hv; } } }
    } else {
        bf16x8 ka[2][4][4];
        f32x4 accC[4][3];
#pragma unroll
        for (int mt = 0; mt < 4; ++mt)
#pragma unroll
            for (int nt = 0; nt < 3; ++nt) accC[mt][nt] = (f32x4){0.f, 0.f, 0.f, 0.f};
        M2_LDK(ka[0], s0);
        u32x4 vna = *(const u32x4*)(VT + s1.tokrow0), vnb = *(const u32x4*)(VT + (size_t)16 * MTOK + s1.tokrow0);
        f32x4 tn2 = *(const f32x4*)(TS + (size_t)(m2_step(dir, b, 2).p0 + (tr & 127)) * 4);
        __syncthreads();
        for (int jj = 0; jj < NCHK; jj += 2) {
#pragma unroll
          for (int u = 0; u < 2; ++u) { const int j = jj + u;
            const M2Step sn = m2_step(dir, b, j + 1), sn2 = m2_step(dir, b, j + 2);
            M2_LDK(ka[u ^ 1], sn);
            const LAS unsigned char* sVW = L + M2_VW + (j & 1) * M2_VWB; const float dec = sdec[j];
            const u32x4 vxa = *(const u32x4*)(VT + sn2.tokrow0), vxb = *(const u32x4*)(VT + (size_t)16 * MTOK + sn2.tokrow0);
            const f32x4 tn3 = *(const f32x4*)(TS + (size_t)(m2_step(dir, b, j + 3).p0 + (tr & 127)) * 4);
#pragma unroll
            for (int mt = 0; mt < 4; ++mt)
#pragma unroll
                for (int nt = 0; nt < 3; ++nt) accC[mt][nt] = accC[mt][nt] * dec;
#pragma unroll
            for (int k = 0; k < 4; ++k)
#pragma unroll
                for (int nt = 0; nt < 3; ++nt) { const bf16x8 bb = *(const LAS bf16x8*)(sVW + (16 * nt + fr) * 288 + (32 * k + 8 * fq) * 2);
#pragma unroll
                    for (int mt = 0; mt < 4; ++mt) accC[mt][nt] = __builtin_amdgcn_mfma_f32_16x16x32_bf16(ka[u][mt][k], bb, accC[mt][nt], 0, 0, 0); }
            { LAS unsigned char* dCT = L + M2_CT + ((j + 1) & 1) * M2_CTB;
#pragma unroll
              for (int mt = 0; mt < 4; ++mt)
#pragma unroll
                for (int nt = 0; nt < 3; ++nt) { u32x2 o; o.x = pk2(accC[mt][nt][0], accC[mt][nt][1]); o.y = pk2(accC[mt][nt][2], accC[mt][nt][3]);
                    *(LAS u32x2*)(dCT + (16 * nt + fr) * 544 + (64 * wa + 16 * mt + 4 * fq) * 2) = o; } }
            M2_VSTAGE(j + 1, vna, vnb);
            M2_TABLES(j + 2, sn2, tn2);
            vna = vxa; vnb = vxb; tn2 = tn3;
            __syncthreads();
          }
        }
    }
    __syncthreads();
#undef M2_LDQ
#undef M2_LDP
#undef M2_LDK
#undef M2_TABLES
#undef M2_VSTAGE
}

#define XB_TMO      128
#define XB_XCNT(j)  (256  + 64 * (j))
#define XB_XSUB(j)  (1280 + 64 * (j))
#define XB_XGEN(j)  (2304 + 64 * (j))
#define XB_TOP      3328
#define XB_TOPGEN   3392
#define XB_SPIN_CAP (1u << 22)
__device__ __forceinline__ unsigned xb_ld(unsigned* p)              { return __hip_atomic_load(p, __ATOMIC_RELAXED, __HIP_MEMORY_SCOPE_AGENT); }
__device__ __forceinline__ unsigned xb_add(unsigned* p, unsigned v) { return __hip_atomic_fetch_add(p, v, __ATOMIC_RELAXED, __HIP_MEMORY_SCOPE_AGENT); }
__device__ __forceinline__ unsigned xb_xcc_id() { return (unsigned)__builtin_amdgcn_s_getreg((3 << 11) | 20) & 0xFu; }
#define XB_SPIN(cond, bar) do { unsigned _sp = 0; while (cond) { __builtin_amdgcn_s_sleep(1); \
    if ((++_sp & 255u) == 0u) { if (xb_ld(&(bar)[XB_TMO])) break; if (_sp > XB_SPIN_CAP) { atomicAdd(&(bar)[XB_TMO], 1u); break; } } } } while (0)
struct XcdBarrier { unsigned* bar; unsigned x; volatile LAS unsigned* st; };
__device__ __forceinline__ XcdBarrier xcd_barrier_post(unsigned* bar, volatile LAS unsigned* st) {
    XcdBarrier b; b.bar = bar; b.x = xb_xcc_id(); b.st = st;
    if (threadIdx.x == 0) (void)xb_add(&bar[XB_XCNT(b.x)], 1u);
    return b;
}
__device__ __forceinline__ void xcd_barrier_complete(unsigned* bar, unsigned x, unsigned& nloc, unsigned& nx) {
    const unsigned G = gridDim.x * gridDim.y * gridDim.z;
    unsigned sum, cnt, mine, sp = 0u;
    for (;;) {
        sum = 0u; cnt = 0u; mine = 0u;
#pragma unroll
        for (unsigned j = 0; j < 16; ++j) { const unsigned c = xb_ld(&bar[XB_XCNT(j)]); sum += c; cnt += (c > 0u) ? 1u : 0u; mine = (j == x) ? c : mine; }
        if (sum == G) break;
        __builtin_amdgcn_s_sleep(1);
        if ((++sp & 255u) == 0u) { if (xb_ld(&bar[XB_TMO])) break; if (sp > XB_SPIN_CAP) { atomicAdd(&bar[XB_TMO], 1u); break; } }
    }
    nloc = mine > 0u ? mine : 1u; nx = cnt > 0u ? cnt : 1u;
}
__device__ __forceinline__ void xcd_barrier(const XcdBarrier& b) {
    asm volatile("s_waitcnt vmcnt(0)" ::: "memory");
    __syncthreads();
    if (threadIdx.x == 0) {
        unsigned* bar = b.bar;
        __builtin_amdgcn_s_waitcnt(0);
        unsigned nloc = b.st[0], nx = b.st[1];
        if (nloc == 0u) { xcd_barrier_complete(bar, b.x, nloc, nx); b.st[0] = nloc; b.st[1] = nx; }
        const unsigned old = xb_add(&bar[XB_XSUB(b.x)], 1u);
        const unsigned gen = old / nloc;
        if (old + 1u == (gen + 1u) * nloc) {
            __builtin_amdgcn_fence(__ATOMIC_RELEASE, "agent");
            asm volatile("s_waitcnt vmcnt(0)" ::: "memory");
            const unsigned og = xb_add(&bar[XB_TOP], 1u);
            const unsigned tg = og / nx;
            if (og + 1u == (tg + 1u) * nx) xb_add(&bar[XB_TOPGEN], 1u);
            else XB_SPIN(xb_ld(&bar[XB_TOPGEN]) == tg, bar);
            __builtin_amdgcn_fence(__ATOMIC_ACQUIRE, "agent");
            xb_add(&bar[XB_XGEN(b.x)], 1u);
            asm volatile("s_waitcnt vmcnt(0)" ::: "memory");
        } else {
            XB_SPIN(xb_ld(&bar[XB_XGEN(b.x)]) == gen, bar);
            __builtin_amdgcn_fence(__ATOMIC_ACQUIRE, "agent");
            asm volatile("s_waitcnt vmcnt(0)" ::: "memory");
        }
    }
    __syncthreads();
}

__device__ __forceinline__ pg8::Seg mkseg(const void* A0, const void* B0, int nM, int nN, int kind, int ksplit = 1) { pg8::Seg s; s.A0 = (const char*)A0; s.B0 = (const char*)B0; s.nM = nM; s.nN = nN; s.kind = kind; s.ksplit = ksplit; return s; }
__device__ __forceinline__ pg8::Sched mksched(int K) { pg8::Sched S; S.s[0] = S.s[1] = S.s[2] = S.s[3] = mkseg(nullptr, nullptr, 0, 0, 0); S.G = gridDim.x; S.c = blockIdx.x; S.tstep = (size_t)256 * K * 2; S.ntk = K / 64; return S; }

__global__ void __launch_bounds__(NTHR) mega_fwd(Params p) {
    extern __shared__ __attribute__((aligned(16))) unsigned char lds_raw[];
    Frame F;
#define REFRAME() do { int t_ = threadIdx.x; asm volatile("" : "+v"(t_)); F.lds = (LAS unsigned char*)lds_raw; F.tid = t_; F.lane = t_ & 63; F.wave = __builtin_amdgcn_readfirstlane(t_ >> 6); \
        F.gw = blockIdx.x * NWAVE + F.wave; F.ngw = gridDim.x * NWAVE; } while (0)
    REFRAME();
    unsigned char* ws = p.ws; unsigned char* dout = (unsigned char*)p.out;
    volatile LAS unsigned* bst = (volatile LAS unsigned*)(F.lds + LDS_BYTES - 16);
    if (F.tid < 4) bst[F.tid] = 0u;
    __syncthreads();
    const XcdBarrier gbar = xcd_barrier_post((unsigned*)(ws + WS_BAR), bst);
#define GSYNC() do { xcd_barrier(gbar); REFRAME(); } while (0)

    ada_phase(F, p);
    wfour_phase(F, p);
    {
        constexpr int I13 = 16 * 176, I2 = 44 * 32, IIN = 16 * (WIN_ROWS / 32), ISQ = 16 * 32;
        Frame F2 = F; const bool extra = gridDim.x == 256 && blockIdx.x >= 144; F2.gw = (blockIdx.x - 144) * NWAVE + F.wave; F2.ngw = 112 * NWAVE;
#define CONV_SPLIT(CALL_A, CALL_B) do { CALL_A; if (gridDim.x != 256) { Frame F2 = F; CALL_B; } else if (extra) { CALL_B; } } while (0)
        { constexpr int A = I13 * 55 / 100; CONV_SPLIT(conv_w13(F, p.w13_a, (bf16*)(ws + WS_W13), 0, A), conv_w13(F2, p.w13_a, (bf16*)(ws + WS_W13), A, I13 - A)); }
        { constexpr int A = I2 * 55 / 100; CONV_SPLIT(conv_plain(F, p.w2_a, FF, D, (bf16*)(ws + WS_W2), 0, A), conv_plain(F2, p.w2_a, FF, D, (bf16*)(ws + WS_W2), A, I2 - A)); }
        { constexpr int A = IIN * 55 / 100; CONV_SPLIT(conv_win(F, p.w_in, (bf16*)(ws + WS_WIN), 0, A), conv_win(F2, p.w_in, (bf16*)(ws + WS_WIN), A, IIN - A)); }
        { constexpr int A = ISQ * 55 / 100; CONV_SPLIT(conv_plain(F, p.w_mproj, D, D, (bf16*)(ws + WS_WMPROJ), 0, A), conv_plain(F2, p.w_mproj, D, D, (bf16*)(ws + WS_WMPROJ), A, ISQ - A));
          CONV_SPLIT(conv_plain(F, p.w_out, D, D, (bf16*)(ws + WS_WOUT), 0, A), conv_plain(F2, p.w_out, D, D, (bf16*)(ws + WS_WOUT), A, ISQ - A)); }
#undef CONV_SPLIT
        { LAS float* scr = (LAS float*)(F.lds + F.wave * 16384);
          for (int it = F.gw; it < 16; it += F.ngw) transpose_item(p.w_in, D, INW, (bf16*)(ws + WS_WG), 0, COL_GATES, 64 * it, scr, F.lane);
          u32x4* z = (u32x4*)(ws + WS_WG + 32 * D * 2); for (int i = blockIdx.x * NTHR + F.tid; i < 224 * D * 2 / 16; i += gridDim.x * NTHR) z[i] = (u32x4){0u, 0u, 0u, 0u}; }
    }
    GSYNC();
    phase_u1(F, p);
    GSYNC();
    { pg8::Sched S = mksched(D); S.s[0] = mkseg(ws + WS_U, ws + WS_W13, MTOK / 256, 22, 0); EpiSwiglu E{(bf16*)(ws + WS_ACT)}; pg8::gemm_phase(F.lds, D, S, E); }
    GSYNC();
    { pg8::Sched S = mksched(FF); S.s[0] = mkseg(ws + WS_ACT, ws + WS_W2, TLAT / 256, 4, 0); S.s[1] = mkseg(ws + WS_ACT + (size_t)TLAT * FF * 2, ws + WS_W2, TCTX / 256, 4, 1, 8);
      EpiDownA E{(bf16*)(ws + WS_Y1), (float*)(ws + WS_Y1C)}; pg8::gemm_phase(F.lds, FF, S, E); }
    GSYNC();
    phase_post_ffn_a(F, p);
    GSYNC();
    { pg8::Sched S = mksched(D); const unsigned char* W = ws + WS_WIN;
      S.s[0] = mkseg(ws + WS_U, W + (size_t)ROW_Q * D * 2, MTOK / 256, 8, 0);
      S.s[1] = mkseg(W + (size_t)ROW_V * D * 2, ws + WS_U, 4, MTOK / 256, 2);
      S.s[2] = mkseg(W + (size_t)ROW_F * D * 2, ws + WS_U, 2, TLAT / 256, 3);
      S.s[3] = mkseg(ws + WS_U, ws + WS_WG, MTOK / 256, 1, 4);
      EpiProjA E{(bf16*)(ws + WS_QPRE), (bf16*)(ws + WS_KPRE), (bf16*)(ws + WS_VT), (bf16*)(ws + WS_XFT), p.b_in, (float*)(ws + WS_GATES)}; pg8::gemm_phase(F.lds, D, S, E); }
    GSYNC();
    for (int it = blockIdx.x; it < 16 * NCHK; it += gridDim.x) { if (it < 512) m1_item(F, p, it & 15, 2 + (it >> 4)); else m1_item(F, p, (it - 512) & 15, (it - 512) >> 4); }
    for (int it = blockIdx.x; it < 256; it += gridDim.x) fourier_item(F, p, it);
    GSYNC();
    for (int sid = blockIdx.x; sid < 256; sid += gridDim.x) m2_stream(F, p, sid);
    GSYNC();
    phase_u2_again(F, p);
    { constexpr int I13 = 16 * 176, I2 = 44 * 32; conv_w13(F, p.w13_b, (bf16*)(ws + WS_W13), 0, I13); conv_plain(F, p.w2_b, FF, D, (bf16*)(ws + WS_W2), 0, I2); }
    GSYNC();
    { pg8::Sched S = mksched(D); const pg8::Seg so = mkseg(ws + WS_U, ws + WS_WIN + (size_t)ROW_O * D * 2, TLAT / 256, 4, 0), sf = mkseg(ws + WS_UF, ws + WS_WFOUR, TLAT / 256, 4, 1);
      const bool swp = gridDim.x == 256 && ((blockIdx.x >> 3) & 1);
      S.s[0] = swp ? sf : so; S.s[1] = swp ? so : sf;
      EpiX E{(bf16*)(ws + WS_HM), (bf16*)(ws + WS_TF), (const bf16*)(ws + WS_HF), (const bf16*)(ws + WS_HB), p.b_in, p.head_g, (LAS float*)(F.lds + pg8::STAGE_BYTES)}; pg8::gemm_phase(F.lds, D, S, E); }
    GSYNC();
    if (gridDim.x == 256) {
      pg8::SchedY S; S.base = mksched(D); S.base.s[0] = mkseg(ws + WS_HM, ws + WS_WMPROJ, TLAT / 256, 4, 1); S.Ag = (const char*)(ws + WS_U); S.Bg = (const char*)(ws + WS_WIN + (size_t)ROW_GF * D * 2);
      EpiY E{(bf16*)(ws + WS_TF), (bf16*)(ws + WS_TM), p.b_in}; pg8::gemm_phase(F.lds, D, S, E);
    } else {
      { pg8::Sched S = mksched(D); S.s[0] = mkseg(ws + WS_HM, ws + WS_WMPROJ, TLAT / 256, 4, 1); EpiY E{(bf16*)(ws + WS_TF), (bf16*)(ws + WS_TM), p.b_in}; pg8::gemm_phase(F.lds, D, S, E); }
      GSYNC();
      { pg8::Sched S = mksched(D); S.s[0] = mkseg(ws + WS_U, ws + WS_WIN + (size_t)ROW_GF * D * 2, TLAT / 256, 8, 0); EpiY E{(bf16*)(ws + WS_TF), (bf16*)(ws + WS_TM), p.b_in}; pg8::gemm_phase(F.lds, D, S, E); }
    }
    GSYNC();
    { pg8::Sched S = mksched(D); S.s[0] = mkseg(ws + WS_TM, ws + WS_WOUT, TLAT / 256, 4, 0);
      float* xb = (float*)(ws + WS_XCH); unsigned* xc = (unsigned*)(ws + WS_XCNT);
      EpiMix E{p.x, p.norm_g + 3 * D, p.norm_g + 4 * D, (const float*)(ws + WS_MOD), (const bf16*)(dout + DO_D1), (bf16*)(ws + WS_D12), (bf16*)(dout + DO_U3),
               PanelRms{xb, xc}, PanelRms{xb + 65536, xc + 64 * 64}, (LAS float*)(F.lds + pg8::STAGE_BYTES)};
      if (gridDim.x == 256) pg8::gemm_phase(F.lds, D, S, E); }
    GSYNC();
    { pg8::Sched S = mksched(D); S.s[0] = mkseg(dout + DO_U3, ws + WS_W13, TLAT / 256, 22, 0); EpiSwiglu E{(bf16*)(ws + WS_ACT2)}; pg8::gemm_phase(F.lds, D, S, E); }
    GSYNC();
    { pg8::Sched S = mksched(FF); S.s[0] = mkseg(ws + WS_ACT2, ws + WS_W2, TLAT / 256, 4, 0);
      EpiFinal E{p.x, p.norm_g + 5 * D, (const float*)(ws + WS_MOD), (const bf16*)(ws + WS_D12), p.out, PanelRms{(float*)(ws + WS_XCH) + 2 * 65536, (unsigned*)(ws + WS_XCNT) + 2 * 64 * 64}, (LAS float*)(F.lds + pg8::STAGE_BYTES)};
      if (gridDim.x == 256) pg8::gemm_phase(F.lds, FF, S, E); }
}

extern "C" void kernel_launch(void* const* d_in, const int* in_sizes, int n_in, void* d_out, int out_size, void* d_ws, size_t ws_size, hipStream_t stream) {
    static int grid = 0;
    if (grid == 0) {
        if (n_in != 19 || out_size != TLAT * D || ws_size < WS_NEED) { fprintf(stderr, "kernel_launch: unexpected problem (n_in %d, out %d, ws %zu)\n", n_in, out_size, ws_size); grid = -1; return; }
        int dev = 0, cus = 0, per_cu = 0;
        if (hipGetDevice(&dev) != hipSuccess || hipDeviceGetAttribute(&cus, hipDeviceAttributeMultiprocessorCount, dev) != hipSuccess) { grid = -1; return; }
        if (hipFuncSetAttribute((const void*)mega_fwd, hipFuncAttributeMaxDynamicSharedMemorySize, LDS_BYTES) != hipSuccess) { fprintf(stderr, "kernel_launch: hipFuncSetAttribute failed\n"); grid = -1; return; }
        if (hipOccupancyMaxActiveBlocksPerMultiprocessor(&per_cu, (const void*)mega_fwd, NTHR, LDS_BYTES) != hipSuccess || per_cu < 1) { fprintf(stderr, "kernel_launch: occupancy query failed (%d)\n", per_cu); (void)hipGetLastError(); grid = -1; return; }
        grid = cus * 1;
        if (grid != 256) fprintf(stderr, "kernel_launch: built for a 256-CU device (fused norm epilogues need one 256x256 unit per workgroup); got %d\n", grid);
        fprintf(stderr, "kernel_launch: %d CUs, %d blocks/CU by the occupancy query, grid %d\n", cus, per_cu, grid);
    }
    if (grid < 0) return;
    Params p{};
    const float** f = (const float**)&p;
    for (int i = 0; i < 19; ++i) f[i] = (const float*)d_in[i];
    p.out = (float*)d_out; p.ws = (unsigned char*)d_ws;
    (void)hipMemsetAsync((char*)d_ws + WS_BAR, 0, 64 * 1024, stream);
    void* args[] = {&p};
    hipError_t e = hipLaunchCooperativeKernel((const void*)mega_fwd, dim3(grid), dim3(NTHR), args, LDS_BYTES, stream);
    if (e != hipSuccess) fprintf(stderr, "kernel_launch: cooperative launch failed: %s (grid %d)\n", hipGetErrorString(e), grid);
}
```

```cpp
#include <hip/hip_runtime.h>
#include <hip/hip_cooperative_groups.h>
#include <cstdio>
#include <cstdint>
namespace cg = cooperative_groups;

#define LAS __attribute__((address_space(3)))
typedef unsigned short bf16;
typedef short bf16x8 __attribute__((ext_vector_type(8)));
typedef float f32x4 __attribute__((ext_vector_type(4)));
typedef float f32x2 __attribute__((ext_vector_type(2)));
typedef unsigned u32x4 __attribute__((ext_vector_type(4)));
typedef unsigned u32x2 __attribute__((ext_vector_type(2)));

constexpr int D = 1024, NB = 4, SEQ = 4096, CTXL = 256, FF = 2816, NH = 4, DH = 256, CH = 128;
constexpr int TLAT = NB * SEQ;
constexpr int TCTX = NB * CTXL;
constexpr int MTOK = TLAT + TCTX;
constexpr int INW = 6672;
constexpr int PLEN = CTXL + SEQ;
constexpr int NCHK = PLEN / CH;
constexpr float EPS = 1e-6f;
constexpr int NTHR = 512, NWAVE = 8;
constexpr int LDS_BYTES = 147456;

constexpr size_t MiB = 1u << 20;
constexpr size_t WS_MOD = 0;
constexpr size_t WS_BAR = 256 * 1024;
constexpr size_t WS_GATES = 512 * 1024;
constexpr size_t WS_TOKSC = 2 * MiB;
constexpr size_t WS_CHSC = 5 * MiB;
constexpr size_t WS_WG = 7 * MiB;
constexpr size_t WS_XCH = 6 * MiB;
constexpr size_t WS_XCNT = WS_BAR + 16 * 1024;
constexpr size_t WS_W13 = 8 * MiB, WS_W2 = 19 * MiB, WS_WIN = 25 * MiB, WS_WFOUR = 38 * MiB, WS_WMPROJ = 40 * MiB, WS_WOUT = 42 * MiB;
constexpr size_t WS_XFT = 8 * MiB;
constexpr size_t WS_U = 44 * MiB;
constexpr size_t WS_U2 = 210 * MiB;
constexpr size_t WS_ACT = 78 * MiB;
constexpr size_t WS_Y1 = 172 * MiB;
constexpr size_t WS_Y1C = 44 * MiB;
constexpr size_t WS_QPRE = 78 * MiB;
constexpr size_t WS_KPRE = 110 * MiB;
constexpr size_t WS_VT = 144 * MiB;
constexpr size_t WS_Q = 178 * MiB;
constexpr size_t WS_UF = 142 * MiB;
constexpr size_t WS_KT = 44 * MiB;
constexpr size_t WS_HF = 78 * MiB, WS_HB = 110 * MiB;
constexpr size_t WS_HM = 174 * MiB;
constexpr size_t DO_TF = 32 * MiB;
constexpr size_t WS_W13B = 44 * MiB, WS_W2B = 55 * MiB;
constexpr size_t WS_TM = 78 * MiB;
constexpr size_t WS_OUTL = 110 * MiB;
constexpr size_t WS_D12 = 110 * MiB;
constexpr size_t WS_ACT2 = 142 * MiB;
constexpr size_t WS_Y3 = 164 * MiB;
constexpr size_t WS_NEED = 256 * MiB;
constexpr size_t DO_D1 = 0, DO_P = 32 * MiB, DO_U3 = 32 * MiB;

constexpr int COL_F = 0, COL_Q = 512, COL_K = 1536, COL_V = 2560, COL_O = 3584, COL_GATES = 4608, COL_GF = 4624, COL_GM = 5648;
constexpr int ROW_Q = 0, ROW_K = 1024, ROW_V = 2048, ROW_F = 3072, ROW_O = 3584, ROW_GF = 4608, ROW_GM = 5632, WIN_ROWS = 6656;

struct Params {
    const float *x, *c, *ctx, *c_ctx, *w_ada, *b_ada, *norm_g, *w13_a, *w2_a, *w_in, *b_in, *conv_w, *conv_b, *head_g, *w_four, *w_mproj, *w_out, *w13_b, *w2_b;
    float* out; unsigned char* ws;
};

typedef __bf16 bf16x2_t __attribute__((ext_vector_type(2)));
__device__ __forceinline__ unsigned f2bf(float f) { return (unsigned)__builtin_bit_cast(unsigned short, (__bf16)f); }
__device__ __forceinline__ unsigned pk2(float lo, float hi) { bf16x2_t v; v[0] = (__bf16)lo; v[1] = (__bf16)hi; return __builtin_bit_cast(unsigned, v); }
__device__ __forceinline__ float bf2f(unsigned b) { return __builtin_bit_cast(float, b << 16); }
__device__ __forceinline__ float bflo(unsigned w) { return __builtin_bit_cast(float, w << 16); }
__device__ __forceinline__ float bfhi(unsigned w) { return __builtin_bit_cast(float, w & 0xffff0000u); }
__device__ __forceinline__ unsigned cvt_pk_bf16(float lo, float hi) { return pk2(lo, hi); }
#define DPP_F(v, ctrl) __builtin_bit_cast(float, __builtin_amdgcn_update_dpp(0, __builtin_bit_cast(int, (v)), (ctrl), 0xf, 0xf, false))
__device__ __forceinline__ float row16_sum(float v) {
    v += DPP_F(v, 0xB1);
    v += DPP_F(v, 0x4E);
    v += DPP_F(v, 0x141);
    v += DPP_F(v, 0x140);
    return v;
}
__device__ __forceinline__ float rlane(float v, int l) { return __builtin_bit_cast(float, __builtin_amdgcn_readlane(__builtin_bit_cast(int, v), l)); }
__device__ __forceinline__ float wave_sum(float v) { v = row16_sum(v); return (rlane(v, 0) + rlane(v, 16)) + (rlane(v, 32) + rlane(v, 48)); }
__device__ __forceinline__ float sigmoidf_(float x) { return __builtin_amdgcn_rcpf(1.0f + __expf(-x)); }
__device__ __forceinline__ float siluf_(float x) { return x * __builtin_amdgcn_rcpf(1.0f + __expf(-x)); }
#define LDS_WAIT() asm volatile("s_waitcnt lgkmcnt(0)" ::: "memory")
#define VM_WAIT() asm volatile("s_waitcnt vmcnt(0)" ::: "memory")

namespace pg8 {
constexpr int BM = 256, BK = 64, HALF = 128, HTB = HALF * BK * 2, STAGE_BYTES = 8 * HTB, NXCD = 8, WGM = 8;
__host__ __device__ __forceinline__ int lds_byte(int r, int c) { const int st = (r >> 4) * 2 + (c >> 5), rr = r & 15, cc = c & 31, ob = rr * 64 + cc * 2; return st * 1024 + (ob ^ (((ob >> 9) & 1) << 5)); }
__host__ __device__ __forceinline__ void stage_rc(int b, int& R, int& C) { const int st = b / 1024, sb = b % 1024, swz = sb ^ (((sb >> 9) & 1) << 5); R = (st >> 1) * 16 + swz / 64; C = (st & 1) * 32 + (swz % 64) / 2; }
__host__ __device__ __forceinline__ int perm32(int rho) { const int n = rho >> 4, i = rho & 15; return 8 * (i >> 2) + 4 * n + (i & 3); }

struct Unit { const char* A; const char* B; int kind, pm, pn, nt, kq; };
struct Seg { const char* A0; const char* B0; int nM, nN, kind, ksplit; };
struct Sched {
    Seg s[4]; int G, c; size_t tstep;
    int ntk;
    __device__ __forceinline__ bool pick(const Seg& sg, long& L, Unit& u) const {
        const int nwg = sg.nM * sg.nN * sg.ksplit;
        if (L >= nwg) { L -= nwg; return false; }
        if (sg.ksplit > 1) { const int tiles = sg.nM * sg.nN, kq = (int)L / tiles, tl = (int)L % tiles; u.pm = tl % sg.nM; u.pn = tl / sg.nM; u.kind = sg.kind;
            const int kt0 = kq * 6 - (kq > 6 ? 2 : 0); u.nt = kq < 6 ? 6 : 4; u.kq = kq;
            u.A = sg.A0 + (size_t)u.pm * tstep + kt0 * 128; u.B = sg.B0 + (size_t)u.pn * tstep + kt0 * 128; return true; }
        u.nt = ntk; u.kq = 0;
        int wgid = (int)L; { const int q = nwg / NXCD, r = nwg % NXCD, xcd = wgid % NXCD, off = wgid / NXCD; wgid = (xcd < r ? xcd * (q + 1) : r * (q + 1) + (xcd - r) * q) + off; }
        const int nig = WGM * sg.nN, gid = wgid / nig, fm = gid * WGM, gsz = (sg.nM - fm) < WGM ? (sg.nM - fm) : WGM;
        u.pm = fm + ((wgid % nig) % gsz); u.pn = (wgid % nig) / gsz; u.kind = sg.kind;
        u.A = sg.A0 + (size_t)u.pm * tstep; u.B = sg.B0 + (size_t)u.pn * tstep; return true;
    }
    __device__ __forceinline__ bool next(int i, Unit& u) const {
        long L = (long)i * G + c;
        if (pick(s[0], L, u)) return true;
        if (pick(s[1], L, u)) return true;
        if (pick(s[2], L, u)) return true;
        if (pick(s[3], L, u)) return true;
        return false;
    }
};

struct SchedY {
    Sched base; const char* Ag; const char* Bg;
    __device__ __forceinline__ bool next(int i, Unit& u) const {
        if (i > 2) return false;
        long L = base.c; Unit t; base.pick(base.s[0], L, t);
        if (i == 0) { u = t; return true; }
        u.kind = 0; u.pm = t.pm; u.pn = 2 * t.pn + (i - 1); u.nt = base.ntk; u.kq = 0;
        u.A = Ag + (size_t)u.pm * base.tstep; u.B = Bg + (size_t)u.pn * base.tstep; return true;
    }
};
template <class Epi, class SchedT>
__device__ __forceinline__ void gemm_phase(LAS unsigned char* lds, const int K, const SchedT& S, const Epi& E) {
    int tid_ = threadIdx.x; asm volatile("" : "+v"(tid_));
    const int tid = tid_, wid = __builtin_amdgcn_readfirstlane(tid >> 6), lane = tid & 63, wr = wid >> 2, wc = wid & 3, fr = lane & 15, fq = lane >> 4;
    unsigned voffA[2], voffB[2];
#pragma unroll
    for (int i = 0; i < 2; ++i) { int R, C; stage_rc(tid * 16 + i * 8192, R, C); const int Rb = (R & ~31) + perm32(R & 31);
        voffA[i] = (unsigned)(R * K + C) * 2u; voffB[i] = (unsigned)(Rb * K + C) * 2u; }
    const size_t kstep = (size_t)(BK * 2);
    const size_t hstep = (size_t)HALF * K * 2;
    const unsigned ldsw = (unsigned)wid * 1024u;
    const int aoff = lds_byte(wr * 64 + fr, fq * 8), boff = lds_byte(wc * 32 + fr, fq * 8);
#define PG8_SA(b, h) (((b) * 2 + (h)) * HTB)
#define PG8_SB(b, h) ((4 + (b) * 2 + (h)) * HTB)
#define PG8_STAGE(bufoff, gbase, voff) do { _Pragma("unroll") for (int _i = 0; _i < 2; ++_i) \
        __builtin_amdgcn_global_load_lds((const unsigned*)((const char*)(gbase) + (voff)[_i]), (LAS unsigned*)(lds + (bufoff) + ldsw + _i * 8192), 16, 0, 0); } while (0)
#define PG8_LDA(dst, b, h) do { _Pragma("unroll") for (int m = 0; m < 4; ++m) _Pragma("unroll") for (int k = 0; k < 2; ++k) dst[m][k] = *(const LAS bf16x8*)(lds + PG8_SA(b, h) + aoff + m * 2048 + k * 1024); } while (0)
#define PG8_LDB(dst, b, h) do { _Pragma("unroll") for (int n = 0; n < 2; ++n) _Pragma("unroll") for (int k = 0; k < 2; ++k) dst[n][k] = *(const LAS bf16x8*)(lds + PG8_SB(b, h) + boff + n * 2048 + k * 1024); } while (0)
#define PG8_MMA(ai, bj, At, Bt) do { __builtin_amdgcn_s_setprio(1); _Pragma("unroll") for (int m = 0; m < 4; ++m) _Pragma("unroll") for (int n = 0; n < 2; ++n) _Pragma("unroll") for (int k = 0; k < 2; ++k) \
        acc[ai][bj][m][n] = __builtin_amdgcn_mfma_f32_16x16x32_bf16(Bt[n][k], At[m][k], acc[ai][bj][m][n], 0, 0, 0); __builtin_amdgcn_s_setprio(0); } while (0)
#define PG8_WAIT_V(n) asm volatile("s_waitcnt vmcnt(" #n ")" ::: "memory")
#define PG8_WAIT_L(n) asm volatile("s_waitcnt lgkmcnt(" #n ")" ::: "memory")
#define PG8_BAR __builtin_amdgcn_s_barrier()
#define PG8_SCHED __builtin_amdgcn_sched_barrier(0)
    Unit cur, nxt; int ui = 0;
    if (!S.next(0, cur)) return;
    f32x4 acc[2][2][4][2];
#pragma unroll
    for (int a = 0; a < 2; ++a)
#pragma unroll
        for (int b = 0; b < 2; ++b)
#pragma unroll
            for (int m = 0; m < 4; ++m)
#pragma unroll
                for (int n = 0; n < 2; ++n) acc[a][b][m][n] = (f32x4){0.f, 0.f, 0.f, 0.f};
    bf16x8 At[4][2], B0[2][2], B1[2][2];
    const char* cA = cur.A; const char* cB = cur.B;
    PG8_STAGE(PG8_SB(0, 0), cB, voffB); PG8_STAGE(PG8_SB(0, 1), cB + hstep, voffB); PG8_STAGE(PG8_SA(0, 0), cA, voffA); PG8_STAGE(PG8_SA(0, 1), cA + hstep, voffA);
    if (wr == 1) PG8_BAR;
    PG8_WAIT_V(2); PG8_BAR;
    PG8_STAGE(PG8_SB(1, 0), cB + kstep, voffB); PG8_STAGE(PG8_SA(1, 0), cA + kstep, voffA); PG8_STAGE(PG8_SB(1, 1), cB + hstep + kstep, voffB);
    PG8_WAIT_V(6); PG8_BAR;
    for (;;) {
        const bool has_next = S.next(ui + 1, nxt);
        const char* nA = has_next ? nxt.A : cA; const char* nB = has_next ? nxt.B : cB;
        const int nt = cur.nt;
        for (int t = 0; t < nt; t += 2) {
            const bool last = (t == nt - 2);
            const char* a1 = cA + (size_t)(t + 1) * kstep;
            const char* a2 = last ? nA : cA + (size_t)(t + 2) * kstep; const char* b2 = last ? nB : cB + (size_t)(t + 2) * kstep;
            const char* a3 = a2 + kstep; const char* b3 = b2 + kstep;
            PG8_LDB(B0, 0, 0); PG8_LDB(B1, 0, 1); PG8_SCHED; PG8_LDA(At, 0, 0); PG8_STAGE(PG8_SA(1, 1), a1 + hstep, voffA);
            PG8_WAIT_V(8); PG8_WAIT_L(0); PG8_BAR; PG8_MMA(0, 0, At, B0); PG8_MMA(0, 1, At, B1); PG8_BAR; PG8_SCHED;
            PG8_LDA(At, 0, 1); PG8_STAGE(PG8_SB(0, 0), b2, voffB); PG8_STAGE(PG8_SB(0, 1), b2 + hstep, voffB); PG8_STAGE(PG8_SA(0, 0), a2, voffA);
            PG8_WAIT_V(8); PG8_WAIT_L(0); PG8_BAR; PG8_MMA(1, 0, At, B0); PG8_MMA(1, 1, At, B1); PG8_BAR; PG8_SCHED;
            PG8_LDB(B0, 1, 0); PG8_LDB(B1, 1, 1); PG8_SCHED; PG8_LDA(At, 1, 0); PG8_STAGE(PG8_SA(0, 1), a2 + hstep, voffA);
            PG8_WAIT_V(8); PG8_WAIT_L(0); PG8_BAR; PG8_MMA(0, 0, At, B0); PG8_MMA(0, 1, At, B1); PG8_BAR; PG8_SCHED;
            PG8_LDA(At, 1, 1); PG8_STAGE(PG8_SB(1, 0), b3, voffB); PG8_STAGE(PG8_SB(1, 1), b3 + hstep, voffB); PG8_STAGE(PG8_SA(1, 0), a3, voffA);
            PG8_WAIT_V(8); PG8_WAIT_L(0); PG8_BAR; PG8_MMA(1, 0, At, B0); PG8_MMA(1, 1, At, B1); PG8_BAR; PG8_SCHED;
        }
        if (wr == 0) PG8_BAR;
        { int fr2 = fr, fq2 = fq; asm volatile("" : "+v"(fr2), "+v"(fq2));
          E(acc, cur, wr, wc, fr2, fq2); }
        if (!has_next) break;
#pragma unroll
        for (int a = 0; a < 2; ++a)
#pragma unroll
            for (int b = 0; b < 2; ++b)
#pragma unroll
                for (int m = 0; m < 4; ++m)
#pragma unroll
                    for (int n = 0; n < 2; ++n) acc[a][b][m][n] = (f32x4){0.f, 0.f, 0.f, 0.f};
        cur = nxt; cA = nA; cB = nB; ++ui;
        if (wr == 1) PG8_BAR;
    }
    PG8_WAIT_V(0);
    PG8_BAR;
#undef PG8_SA
#undef PG8_SB
#undef PG8_STAGE
#undef PG8_LDA
#undef PG8_LDB
#undef PG8_MMA
#undef PG8_WAIT_V
#undef PG8_WAIT_L
#undef PG8_BAR
#undef PG8_SCHED
}
}

#define ACC_T const f32x4 (&acc)[2][2][4][2]
template <class T> __device__ __forceinline__ T ldg(const void* base, unsigned boff) { return *(const T*)((const char*)base + boff); }
#ifndef WT_STORES
#define WT_STORES 0
#endif
template <class T> __device__ __forceinline__ void stg(void* base, unsigned boff, const T& v) {
    static_assert(sizeof(T) == 16, "16-byte stores only");
#if WT_STORES
    const __amdgpu_buffer_rsrc_t rs = __builtin_amdgcn_make_buffer_rsrc(base, (short)0, 0x7fffffff, 0x00020000);
    __builtin_amdgcn_raw_buffer_store_b128(__builtin_bit_cast(u32x4, v), rs, boff, 0, 16);
#else
    *(T*)((char*)base + boff) = v;
#endif
}
__device__ __forceinline__ u32x4 pack8(const f32x4& v0, const f32x4& v1) { u32x4 w; w.x = cvt_pk_bf16(v0[0], v0[1]); w.y = cvt_pk_bf16(v0[2], v0[3]); w.z = cvt_pk_bf16(v1[0], v1[1]); w.w = cvt_pk_bf16(v1[2], v1[3]); return w; }
#define ROWGROUPS(ai, m) _Pragma("unroll") for (int ai = 0; ai < 2; ++ai) _Pragma("unroll") for (int m = 0; m < 4; ++m)

struct EpiSwiglu {
    bf16* O;
    __device__ __forceinline__ void operator()(ACC_T, const pg8::Unit& u, int wr, int wc, int fr, int fq) const {
        const unsigned off0 = (unsigned)((u.pm * 256 + wr * 64 + fr) * FF + u.pn * 128 + wc * 32 + 8 * fq) * 2u;
        ROWGROUPS(ai, m) {
            const f32x4 a0 = acc[ai][0][m][0], a1 = acc[ai][0][m][1], b0 = acc[ai][1][m][0], b1 = acc[ai][1][m][1];
            f32x4 h0, h1;
#pragma unroll
            for (int j = 0; j < 4; ++j) { h0[j] = a0[j] * b0[j] * __builtin_amdgcn_rcpf(1.0f + __builtin_amdgcn_exp2f(-a0[j])); h1[j] = a1[j] * b1[j] * __builtin_amdgcn_rcpf(1.0f + __builtin_amdgcn_exp2f(-a1[j])); }
            stg(O, off0 + (unsigned)((ai * 128 + m * 16) * FF * 2), pack8(h0, h1));
        }
    }
};

struct EpiProjA {
    bf16 *Oq, *Ok, *Ovt, *Oxt; const float* b_in; float* G;
    __device__ __forceinline__ void operator()(ACC_T, const pg8::Unit& u, int wr, int wc, int fr, int fq) const {
        const int row0 = u.pm * 256 + wr * 64 + fr, col0 = u.pn * 256 + wc * 32 + 8 * fq;
        if (u.kind == 4) {
            if (wc == 0 && fq < 2) { const f32x4 b0 = ldg<f32x4>(b_in, (unsigned)(COL_GATES + 8 * fq) * 4u), b1 = ldg<f32x4>(b_in, (unsigned)(COL_GATES + 8 * fq + 4) * 4u);
                const unsigned g0 = (unsigned)(row0 * 16 + 8 * fq) * 4u;
                ROWGROUPS(ai, m) { stg(G, g0 + (unsigned)((ai * 128 + m * 16) * 64), acc[ai][0][m][0] + b0); stg(G, g0 + (unsigned)((ai * 128 + m * 16) * 64) + 16, acc[ai][0][m][1] + b1); } }
            return; }
        if (u.kind == 0) {
            const bool isk = u.pn >= 4; if (!isk && u.pm >= TLAT / 256) return;
            bf16* O = isk ? Ok : Oq; const int colq = col0 - (isk ? 1024 : 0); const unsigned boff = (unsigned)((isk ? COL_K : COL_Q) + colq) * 4u;
            const unsigned off0 = (unsigned)(row0 * D + colq) * 2u;
#pragma unroll
            for (int bj = 0; bj < 2; ++bj) {
                const f32x4 bv0 = ldg<f32x4>(b_in, boff + bj * 512), bv1 = ldg<f32x4>(b_in, boff + bj * 512 + 16);
                ROWGROUPS(ai, m) stg(O, off0 + (unsigned)((ai * 128 + m * 16) * D * 2) + bj * 256, pack8(acc[ai][bj][m][0] + bv0, acc[ai][bj][m][1] + bv1));
            }
        } else {
            bf16* O = u.kind == 2 ? Ovt : Oxt; const int ldc = u.kind == 2 ? MTOK : TLAT; const unsigned boff = (unsigned)((u.kind == 2 ? COL_V : COL_F) + row0) * 4u;
            const unsigned off0 = (unsigned)(row0 * ldc + col0) * 2u;
            ROWGROUPS(ai, m) { const float bb = ldg<float>(b_in, boff + (unsigned)((ai * 128 + m * 16) * 4)); const unsigned o = off0 + (unsigned)((ai * 128 + m * 16) * ldc * 2);
#pragma unroll
                for (int bj = 0; bj < 2; ++bj) stg(O, o + bj * 256, pack8(acc[ai][bj][m][0] + bb, acc[ai][bj][m][1] + bb)); }
        }
    }
};
__device__ __forceinline__ void store_bf16_tile(bf16* O, ACC_T, const pg8::Unit& u, int wr, int wc, int fr, int fq) {
    const unsigned off0 = (unsigned)((u.pm * 256 + wr * 64 + fr) * D + u.pn * 256 + wc * 32 + 8 * fq) * 2u;
    ROWGROUPS(ai, m) { const unsigned o = off0 + (unsigned)((ai * 128 + m * 16) * D * 2);
#pragma unroll
        for (int bj = 0; bj < 2; ++bj) stg(O, o + bj * 256, pack8(acc[ai][bj][m][0], acc[ai][bj][m][1])); }
}
struct EpiBf16 { bf16* O; __device__ __forceinline__ void operator()(ACC_T, const pg8::Unit& u, int wr, int wc, int fr, int fq) const { store_bf16_tile(O, acc, u, wr, wc, fr, fq); } };
struct EpiDownA { bf16* Y1; float* Y1C;
    __device__ __forceinline__ void operator()(ACC_T, const pg8::Unit& u, int wr, int wc, int fr, int fq) const {
        if (u.kind == 0) { store_bf16_tile(Y1, acc, u, wr, wc, fr, fq); return; }
        const unsigned off0 = (unsigned)(((u.kq * TCTX + u.pm * 256 + wr * 64 + fr) * D) + u.pn * 256 + wc * 32 + 8 * fq) * 4u;
        ROWGROUPS(ai, m) { const unsigned o = off0 + (unsigned)((ai * 128 + m * 16) * D * 4);
#pragma unroll
            for (int bj = 0; bj < 2; ++bj) { stg(Y1C, o + bj * 512, acc[ai][bj][m][0]); stg(Y1C, o + bj * 512 + 16, acc[ai][bj][m][1]); } }
    }
};
struct EpiX {
    bf16 *HM, *TF; const bf16 *HF, *HB; const float *b_in, *head_g; LAS float* red;
    __device__ __forceinline__ void operator()(ACC_T, const pg8::Unit& u, int wr, int wc, int fr, int fq) const {
        if (u.kind == 1) { store_bf16_tile(TF, acc, u, wr, wc, fr, fq); return; }
        const int col0 = u.pn * 256 + wc * 32 + 8 * fq, rt0 = wr * 64 + fr;
        const unsigned off0 = (unsigned)((u.pm * 256 + rt0) * D + col0) * 2u;
#pragma unroll
        for (int am = 0; am < 4; ++am) { const int ai = am >> 1, mb = (am & 1) * 2;
            u32x4 hp[4][2];
#pragma unroll
            for (int m = mb; m < mb + 2; ++m) { const unsigned o = off0 + (unsigned)((ai * 128 + m * 16) * D * 2); float s = 0.f;
#pragma unroll
                for (int bj = 0; bj < 2; ++bj) { const u32x4 a = ldg<u32x4>(HF, o + bj * 256), b = ldg<u32x4>(HB, o + bj * 256); u32x4 hq;
#pragma unroll
                    for (int q = 0; q < 4; ++q) { const float h0 = bflo(a[q]) + bflo(b[q]), h1 = bfhi(a[q]) + bfhi(b[q]); hq[q] = pk2(h0, h1); const float g0 = bflo(hq[q]), g1 = bfhi(hq[q]); s += g0 * g0 + g1 * g1; }
                    hp[m][bj] = hq; }
                s += __shfl_xor(s, 16); s += __shfl_xor(s, 32);
                if (fq == 0) red[(ai * 128 + m * 16 + rt0) * 4 + wc] = s; }
            LDS_WAIT(); __builtin_amdgcn_s_barrier(); asm volatile("" ::: "memory");
#pragma unroll
            for (int bj = 0; bj < 2; ++bj) {
                const unsigned cb = (unsigned)(col0 + bj * 128) * 4u;
                const f32x4 bo0 = ldg<f32x4>(b_in, COL_O * 4 + cb), bo1 = ldg<f32x4>(b_in, COL_O * 4 + cb + 16), hg0 = ldg<f32x4>(head_g, cb), hg1 = ldg<f32x4>(head_g, cb + 16);
#pragma unroll
                for (int m = mb; m < mb + 2; ++m) { const f32x4 ps = *(const LAS f32x4*)(red + (ai * 128 + m * 16 + rt0) * 4);
                    const float rstd = rsqrtf(((ps[0] + ps[1]) + (ps[2] + ps[3])) * (1.0f / 256.0f) + EPS);
                    const unsigned o = off0 + (unsigned)((ai * 128 + m * 16) * D * 2) + bj * 256;
                    const u32x4 hq = hp[m][bj];
                    const f32x4 v0 = acc[ai][bj][m][0] + bo0, v1 = acc[ai][bj][m][1] + bo1;
                    f32x4 r0, r1;
                    r0[0] = sigmoidf_(v0[0]) * bflo(hq[0]) * rstd * hg0[0]; r0[1] = sigmoidf_(v0[1]) * bfhi(hq[0]) * rstd * hg0[1];
                    r0[2] = sigmoidf_(v0[2]) * bflo(hq[1]) * rstd * hg0[2]; r0[3] = sigmoidf_(v0[3]) * bfhi(hq[1]) * rstd * hg0[3];
                    r1[0] = sigmoidf_(v1[0]) * bflo(hq[2]) * rstd * hg1[0]; r1[1] = sigmoidf_(v1[1]) * bfhi(hq[2]) * rstd * hg1[1];
                    r1[2] = sigmoidf_(v1[2]) * bflo(hq[3]) * rstd * hg1[2]; r1[3] = sigmoidf_(v1[3]) * bfhi(hq[3]) * rstd * hg1[3];
                    stg(HM, o, pack8(r0, r1)); } }
            asm volatile("" ::: "memory");
        }
    }
};
struct EpiY {
    bf16 *TF, *TM; const float* b_in;
    __device__ __forceinline__ void operator()(ACC_T, const pg8::Unit& u, int wr, int wc, int fr, int fq) const {
        if (u.kind == 1) { store_bf16_tile(TM, acc, u, wr, wc, fr, fq); return; }
        const int ch0 = u.pn * 128 + wc * 32 + 8 * fq;
        const unsigned off0 = (unsigned)((u.pm * 256 + wr * 64 + fr) * D + ch0) * 2u;
        const f32x4 bf0 = ldg<f32x4>(b_in, (unsigned)(COL_GF + ch0) * 4u), bf1 = ldg<f32x4>(b_in, (unsigned)(COL_GF + ch0) * 4u + 16);
        const f32x4 bm0 = ldg<f32x4>(b_in, (unsigned)(COL_GM + ch0) * 4u), bm1 = ldg<f32x4>(b_in, (unsigned)(COL_GM + ch0) * 4u + 16);
        ROWGROUPS(ai, m) { const unsigned o = off0 + (unsigned)((ai * 128 + m * 16) * D * 2);
            const u32x4 t = ldg<u32x4>(TF, o), tm = ldg<u32x4>(TM, o);
            const f32x4 f0 = acc[ai][0][m][0] + bf0, f1 = acc[ai][0][m][1] + bf1, g0 = acc[ai][1][m][0] + bm0, g1 = acc[ai][1][m][1] + bm1;
            f32x4 r0, r1;
            r0[0] = sigmoidf_(f0[0]) * bflo(t[0]) + sigmoidf_(g0[0]) * bflo(tm[0]); r0[1] = sigmoidf_(f0[1]) * bfhi(t[0]) + sigmoidf_(g0[1]) * bfhi(tm[0]);
            r0[2] = sigmoidf_(f0[2]) * bflo(t[1]) + sigmoidf_(g0[2]) * bflo(tm[1]); r0[3] = sigmoidf_(f0[3]) * bfhi(t[1]) + sigmoidf_(g0[3]) * bfhi(tm[1]);
            r1[0] = sigmoidf_(f1[0]) * bflo(t[2]) + sigmoidf_(g1[0]) * bflo(tm[2]); r1[1] = sigmoidf_(f1[1]) * bfhi(t[2]) + sigmoidf_(g1[1]) * bfhi(tm[2]);
            r1[2] = sigmoidf_(f1[2]) * bflo(t[3]) + sigmoidf_(g1[2]) * bflo(tm[3]); r1[3] = sigmoidf_(f1[3]) * bfhi(t[3]) + sigmoidf_(g1[3]) * bfhi(tm[3]);
            stg(TM, o, pack8(r0, r1));
            asm volatile("" ::: "memory"); }
    }
};

struct PanelRms {
    float* xbuf; unsigned* cnt;
    __device__ __forceinline__ void run(const f32x4 (&v)[2][2][4][2], const pg8::Unit& u, int wr, int wc, int fr, int fq, LAS float* Pt, LAS float* S, int wid, int lane) const {
        ROWGROUPS(ai, m) { float s = 0.f;
#pragma unroll
            for (int bj = 0; bj < 2; ++bj)
#pragma unroll
                for (int n = 0; n < 2; ++n) { const f32x4 x = v[ai][bj][m][n]; s += (x[0] * x[0] + x[1] * x[1]) + (x[2] * x[2] + x[3] * x[3]); }
            s += __shfl_xor(s, 16); s += __shfl_xor(s, 32);
            if (fq == 0) Pt[(ai * 128 + wr * 64 + m * 16 + fr) * 4 + wc] = s; }
        LDS_WAIT(); __builtin_amdgcn_s_barrier(); asm volatile("" ::: "memory");
        const int row = wid * 32 + (lane & 31);
        if (lane < 32) { const f32x4 a = *(const LAS f32x4*)(Pt + row * 4);
            __hip_atomic_store(xbuf + (size_t)(u.pm * 256 + row) * 4 + u.pn, (a[0] + a[1]) + (a[2] + a[3]), __ATOMIC_RELAXED, __HIP_MEMORY_SCOPE_AGENT); }
        asm volatile("s_waitcnt vmcnt(0)" ::: "memory");
        if (lane == 0) __hip_atomic_fetch_add(cnt + 64 * u.pm, 1u, __ATOMIC_RELAXED, __HIP_MEMORY_SCOPE_AGENT);
        if (wid == 0) { unsigned sp = 0;
            while ((unsigned)__builtin_amdgcn_readfirstlane(__hip_atomic_load(cnt + 64 * u.pm, __ATOMIC_RELAXED, __HIP_MEMORY_SCOPE_AGENT)) < 32u) { __builtin_amdgcn_s_sleep(2); if (++sp > (1u << 22)) break; }
            __builtin_amdgcn_fence(__ATOMIC_ACQUIRE, "agent"); }
        asm volatile("s_waitcnt vmcnt(0) lgkmcnt(0)" ::: "memory"); __builtin_amdgcn_s_barrier(); asm volatile("" ::: "memory");
        if (lane < 32) { const float* sl = xbuf + (size_t)(u.pm * 256 + row) * 4; float t = 0.f;
#pragma unroll
            for (int k = 0; k < 4; ++k) t += __hip_atomic_load(sl + k, __ATOMIC_RELAXED, __HIP_MEMORY_SCOPE_AGENT);
            S[row] = rsqrtf(t * (1.0f / 1024.0f) + EPS); }
        LDS_WAIT(); __builtin_amdgcn_s_barrier(); asm volatile("" ::: "memory");
    }
};
struct EpiFinal {
    const float *x, *g5, *mod; const bf16* D12; float* out; PanelRms st; LAS float* tab;
    __device__ __forceinline__ void operator()(ACC_T, const pg8::Unit& u, int wr, int wc, int fr, int fq) const {
        const int wid = wr * 4 + wc, lane = fq * 16 + fr; LAS float* S = tab + 1024;
        st.run(acc, u, wr, wc, fr, fq, tab, S, wid, lane);
        const int col0 = u.pn * 256 + wc * 32 + 8 * fq, rt0 = wr * 64 + fr, v = (u.pm * 256) >> 12;
        const unsigned e0 = (unsigned)((u.pm * 256 + rt0) * D + col0);
        const float* gate = mod + (size_t)v * 9216 + 8 * 1024;
#pragma unroll
        for (int bj = 0; bj < 2; ++bj) {
            const unsigned cb = (unsigned)(col0 + bj * 128) * 4u;
            f32x4 g0 = ldg<f32x4>(g5, cb), g1 = ldg<f32x4>(g5, cb + 16); const f32x4 t0 = ldg<f32x4>(gate, cb), t1 = ldg<f32x4>(gate, cb + 16);
            g0 = g0 * t0 * 0.5f; g1 = g1 * t1 * 0.5f;
            ROWGROUPS(ai, m) { const float rs = S[ai * 128 + m * 16 + rt0]; const unsigned e = e0 + (unsigned)((ai * 128 + m * 16) * D) + bj * 128;
                const f32x4 x0 = ldg<f32x4>(x, e * 4u), x1 = ldg<f32x4>(x, e * 4u + 16); const u32x4 dd = ldg<u32x4>(D12, e * 2u);
                f32x4 o0, o1;
                o0[0] = x0[0] + bflo(dd[0]); o0[1] = x0[1] + bfhi(dd[0]); o0[2] = x0[2] + bflo(dd[1]); o0[3] = x0[3] + bfhi(dd[1]);
                o1[0] = x1[0] + bflo(dd[2]); o1[1] = x1[1] + bfhi(dd[2]); o1[2] = x1[2] + bflo(dd[3]); o1[3] = x1[3] + bfhi(dd[3]);
                o0 = o0 + acc[ai][bj][m][0] * rs * g0; o1 = o1 + acc[ai][bj][m][1] * rs * g1;
                stg(out, e * 4u, o0); stg(out, e * 4u + 16, o1);
                asm volatile("" ::: "memory"); } }
    }
};
struct EpiMix {
    const float *x, *g3, *g4, *mod; const bf16* D1; bf16 *D12, *U3; PanelRms st1, st2; LAS float* tab;
    __device__ __forceinline__ void operator()(f32x4 (&acc)[2][2][4][2], const pg8::Unit& u, int wr, int wc, int fr, int fq) const {
        const int wid = wr * 4 + wc, lane = fq * 16 + fr; LAS float* S = tab + 1024;
        st1.run(acc, u, wr, wc, fr, fq, tab, S, wid, lane);
        const int col0 = u.pn * 256 + wc * 32 + 8 * fq, rt0 = wr * 64 + fr, v = (u.pm * 256) >> 12;
        const unsigned e0 = (unsigned)((u.pm * 256 + rt0) * D + col0);
        const float* mv = mod + (size_t)v * 9216;
#pragma unroll
        for (int bj = 0; bj < 2; ++bj) {
            const unsigned cb = (unsigned)(col0 + bj * 128) * 4u;
            f32x4 g0 = ldg<f32x4>(g3, cb), g1 = ldg<f32x4>(g3, cb + 16); const f32x4 t0 = ldg<f32x4>(mv + 5 * 1024, cb), t1 = ldg<f32x4>(mv + 5 * 1024, cb + 16);
            g0 = g0 * t0; g1 = g1 * t1;
            ROWGROUPS(ai, m) { const float rs = S[ai * 128 + m * 16 + rt0]; const unsigned e = e0 + (unsigned)((ai * 128 + m * 16) * D) + bj * 128;
                const u32x4 dd = ldg<u32x4>(D1, e * 2u);
                f32x4 d0, d1;
                d0[0] = bflo(dd[0]); d0[1] = bfhi(dd[0]); d0[2] = bflo(dd[1]); d0[3] = bfhi(dd[1]); d1[0] = bflo(dd[2]); d1[1] = bfhi(dd[2]); d1[2] = bflo(dd[3]); d1[3] = bfhi(dd[3]);
                d0 = d0 + acc[ai][bj][m][0] * rs * g0; d1 = d1 + acc[ai][bj][m][1] * rs * g1;
                const u32x4 pk = pack8(d0, d1); stg(D12, e * 2u, pk);
                const f32x4 x0 = ldg<f32x4>(x, e * 4u), x1 = ldg<f32x4>(x, e * 4u + 16);
                f32x4 h0, h1;
                h0[0] = x0[0] + bflo(pk[0]); h0[1] = x0[1] + bfhi(pk[0]); h0[2] = x0[2] + bflo(pk[1]); h0[3] = x0[3] + bfhi(pk[1]);
                h1[0] = x1[0] + bflo(pk[2]); h1[1] = x1[1] + bfhi(pk[2]); h1[2] = x1[2] + bflo(pk[3]); h1[3] = x1[3] + bfhi(pk[3]);
                acc[ai][bj][m][0] = h0; acc[ai][bj][m][1] = h1;
                asm volatile("" ::: "memory"); } }
        st2.run(acc, u, wr, wc, fr, fq, tab, S, wid, lane);
#pragma unroll
        for (int bj = 0; bj < 2; ++bj) {
            const unsigned cb = (unsigned)(col0 + bj * 128) * 4u;
            f32x4 g0 = ldg<f32x4>(g4, cb), g1 = ldg<f32x4>(g4, cb + 16); const f32x4 c0 = ldg<f32x4>(mv + 7 * 1024, cb), c1 = ldg<f32x4>(mv + 7 * 1024, cb + 16);
            const f32x4 s0 = ldg<f32x4>(mv + 6 * 1024, cb), s1 = ldg<f32x4>(mv + 6 * 1024, cb + 16);
            g0 = g0 * (c0 + 1.0f); g1 = g1 * (c1 + 1.0f);
            ROWGROUPS(ai, m) { const float rs = S[ai * 128 + m * 16 + rt0]; const unsigned e = e0 + (unsigned)((ai * 128 + m * 16) * D) + bj * 128;
                stg(U3, e * 2u, pack8(acc[ai][bj][m][0] * rs * g0 + s0, acc[ai][bj][m][1] * rs * g1 + s1)); } }
    }
};

struct Frame { LAS unsigned char* lds; int tid, lane, wave, gw, ngw; };

__device__ __forceinline__ void transpose_item(const float* W, int K, int Nsrc, bf16* WT, int dst_row0, int src_col0, int k0, LAS float* scr, int lane, float scale = 1.0f) {
    float tv[32];
    { const float* wp = W + (size_t)(k0 + (lane >> 5)) * Nsrc + src_col0 + (lane & 31);
#pragma unroll
      for (int i = 0; i < 32; ++i) tv[i] = __builtin_nontemporal_load(wp + (size_t)(2 * i) * Nsrc); }
#pragma unroll
    for (int i = 0; i < 32; ++i) scr[(2 * i + (lane >> 5)) * 33 + (lane & 31)] = tv[i] * scale;
    LDS_WAIT(); asm volatile("" ::: "memory");
    const int c = lane & 7;
#pragma unroll
    for (int j = 0; j < 4; ++j) { const int n = (lane >> 3) + 8 * j; const LAS float* s = scr + (8 * c) * 33 + n;
        u32x4 o; o.x = pk2(s[0 * 33], s[1 * 33]); o.y = pk2(s[2 * 33], s[3 * 33]); o.z = pk2(s[4 * 33], s[5 * 33]); o.w = pk2(s[6 * 33], s[7 * 33]);
        *(u32x4*)(WT + (size_t)(dst_row0 + n) * K + k0 + 8 * c) = o; }
    LDS_WAIT(); asm volatile("" ::: "memory");
}
__device__ __forceinline__ void conv_w13(const Frame& F, const float* w13, bf16* dst, int it0, int its) {
    LAS float* scr = (LAS float*)(F.lds + F.wave * 16384);
    for (int it = it0 + F.gw; it < it0 + its; it += F.ngw) { const int r = it, kb = r / 176, nb = r % 176, n0 = 32 * nb, j = n0 >> 8, s = (n0 >> 7) & 1, i0 = n0 & 127;
        transpose_item(w13, D, 2 * FF, dst, n0, s * FF + 128 * j + i0, 64 * kb, scr, F.lane, s ? 0.6931471805599453f : 1.4426950408889634f); }
}
__device__ __forceinline__ void conv_plain(const Frame& F, const float* W, int K, int N, bf16* dst, int it0, int its) {
    LAS float* scr = (LAS float*)(F.lds + F.wave * 16384);
    const int nblk = N / 32;
    for (int it = it0 + F.gw; it < it0 + its; it += F.ngw) { const int r = it, kb = r / nblk, nb = r % nblk;
        transpose_item(W, K, N, dst, 32 * nb, 32 * nb, 64 * kb, scr, F.lane); }
}
__device__ __forceinline__ int win_src_col(int n0) {
    if (n0 < ROW_K) return COL_Q + n0;
    if (n0 < ROW_V) return COL_K + (n0 - ROW_K);
    if (n0 < ROW_F) return COL_V + (n0 - ROW_V);
    if (n0 < ROW_O) return COL_F + (n0 - ROW_F);
    if (n0 < ROW_GF) return COL_O + (n0 - ROW_O);
    { const int r = n0 - ROW_GF, j = r >> 8, sg = (r >> 7) & 1, i0 = r & 127; return (sg ? COL_GM : COL_GF) + 128 * j + i0; }
}
__device__ __forceinline__ void conv_win(const Frame& F, const float* w_in, bf16* dst, int it0, int its) {
    LAS float* scr = (LAS float*)(F.lds + F.wave * 16384);
    constexpr int nblk = WIN_ROWS / 32;
    for (int it = it0 + F.gw; it < it0 + its; it += F.ngw) { const int r = it, kb = r / nblk, nb = r % nblk;
        transpose_item(w_in, D, INW, dst, 32 * nb, win_src_col(32 * nb), 64 * kb, scr, F.lane); }
}

__device__ __forceinline__ void ada_phase(const Frame& F, const Params& p) {
    LAS float* sc = (LAS float*)F.lds;
    LAS float* part = sc + 5 * 1024;
    float* mod = (float*)(p.ws + WS_MOD);
    for (int i = F.tid; i < 5 * 1024; i += NTHR) { const int v = i >> 10, k = i & 1023; const float cv = v < 4 ? p.c[v * 1024 + k] : p.c_ctx[k]; sc[i] = siluf_(cv); }
    __syncthreads();
    for (int tile = blockIdx.x; tile < 144; tile += gridDim.x) {
        const int col = 64 * tile + F.lane;
        float a0 = 0.f, a1 = 0.f, a2 = 0.f, a3 = 0.f, a4 = 0.f;
#pragma unroll 32
        for (int it = 0; it < 128; ++it) { const int k = 128 * F.wave + it; const float w = __builtin_nontemporal_load(p.w_ada + (size_t)k * 9216 + col);
            a0 += sc[k] * w; a1 += sc[1024 + k] * w; a2 += sc[2048 + k] * w; a3 += sc[3072 + k] * w; a4 += sc[4096 + k] * w; }
        { LAS float* pp = part + F.wave * 320 + F.lane; pp[0] = a0; pp[64] = a1; pp[128] = a2; pp[192] = a3; pp[256] = a4; }
        __syncthreads();
        if (F.tid < 320) { float s = 0.f;
#pragma unroll
            for (int w = 0; w < 8; ++w) s += part[w * 320 + F.tid];
            const int v = F.tid >> 6, cc = 64 * tile + (F.tid & 63); mod[v * 9216 + cc] = s + p.b_ada[cc]; }
        __syncthreads();
    }
}
__device__ __forceinline__ void wfour_phase(const Frame& F, const Params& p) {
    LAS float* ct = (LAS float*)(F.lds + 32768);
    if (F.tid < 128) ct[F.tid] = cosf((float)F.tid * (6.283185307179586f / 128.0f));
    __syncthreads();
    bf16* WF = (bf16*)(p.ws + WS_WFOUR);
    for (int task = blockIdx.x * NTHR + F.tid; task < 1024 * 128; task += gridDim.x * NTHR) {
        const int n = task & 1023, jg = task >> 10, i = jg >> 1, pq = jg & 1, f0 = 8 * i, g = f0 >> 7, ch0 = f0 & 127;
        float a[8];
#pragma unroll
        for (int t = 0; t < 8; ++t) a[t] = 0.f;
        const float* wp = p.w_four + (size_t)(g * 128) * 1024 + n;
        const int sh = pq ? 96 : 0;
#pragma unroll 8
        for (int k3 = 0; k3 < 128; ++k3) { const float w = wp[(size_t)k3 * 1024];
#pragma unroll
            for (int t = 0; t < 8; ++t) a[t] += ct[(k3 * (ch0 + t) + sh) & 127] * w; }
        const float scl = pq ? -0.08838834764831845f : 0.08838834764831845f;
        u32x4 o; o.x = pk2(a[0] * scl, a[1] * scl); o.y = pk2(a[2] * scl, a[3] * scl); o.z = pk2(a[4] * scl, a[5] * scl); o.w = pk2(a[6] * scl, a[7] * scl);
        *(u32x4*)(WF + (size_t)n * 1024 + 8 * jg) = o;
    }
    __syncthreads();
}

struct Row { f32x4 v[4]; };
__device__ __forceinline__ Row ld_row_f32(const float* r, int lane) { Row o; const f32x4* q = (const f32x4*)r + lane;
#pragma unroll
    for (int j = 0; j < 4; ++j) o.v[j] = q[64 * j]; return o; }
__device__ __forceinline__ Row ld_row_bf16(const bf16* r, int lane) { Row o; const u32x2* q = (const u32x2*)r + lane;
#pragma unroll
    for (int j = 0; j < 4; ++j) { const u32x2 w = q[64 * j]; o.v[j] = (f32x4){bflo(w.x), bfhi(w.x), bflo(w.y), bfhi(w.y)}; } return o; }
__device__ __forceinline__ void st_row_bf16(bf16* r, int lane, const Row& a) { u32x2* q = (u32x2*)r + lane;
#pragma unroll
    for (int j = 0; j < 4; ++j) { u32x2 w; w.x = pk2(a.v[j][0], a.v[j][1]); w.y = pk2(a.v[j][2], a.v[j][3]); q[64 * j] = w; } }
__device__ __forceinline__ void st_row_f32(float* r, int lane, const Row& a) { f32x4* q = (f32x4*)r + lane;
#pragma unroll
    for (int j = 0; j < 4; ++j) q[64 * j] = a.v[j]; }
__device__ __forceinline__ float row_rstd(const Row& a) { float s = 0.f;
#pragma unroll
    for (int j = 0; j < 4; ++j) s += (a.v[j][0] * a.v[j][0] + a.v[j][1] * a.v[j][1]) + (a.v[j][2] * a.v[j][2] + a.v[j][3] * a.v[j][3]);
    return rsqrtf(wave_sum(s) * (1.0f / 1024.0f) + EPS); }
__device__ __forceinline__ Row round_bf16(const Row& a) { Row o;
#pragma unroll
    for (int j = 0; j < 4; ++j)
#pragma unroll
        for (int e = 0; e < 4; ++e) o.v[j][e] = bf2f(f2bf(a.v[j][e]));
    return o; }
__device__ __forceinline__ Row modnorm2(const Row& h, const Row& gs, const Row& sh) {
    const float rs = row_rstd(h); Row o;
#pragma unroll
    for (int j = 0; j < 4; ++j) o.v[j] = h.v[j] * rs * gs.v[j] + sh.v[j];
    return o; }
__device__ __forceinline__ Row gated_norm2(const Row& y, const Row& gg) {
    const float rs = row_rstd(y); Row o;
#pragma unroll
    for (int j = 0; j < 4; ++j) o.v[j] = y.v[j] * rs * gg.v[j];
    return o; }
__device__ __forceinline__ Row rmul(const Row& a, const Row& b) { Row o;
#pragma unroll
    for (int j = 0; j < 4; ++j) o.v[j] = a.v[j] * b.v[j]; return o; }
__device__ __forceinline__ Row rmul1p(const Row& g, const Row& sc) { Row o;
#pragma unroll
    for (int j = 0; j < 4; ++j) o.v[j] = g.v[j] * (sc.v[j] + 1.0f); return o; }
__device__ __forceinline__ Row rscale(const Row& a, float c) { Row o;
#pragma unroll
    for (int j = 0; j < 4; ++j) o.v[j] = a.v[j] * c; return o; }
__device__ __forceinline__ Row radd(const Row& a, const Row& b) { Row o;
#pragma unroll
    for (int j = 0; j < 4; ++j) o.v[j] = a.v[j] + b.v[j]; return o; }
__device__ __forceinline__ const float* modp(const Params& p, int v, int i) { return (const float*)(p.ws + WS_MOD) + (size_t)v * 9216 + i * 1024; }
__device__ __forceinline__ const float* xrow(const Params& p, int r) { return r < TLAT ? p.x + (size_t)r * D : p.ctx + (size_t)(r - TLAT) * D; }
__device__ __forceinline__ int rowvar(int r) { return r < TLAT ? (r >> 12) : 4; }

__device__ __forceinline__ int row_of(const Frame& F, int it) {
    const int per = F.ngw >> 2, nl = (SEQ + per - 1) / per;
    if (it < nl) { const int rl = (F.gw >> 2) + it * per; if (rl < SEQ) return (F.gw & 3) * SEQ + rl; it = nl; }
    const int rc = F.gw + (it - nl) * F.ngw; return rc < TCTX ? TLAT + rc : -1;
}
__device__ __forceinline__ int lat_row(const Frame& F, int k) { const int rl = (F.gw >> 2) + k * (F.ngw >> 2); return rl < SEQ ? (F.gw & 3) * SEQ + rl : -1; }
__device__ __forceinline__ void phase_u1(const Frame& F, const Params& p) {
    bf16* U = (bf16*)(p.ws + WS_U);
    { const int v = F.gw & 3; const Row gs = rmul1p(ld_row_f32(p.norm_g, F.lane), ld_row_f32(modp(p, v, 1), F.lane)), sh = ld_row_f32(modp(p, v, 0), F.lane);
      for (int k0 = 0; lat_row(F, k0) >= 0; k0 += 4) { Row xr[4]; int rr[4];
#pragma unroll
          for (int q = 0; q < 4; ++q) { rr[q] = lat_row(F, k0 + q); if (rr[q] >= 0) xr[q] = ld_row_f32(p.x + (size_t)rr[q] * D, F.lane); }
#pragma unroll
          for (int q = 0; q < 4; ++q) if (rr[q] >= 0) st_row_bf16(U + (size_t)rr[q] * D, F.lane, modnorm2(xr[q], gs, sh)); } }
    { const Row gs = rmul1p(ld_row_f32(p.norm_g, F.lane), ld_row_f32(modp(p, 4, 1), F.lane)), sh = ld_row_f32(modp(p, 4, 0), F.lane);
      for (int rc = F.gw; rc < TCTX; rc += F.ngw) st_row_bf16(U + (size_t)(TLAT + rc) * D, F.lane, modnorm2(ld_row_f32(p.ctx + (size_t)rc * D, F.lane), gs, sh)); }
}
__device__ __forceinline__ void phase_post_ffn_a(const Frame& F, const Params& p) {
    bf16* U = (bf16*)(p.ws + WS_U2); bf16* D1 = (bf16*)((unsigned char*)p.out + DO_D1); const bf16* Y1 = (const bf16*)(p.ws + WS_Y1);
    { const int v = F.gw & 3; const Row gg = rscale(rmul(ld_row_f32(p.norm_g + 1 * D, F.lane), ld_row_f32(modp(p, v, 2), F.lane)), 0.5f);
      const Row gs = rmul1p(ld_row_f32(p.norm_g + 2 * D, F.lane), ld_row_f32(modp(p, v, 4), F.lane)), sh = ld_row_f32(modp(p, v, 3), F.lane);
      for (int k0 = 0; lat_row(F, k0) >= 0; k0 += 4) { Row xr[4], yr[4]; int rr[4];
#pragma unroll
          for (int q = 0; q < 4; ++q) { rr[q] = lat_row(F, k0 + q); if (rr[q] >= 0) { yr[q] = ld_row_bf16(Y1 + (size_t)rr[q] * D, F.lane); xr[q] = ld_row_f32(p.x + (size_t)rr[q] * D, F.lane); } }
#pragma unroll
          for (int q = 0; q < 4; ++q) if (rr[q] >= 0) { const Row dl = round_bf16(gated_norm2(yr[q], gg)); st_row_bf16(D1 + (size_t)rr[q] * D, F.lane, dl);
              st_row_bf16(U + (size_t)rr[q] * D, F.lane, modnorm2(radd(xr[q], dl), gs, sh)); } } }
    { const Row gg = rscale(rmul(ld_row_f32(p.norm_g + 1 * D, F.lane), ld_row_f32(modp(p, 4, 2), F.lane)), 0.5f);
      const Row gs = rmul1p(ld_row_f32(p.norm_g + 2 * D, F.lane), ld_row_f32(modp(p, 4, 4), F.lane)), sh = ld_row_f32(modp(p, 4, 3), F.lane);
      for (int rc = F.gw; rc < TCTX; rc += F.ngw) { const float* yc = (const float*)(p.ws + WS_Y1C) + (size_t)rc * D;
          Row y = radd(radd(ld_row_f32(yc, F.lane), ld_row_f32(yc + (size_t)TCTX * D, F.lane)), radd(ld_row_f32(yc + (size_t)2 * TCTX * D, F.lane), ld_row_f32(yc + (size_t)3 * TCTX * D, F.lane)));
          y = radd(y, radd(radd(ld_row_f32(yc + (size_t)4 * TCTX * D, F.lane), ld_row_f32(yc + (size_t)5 * TCTX * D, F.lane)), radd(ld_row_f32(yc + (size_t)6 * TCTX * D, F.lane), ld_row_f32(yc + (size_t)7 * TCTX * D, F.lane))));
          const Row dl = round_bf16(gated_norm2(y, gg));
          st_row_bf16(U + (size_t)(TLAT + rc) * D, F.lane, modnorm2(radd(ld_row_f32(p.ctx + (size_t)rc * D, F.lane), dl), gs, sh)); } }
}
__device__ __forceinline__ void phase_u2_again(const Frame& F, const Params& p) {
    bf16* U = (bf16*)(p.ws + WS_U); const bf16* D1 = (const bf16*)((unsigned char*)p.out + DO_D1);
    const int v = F.gw & 3; const Row gs = rmul1p(ld_row_f32(p.norm_g + 2 * D, F.lane), ld_row_f32(modp(p, v, 4), F.lane)), sh = ld_row_f32(modp(p, v, 3), F.lane);
    for (int k0 = 0; lat_row(F, k0) >= 0; k0 += 4) { Row xr[4], dr[4]; int rr[4];
#pragma unroll
        for (int q = 0; q < 4; ++q) { rr[q] = lat_row(F, k0 + q); if (rr[q] >= 0) { xr[q] = ld_row_f32(p.x + (size_t)rr[q] * D, F.lane); dr[q] = ld_row_bf16(D1 + (size_t)rr[q] * D, F.lane); } }
#pragma unroll
        for (int q = 0; q < 4; ++q) if (rr[q] >= 0) st_row_bf16(U + (size_t)rr[q] * D, F.lane, modnorm2(radd(xr[q], dr[q]), gs, sh)); }
}

constexpr int SQK_STRIDE = 544;
constexpr int M1_SQ = 0, M1_SK = 128 * SQK_STRIDE, M1_TAB = 2 * 128 * SQK_STRIDE;
__device__ __forceinline__ float logsigmoidf_(float x) { return fminf(x, 0.f) - log1pf(__expf(-fabsf(x))); }

__device__ __forceinline__ void m1_item(const Frame& F, const Params& p, int bh, int cp) {
    const int b = bh >> 2, h = bh & 3; const bool is_lat = cp >= 2;
    const int seqlen = is_lat ? SEQ : CTXL, t0 = is_lat ? CH * (cp - 2) : CH * cp, rowbase = is_lat ? b * SEQ : TLAT + b * CTXL, pbase = CH * cp;
    const bf16* QPRE = (const bf16*)(p.ws + WS_QPRE); const bf16* KPRE = (const bf16*)(p.ws + WS_KPRE);
    LAS unsigned char* sQ = F.lds + M1_SQ; LAS unsigned char* sK = F.lds + M1_SK; LAS float* tab = (LAS float*)(F.lds + M1_TAB);
    const int lane = F.lane, w = F.wave, fr = lane & 15, fq = lane >> 4;
    {
        const int ch = 8 * (F.tid & 31), rb = 8 * (F.tid >> 5);
#define M1_CONV(SRC, CCH, SCALE, DST) do { \
        float w0[8], w1[8], w2[8], bb[8]; \
        _Pragma("unroll") for (int e = 0; e < 8; ++e) { const int cc = (CCH) + h * 256 + ch + e; w0[e] = p.conv_w[cc]; w1[e] = p.conv_w[2048 + cc]; w2[e] = p.conv_w[4096 + cc]; bb[e] = p.conv_b[cc]; } \
        u32x4 xr[10]; const bf16* base = (SRC) + (size_t)(rowbase + t0 + rb) * D + h * 256 + ch; \
        _Pragma("unroll") for (int i = 0; i < 10; ++i) { const int sq = t0 + rb + i - 1; xr[i] = (sq >= 0 && sq < seqlen) ? *(const u32x4*)(base + (ptrdiff_t)(i - 1) * D) : (u32x4){0u, 0u, 0u, 0u}; } \
        _Pragma("unroll") for (int i = 0; i < 8; ++i) { float o[8]; \
            _Pragma("unroll") for (int q = 0; q < 4; ++q) { \
                const float y0 = w0[2 * q] * bflo(xr[i][q]) + w1[2 * q] * bflo(xr[i + 1][q]) + w2[2 * q] * bflo(xr[i + 2][q]) + bb[2 * q]; \
                const float y1 = w0[2 * q + 1] * bfhi(xr[i][q]) + w1[2 * q + 1] * bfhi(xr[i + 1][q]) + w2[2 * q + 1] * bfhi(xr[i + 2][q]) + bb[2 * q + 1]; \
                o[2 * q] = siluf_(y0) * (SCALE); o[2 * q + 1] = siluf_(y1) * (SCALE); } \
            u32x4 wv; wv.x = pk2(o[0], o[1]); wv.y = pk2(o[2], o[3]); wv.z = pk2(o[4], o[5]); wv.w = pk2(o[6], o[7]); \
            *(LAS u32x4*)((DST) + (rb + i) * SQK_STRIDE + ch * 2) = wv; } } while (0)
        M1_CONV(KPRE, 1024, 0.0625f, sK);
        if (is_lat) M1_CONV(QPRE, 0, 1.0f, sQ);
#undef M1_CONV
    }
    if (w < 2) {
        const int dir = w; const float* G = (const float*)(p.ws + WS_GATES);
        const int i0 = 2 * lane, i1 = 2 * lane + 1, ta = dir ? 127 - i0 : i0, tb = dir ? 127 - i1 : i1;
        const float li0 = G[(size_t)(rowbase + t0 + ta) * 16 + dir * 8 + h], li1 = G[(size_t)(rowbase + t0 + tb) * 16 + dir * 8 + h];
        const float lf0 = logsigmoidf_(G[(size_t)(rowbase + t0 + ta) * 16 + dir * 8 + 4 + h]), lf1 = logsigmoidf_(G[(size_t)(rowbase + t0 + tb) * 16 + dir * 8 + 4 + h]);
        float ps = lf0 + lf1;
#pragma unroll
        for (int o = 1; o < 64; o <<= 1) { const float v = __shfl_up(ps, o); if (lane >= o) ps += v; }
        const float ex = ps - (lf0 + lf1), b0 = ex + lf0, b1 = ex + lf0 + lf1;
        const float r0 = li0 - b0, r1 = li1 - b1;
        float pm = fmaxf(r0, r1);
#pragma unroll
        for (int o = 1; o < 64; o <<= 1) { const float v = __shfl_up(pm, o); if (lane >= o) pm = fmaxf(pm, v); }
        const float pmex = __shfl_up(pm, 1); const float m0 = lane ? fmaxf(pmex, r0) : r0, m1 = pm;
        LAS float* tb_ = tab + dir * 384;
        tb_[ta] = b0; tb_[128 + ta] = r0; tb_[256 + ta] = m0; tb_[tb] = b1; tb_[128 + tb] = r1; tb_[256 + tb] = m1;
        float* TS = (float*)(p.ws + WS_TOKSC) + ((size_t)(dir * 16 + bh) * PLEN + pbase) * 4;
        TS[ta * 4 + 0] = b0; TS[ta * 4 + 1] = li0; TS[ta * 4 + 2] = b0 + m0; TS[tb * 4 + 0] = b1; TS[tb * 4 + 1] = li1; TS[tb * 4 + 2] = b1 + m1;
        if (lane == 63) { float* CS = (float*)(p.ws + WS_CHSC) + ((size_t)(dir * 16 + bh) * NCHK + cp) * 2; CS[0] = b1; CS[1] = b1 + m1; }
    }
    __syncthreads();
    {
        u32x4* KT = (u32x4*)(p.ws + WS_KT) + ((size_t)bh * NCHK + cp) * 4096;
        const int d = F.tid & 255, sgp = F.tid >> 8;
#pragma unroll
        for (int it = 0; it < 8; ++it) { const int sg = 2 * it + sgp; unsigned short e[8];
#pragma unroll
            for (int j = 0; j < 8; ++j) e[j] = *(const LAS unsigned short*)(sK + (8 * sg + j) * SQK_STRIDE + d * 2);
            u32x4 o; o.x = e[0] | ((unsigned)e[1] << 16); o.y = e[2] | ((unsigned)e[3] << 16); o.z = e[4] | ((unsigned)e[5] << 16); o.w = e[6] | ((unsigned)e[7] << 16);
            KT[((((d >> 5) * 2 + ((d >> 4) & 1)) * 4 + (sg >> 2)) * 64) + (sg & 3) * 16 + (d & 15)] = o; }
        if (is_lat) { u32x4* Q = (u32x4*)(p.ws + WS_Q) + ((size_t)bh * 32 + (cp - 2)) * 4096;
#pragma unroll
            for (int it = 0; it < 8; ++it) { const int piece = F.tid + 512 * it, row = piece >> 5, c16 = piece & 31;
                Q[((row >> 4) * 8 + (c16 >> 2)) * 64 + (c16 & 3) * 16 + (row & 15)] = *(const LAS u32x4*)(sQ + row * SQK_STRIDE + c16 * 16); } }
    }
    if (is_lat) {
        bf16x8 bq[8];
#pragma unroll
        for (int k = 0; k < 8; ++k) bq[k] = *(const LAS bf16x8*)(sQ + (16 * w + fr) * SQK_STRIDE + (32 * k + 8 * fq) * 2);
        f32x4 acc[8];
#pragma unroll
        for (int mt = 0; mt < 8; ++mt) { acc[mt] = (f32x4){0.f, 0.f, 0.f, 0.f};
#pragma unroll
            for (int k = 0; k < 8; ++k) { const bf16x8 a = *(const LAS bf16x8*)(sK + (16 * mt + fr) * SQK_STRIDE + (32 * k + 8 * fq) * 2);
                acc[mt] = __builtin_amdgcn_mfma_f32_16x16x32_bf16(a, bq[k], acc[mt], 0, 0, 0); } }
        const int t = 16 * w + fr, c = cp - 2;
        bf16* P = (bf16*)((unsigned char*)p.out + DO_P);
#pragma unroll
        for (int dir = 0; dir < 2; ++dir) {
            const LAS float* tb_ = tab + dir * 384; const float mx = tb_[256 + t]; float dsum = 0.f;
            unsigned char* pblk = (unsigned char*)(P + ((size_t)(dir * 16 + bh) * 32 + c) * 128 * 128);
#pragma unroll
            for (int mt = 0; mt < 8; ++mt) { const int s0 = 16 * mt + 4 * fq; const f32x4 rs = *(const LAS f32x4*)(tb_ + 128 + s0); float pv[4];
#pragma unroll
                for (int r = 0; r < 4; ++r) { const int s = s0 + r; const bool valid = dir ? (s >= t) : (s <= t);
                    const float wgt = valid ? __expf(fminf(rs[r] - mx, 0.f)) : 0.f; pv[r] = bf2f(f2bf(acc[mt][r] * wgt)); dsum += pv[r]; }
                u32x2 o; o.x = pk2(pv[0], pv[1]); o.y = pk2(pv[2], pv[3]); const int s8 = 2 * mt + (fq >> 1);
                *(u32x2*)(pblk + ((w * 4 + (s8 >> 2)) * 64 + (s8 & 3) * 16 + fr) * 16 + (fq & 1) * 8) = o; }
            dsum += __shfl_xor(dsum, 16); dsum += __shfl_xor(dsum, 32);
            if (fq == 0) ((float*)(p.ws + WS_TOKSC))[((size_t)(dir * 16 + bh) * PLEN + pbase + t) * 4 + 3] = dsum;
        }
    }
    __syncthreads();
}

constexpr int FO_TAB = 131072;
__device__ __forceinline__ int fo_off(int R, int r) { return R * 128 + ((((r >> 3) ^ ((R >> 1) & 7))) << 4) + (r & 7) * 2; }
__device__ __forceinline__ void fourier_item(const Frame& F, const Params& p, int item) {
    const int b = item >> 6, i = item & 63; const int lane = F.lane, w = F.wave, fr = lane & 15, fq = lane >> 4;
    LAS unsigned char* sPQ = F.lds; LAS float* ct = (LAS float*)(F.lds + FO_TAB);
    if (F.tid < 64) ct[F.tid] = cosf((float)F.tid * (6.283185307179586f / 64.0f));
    __syncthreads();
    const bf16* XT = (const bf16*)(p.ws + WS_XFT);
    {
        const bf16* xrow_ = XT + (size_t)(8 * i + w) * TLAT + b * SEQ;
        bf16x8 xv[4][2];
#pragma unroll
        for (int nt = 0; nt < 4; ++nt) { const int r = 16 * nt + fr; xv[nt][0] = *(const bf16x8*)(xrow_ + r * 64 + 8 * fq); xv[nt][1] = *(const bf16x8*)(xrow_ + r * 64 + 32 + 8 * fq); }
#pragma unroll 1
        for (int mt = 0; mt < 8; ++mt) {
            bf16x8 WA[2];
#pragma unroll
            for (int k = 0; k < 2; ++k) { const int kc = (16 * mt + fr) & 63, sh = (mt >> 2) * 48; bf16x8 v;
#pragma unroll
                for (int j = 0; j < 8; ++j) { const int c = 32 * k + 8 * fq + j; v[j] = (short)f2bf(ct[(kc * c + sh) & 63]); }
                WA[k] = v; }
#pragma unroll
            for (int nt = 0; nt < 4; ++nt) { const int r = 16 * nt + fr; f32x4 a = (f32x4){0.f, 0.f, 0.f, 0.f};
                a = __builtin_amdgcn_mfma_f32_16x16x32_bf16(WA[0], xv[nt][0], a, 0, 0, 0); a = __builtin_amdgcn_mfma_f32_16x16x32_bf16(WA[1], xv[nt][1], a, 0, 0, 0);
#pragma unroll
                for (int rg = 0; rg < 4; ++rg) { const int kcp = 16 * mt + 4 * fq + rg; *(LAS unsigned short*)(sPQ + fo_off(kcp * 8 + w, r)) = (unsigned short)f2bf(a[rg]); } } }
    }
    __syncthreads();
    {
        bf16x8 WB[4];
        const int kr = (16 * w + fr) & 63, half = w >> 2;
#pragma unroll
        for (int ks = 0; ks < 4; ++ks) { const int pq = ks >> 1; unsigned short e[8];
#pragma unroll
            for (int j = 0; j < 8; ++j) { const int r = 32 * (ks & 1) + 8 * fq + j;
                float v; if (half == pq) v = ct[(kr * r) & 63]; else { v = ct[(kr * r + 48) & 63]; if (half == 0) v = -v; }
                e[j] = (unsigned short)f2bf(v * 0.015625f); }
            bf16x8 v; v[0] = (short)e[0]; v[1] = (short)e[1]; v[2] = (short)e[2]; v[3] = (short)e[3]; v[4] = (short)e[4]; v[5] = (short)e[5]; v[6] = (short)e[6]; v[7] = (short)e[7]; WB[ks] = v; }
        bf16* UF = (bf16*)(p.ws + WS_UF) + (size_t)(b * SEQ + (16 * (w & 3) + fr) * 64) * D + 16 * i + 8 * half + 4 * (fq & 1);
#pragma unroll 2
        for (int nt = 0; nt < 32; ++nt) { f32x4 a = (f32x4){0.f, 0.f, 0.f, 0.f};
#pragma unroll
            for (int ks = 0; ks < 4; ++ks) { const int R = (ks >> 1) * 512 + 16 * nt + fr, q = 4 * (ks & 1) + fq;
                const bf16x8 bb = *(const LAS bf16x8*)(sPQ + R * 128 + ((q ^ ((R >> 1) & 7)) << 4));
                a = __builtin_amdgcn_mfma_f32_16x16x32_bf16(bb, WB[ks], a, 0, 0, 0); }
            u32x2 o; o.x = pk2(a[0], a[1]); o.y = pk2(a[2], a[3]);
            *(u32x2*)(UF + (size_t)(2 * nt + (fq >> 1)) * D) = o; }
    }
    __syncthreads();
}

constexpr int M2_CT = 0, M2_CTB = 48 * 544, M2_VT = 2 * M2_CTB, M2_VTB = 32 * 288, M2_VW = M2_VT + 2 * M2_VTB, M2_VWB = 48 * 288, M2_TAB = M2_VW + 2 * M2_VWB, M2_TABB = 5 * 512, M2_SC = M2_TAB + 3 * M2_TABB, M2_HS = M2_SC + 1024;
struct M2Step { int cp, is_lat, p0, tl0, tokrow0; };
__device__ __forceinline__ M2Step m2_step(int dir, int b, int j) {
    M2Step s; const int jj = j < NCHK ? j : NCHK - 1;
    s.cp = dir ? (jj == 0 ? 1 : (jj == 1 ? 0 : 35 - jj)) : jj; s.is_lat = s.cp >= 2; s.p0 = CH * s.cp; s.tl0 = s.is_lat ? CH * (s.cp - 2) : 0;
    s.tokrow0 = s.is_lat ? b * SEQ + s.tl0 : TLAT + b * CTXL + CH * s.cp; return s;
}
__device__ __forceinline__ void m2_stream(const Frame& F, const Params& p, int sid) {
    const int x = sid & 7, jj_ = sid >> 3, gl = jj_ >> 3, slice = jj_ & 7, g = x + 8 * gl, dir = g >> 4, bh = g & 15, b = bh >> 2, h = bh & 3;
    int tid = F.tid; asm volatile("" : "+v"(tid)); const int lane = tid & 63, w = F.wave, fr = lane & 15, fq = lane >> 4, wa = w & 3, tr = tid & 255;
    const bool roleA = w < 4;
    LAS unsigned char* L = F.lds;
    LAS float* smst = (LAS float*)(L + M2_SC); LAS float* smnw = smst + 34; LAS float* sdec = smst + 68; LAS float* scs = smst + 102;
    const float* TS = (const float*)(p.ws + WS_TOKSC) + (size_t)(dir * 16 + bh) * PLEN * 4;
    const float* CS = (const float*)(p.ws + WS_CHSC) + (size_t)(dir * 16 + bh) * NCHK * 2;
    const bf16* VT = (const bf16*)(p.ws + WS_VT) + (size_t)(h * 256 + slice * 32 + (tr >> 4)) * MTOK + 8 * (tr & 15);
    const bf16x8* KT = (const bf16x8*)(p.ws + WS_KT) + (size_t)bh * NCHK * 4096 + wa * 1024 + lane;
    const bf16x8* Q = (const bf16x8*)(p.ws + WS_Q) + (size_t)bh * 32 * 4096 + wa * 1024 + lane;
    const bf16x8* P = (const bf16x8*)((const unsigned char*)p.out + DO_P) + (size_t)(dir * 16 + bh) * 32 * 2048 + wa * 512 + lane;
    bf16* H = (bf16*)(p.ws + (dir ? WS_HB : WS_HF)) + (size_t)(b * SEQ) * D + h * 256 + slice * 32;
    for (int i = tid; i < M2_TAB / 4; i += NTHR) ((LAS unsigned*)L)[i] = 0u;
    if (tid < 2 * NCHK) scs[tid] = CS[tid];
    __syncthreads();
    if (tid == 0) { float m = 0.f;
        for (int j = 0; j < NCHK; ++j) { const M2Step st = m2_step(dir, b, j); const float bL = scs[st.cp * 2], gmax = scs[st.cp * 2 + 1];
            const float mn = fmaxf(bL + m, gmax); smst[j] = m; smnw[j] = mn; sdec[j] = __expf(bL + m - mn); m = mn; } }
    __syncthreads();
#define M2_TABLES(jj, stp, sc) do { if (tr < 128 && (jj) < NCHK) { LAS float* tb_ = (LAS float*)(L + M2_TAB + ((jj) % 3) * M2_TABB); const float bL = scs[(stp).cp * 2], mst_ = smst[jj], mnw_ = smnw[jj]; \
        tb_[512 + tr] = __expf(fminf(bL - (sc)[0] + (sc)[1] - mnw_, 0.f)); \
        const float mt_ = fmaxf((sc)[0] + mst_, (sc)[2]); const float c_ = __expf((sc)[2] - mt_); \
        *(LAS f32x4*)(tb_ + 4 * tr) = (f32x4){__expf((sc)[0] + mst_ - mt_), c_, c_ * (sc)[3], __expf(-mt_)}; } } while (0)
#define M2_VSTAGE(jj, va, vb) do { if ((jj) < NCHK) { const LAS float* tb_ = (const LAS float*)(L + M2_TAB + ((jj) % 3) * M2_TABB); const int e = tr >> 4, sg = tr & 15; \
        const f32x4 wa_ = *(const LAS f32x4*)(tb_ + 512 + 8 * sg), wb_ = *(const LAS f32x4*)(tb_ + 516 + 8 * sg); u32x4 o_; \
        *(LAS u32x4*)(L + M2_VT + ((jj) & 1) * M2_VTB + e * 288 + sg * 16) = (va); *(LAS u32x4*)(L + M2_VT + ((jj) & 1) * M2_VTB + (e + 16) * 288 + sg * 16) = (vb); \
        o_[0] = pk2(bflo((va)[0]) * wa_[0], bfhi((va)[0]) * wa_[1]); o_[1] = pk2(bflo((va)[1]) * wa_[2], bfhi((va)[1]) * wa_[3]); o_[2] = pk2(bflo((va)[2]) * wb_[0], bfhi((va)[2]) * wb_[1]); o_[3] = pk2(bflo((va)[3]) * wb_[2], bfhi((va)[3]) * wb_[3]); \
        *(LAS u32x4*)(L + M2_VW + ((jj) & 1) * M2_VWB + e * 288 + sg * 16) = o_; \
        o_[0] = pk2(bflo((vb)[0]) * wa_[0], bfhi((vb)[0]) * wa_[1]); o_[1] = pk2(bflo((vb)[1]) * wa_[2], bfhi((vb)[1]) * wa_[3]); o_[2] = pk2(bflo((vb)[2]) * wb_[0], bfhi((vb)[2]) * wb_[1]); o_[3] = pk2(bflo((vb)[3]) * wb_[2], bfhi((vb)[3]) * wb_[3]); \
        *(LAS u32x4*)(L + M2_VW + ((jj) & 1) * M2_VWB + (e + 16) * 288 + sg * 16) = o_; \
        if (tr < 16) { u32x4 o2; o2[0] = pk2(wa_[0], wa_[1]); o2[1] = pk2(wa_[2], wa_[3]); o2[2] = pk2(wb_[0], wb_[1]); o2[3] = pk2(wb_[2], wb_[3]); \
            *(LAS u32x4*)(L + M2_VW + ((jj) & 1) * M2_VWB + 32 * 288 + tr * 16) = o2; } } } while (0)
#define M2_LDQ(QQ, st) do { const bf16x8* q_ = Q + (size_t)((st).is_lat ? (st).cp - 2 : 0) * 4096; _Pragma("unroll") for (int k = 0; k < 8; ++k) { (QQ)[0][k] = q_[k * 64]; (QQ)[1][k] = q_[(8 + k) * 64]; } } while (0)
#define M2_LDP(st) do { const bf16x8* p_ = P + (size_t)((st).is_lat ? (st).cp - 2 : 0) * 2048; _Pragma("unroll") for (int k = 0; k < 4; ++k) { pa[0][k] = p_[k * 64]; pa[1][k] = p_[(4 + k) * 64]; } } while (0)
#define M2_LDK(KK, st) do { const bf16x8* k_ = KT + (size_t)(st).cp * 4096; _Pragma("unroll") for (int mt = 0; mt < 4; ++mt) _Pragma("unroll") for (int k = 0; k < 4; ++k) (KK)[mt][k] = k_[(mt * 4 + k) * 64]; } while (0)
    const M2Step s0 = m2_step(dir, b, 0), s1 = m2_step(dir, b, 1);
    if (!roleA) { const f32x4 t0 = *(const f32x4*)(TS + (size_t)(s0.p0 + (tr & 127)) * 4), t1 = *(const f32x4*)(TS + (size_t)(s1.p0 + (tr & 127)) * 4);
        M2_TABLES(0, s0, t0); M2_TABLES(1, s1, t1); }
    __syncthreads();
    if (!roleA) { const u32x4 v0a = *(const u32x4*)(VT + s0.tokrow0), v0b = *(const u32x4*)(VT + (size_t)16 * MTOK + s0.tokrow0); M2_VSTAGE(0, v0a, v0b); }
    if (roleA) {
        bf16x8 qa[2][2][8], pa[2][4];
        M2_LDQ(qa[0], s0); M2_LDP(s0);
        __syncthreads();
        for (int jj = 0; jj < NCHK; jj += 2) {
#pragma unroll
          for (int u = 0; u < 2; ++u) { const int j = jj + u;
            const M2Step sj = m2_step(dir, b, j), sn = m2_step(dir, b, j + 1);
            M2_LDQ(qa[u ^ 1], sn);
            if (j > 0) { const M2Step sp = m2_step(dir, b, j - 1);
                if (sp.is_lat) {
#pragma unroll
                    for (int i2 = 0; i2 < 2; ++i2) { const int pc = tr + 256 * i2; const u32x4 hv = *(const LAS u32x4*)(L + M2_HS + ((j - 1) & 1) * 8192 + pc * 16);
                        *(u32x4*)(H + (size_t)(sp.tl0 + (pc >> 2)) * D + (pc & 3) * 8) = hv; } } }
            if (sj.is_lat) {
                const LAS unsigned char* sCT = L + M2_CT + (j & 1) * M2_CTB; const LAS unsigned char* sVT = L + M2_VT + (j & 1) * M2_VTB;
                const LAS float* tb = (const LAS float*)(L + M2_TAB + (j % 3) * M2_TABB);
                f32x4 aI[2][3], aA[2][2];
#pragma unroll
                for (int mt = 0; mt < 2; ++mt) {
#pragma unroll
                    for (int nt = 0; nt < 3; ++nt) aI[mt][nt] = (f32x4){0.f, 0.f, 0.f, 0.f};
                    aA[mt][0] = (f32x4){0.f, 0.f, 0.f, 0.f}; aA[mt][1] = (f32x4){0.f, 0.f, 0.f, 0.f}; }
#pragma unroll
                for (int k = 0; k < 8; ++k)
#pragma unroll
                    for (int nt = 0; nt < 3; ++nt) { const bf16x8 bb = *(const LAS bf16x8*)(sCT + (16 * nt + fr) * 544 + (32 * k + 8 * fq) * 2);
                        aI[0][nt] = __builtin_amdgcn_mfma_f32_16x16x32_bf16(qa[u][0][k], bb, aI[0][nt], 0, 0, 0);
                        aI[1][nt] = __builtin_amdgcn_mfma_f32_16x16x32_bf16(qa[u][1][k], bb, aI[1][nt], 0, 0, 0); }
#pragma unroll
                for (int k = 0; k < 4; ++k)
#pragma unroll
                    for (int nt = 0; nt < 2; ++nt) { const bf16x8 bb = *(const LAS bf16x8*)(sVT + (16 * nt + fr) * 288 + (32 * k + 8 * fq) * 2);
                        aA[0][nt] = __builtin_amdgcn_mfma_f32_16x16x32_bf16(pa[0][k], bb, aA[0][nt], 0, 0, 0);
                        aA[1][nt] = __builtin_amdgcn_mfma_f32_16x16x32_bf16(pa[1][k], bb, aA[1][nt], 0, 0, 0); }
                M2_LDP(sn);
                LAS unsigned short* sH = (LAS unsigned short*)(L + M2_HS + (j & 1) * 8192);
#pragma unroll
                for (int mt = 0; mt < 2; ++mt)
#pragma unroll
                    for (int rg = 0; rg < 4; ++rg) { const int t = 32 * wa + 16 * mt + 4 * fq + rg;
                        const float qn_ = __shfl(aI[mt][2][rg], lane & 48);
                        const f32x4 tv = *(const LAS f32x4*)(tb + 4 * t);
                        const float inv = __builtin_amdgcn_rcpf(fmaxf(fabsf(tv[0] * qn_ + tv[2]), tv[3]));
                        const unsigned hp = pk2((tv[0] * aI[mt][0][rg] + tv[1] * aA[mt][0][rg]) * inv, (tv[0] * aI[mt][1][rg] + tv[1] * aA[mt][1][rg]) * inv);
                        sH[t * 32 + fr] = (unsigned short)hp; sH[t * 32 + 16 + fr] = (unsigned short)(hp >> 16); }
            } else { M2_LDP(sn); }
            __syncthreads();
          }
        }
        { const M2Step sp = m2_step(dir, b, NCHK - 1);
          if (sp.is_lat) {
#pragma unroll
            for (int i2 = 0; i2 < 2; ++i2) { const int pc = tr + 256 * i2; const u32x4 hv = *(const LAS u32x4*)(L + M2_HS + ((NCHK - 1) & 1) * 8192 + pc * 16);
                *(u32x4*)(H + (size_t)(sp.tl0 + (pc >> 2)) * D + (pc & 3) * 8) = hv; } } }
    } else {
        bf16x8 ka[2][4][4];
        f32x4 accC[4][3];
#pragma unroll
        for (int mt = 0; mt < 4; ++mt)
#pragma unroll
            for (int nt = 0; nt < 3; ++nt) accC[mt][nt] = (f32x4){0.f, 0.f, 0.f, 0.f};
        M2_LDK(ka[0], s0);
        u32x4 vna = *(const u32x4*)(VT + s1.tokrow0), vnb = *(const u32x4*)(VT + (size_t)16 * MTOK + s1.tokrow0);
        f32x4 tn2 = *(const f32x4*)(TS + (size_t)(m2_step(dir, b, 2).p0 + (tr & 127)) * 4);
        __syncthreads();
        for (int jj = 0; jj < NCHK; jj += 2) {
#pragma unroll
          for (int u = 0; u < 2; ++u) { const int j = jj + u;
            const M2Step sn = m2_step(dir, b, j + 1), sn2 = m2_step(dir, b, j + 2);
            M2_LDK(ka[u ^ 1], sn);
            const LAS unsigned char* sVW = L + M2_VW + (j & 1) * M2_VWB; const float dec = sdec[j];
            const u32x4 vxa = *(const u32x4*)(VT + sn2.tokrow0), vxb = *(const u32x4*)(VT + (size_t)16 * MTOK + sn2.tokrow0);
            const f32x4 tn3 = *(const f32x4*)(TS + (size_t)(m2_step(dir, b, j + 3).p0 + (tr & 127)) * 4);
#pragma unroll
            for (int mt = 0; mt < 4; ++mt)
#pragma unroll
                for (int nt = 0; nt < 3; ++nt) accC[mt][nt] = accC[mt][nt] * dec;
#pragma unroll
            for (int k = 0; k < 4; ++k)
#pragma unroll
                for (int nt = 0; nt < 3; ++nt) { const bf16x8 bb = *(const LAS bf16x8*)(sVW + (16 * nt + fr) * 288 + (32 * k + 8 * fq) * 2);
#pragma unroll
                    for (int mt = 0; mt < 4; ++mt) accC[mt][nt] = __builtin_amdgcn_mfma_f32_16x16x32_bf16(ka[u][mt][k], bb, accC[mt][nt], 0, 0, 0); }
            { LAS unsigned char* dCT = L + M2_CT + ((j + 1) & 1) * M2_CTB;
#pragma unroll
              for (int mt = 0; mt < 4; ++mt)
#pragma unroll
                for (int nt = 0; nt < 3; ++nt) { u32x2 o; o.x = pk2(accC[mt][nt][0], accC[mt][nt][1]); o.y = pk2(accC[mt][nt][2], accC[mt][nt][3]);
                    *(LAS u32x2*)(dCT + (16 * nt + fr) * 544 + (64 * wa + 16 * mt + 4 * fq) * 2) = o; } }
            M2_VSTAGE(j + 1, vna, vnb);
            M2_TABLES(j + 2, sn2, tn2);
            vna = vxa; vnb = vxb; tn2 = tn3;
            __syncthreads();
          }
        }
    }
    __syncthreads();
#undef M2_LDQ
#undef M2_LDP
#undef M2_LDK
#undef M2_TABLES
#undef M2_VSTAGE
}

#define XB_TMO      128
#define XB_XCNT(j)  (256  + 64 * (j))
#define XB_XSUB(j)  (1280 + 64 * (j))
#define XB_XGEN(j)  (2304 + 64 * (j))
#define XB_TOP      3328
#define XB_TOPGEN   3392
#define XB_SPIN_CAP (1u << 22)
__device__ __forceinline__ unsigned xb_ld(unsigned* p)              { return __hip_atomic_load(p, __ATOMIC_RELAXED, __HIP_MEMORY_SCOPE_AGENT); }
__device__ __forceinline__ unsigned xb_add(unsigned* p, unsigned v) { return __hip_atomic_fetch_add(p, v, __ATOMIC_RELAXED, __HIP_MEMORY_SCOPE_AGENT); }
__device__ __forceinline__ unsigned xb_xcc_id() { return (unsigned)__builtin_amdgcn_s_getreg((3 << 11) | 20) & 0xFu; }
#define XB_SPIN(cond, bar) do { unsigned _sp = 0; while (cond) { __builtin_amdgcn_s_sleep(1); \
    if ((++_sp & 255u) == 0u) { if (xb_ld(&(bar)[XB_TMO])) break; if (_sp > XB_SPIN_CAP) { atomicAdd(&(bar)[XB_TMO], 1u); break; } } } } while (0)
struct XcdBarrier { unsigned* bar; unsigned x; volatile LAS unsigned* st; };
__device__ __forceinline__ XcdBarrier xcd_barrier_post(unsigned* bar, volatile LAS unsigned* st) {
    XcdBarrier b; b.bar = bar; b.x = xb_xcc_id(); b.st = st;
    if (threadIdx.x == 0) (void)xb_add(&bar[XB_XCNT(b.x)], 1u);
    return b;
}
__device__ __forceinline__ void xcd_barrier_complete(unsigned* bar, unsigned x, unsigned& nloc, unsigned& nx) {
    const unsigned G = gridDim.x * gridDim.y * gridDim.z;
    unsigned sum, cnt, mine, sp = 0u;
    for (;;) {
        sum = 0u; cnt = 0u; mine = 0u;
#pragma unroll
        for (unsigned j = 0; j < 16; ++j) { const unsigned c = xb_ld(&bar[XB_XCNT(j)]); sum += c; cnt += (c > 0u) ? 1u : 0u; mine = (j == x) ? c : mine; }
        if (sum == G) break;
        __builtin_amdgcn_s_sleep(1);
        if ((++sp & 255u) == 0u) { if (xb_ld(&bar[XB_TMO])) break; if (sp > XB_SPIN_CAP) { atomicAdd(&bar[XB_TMO], 1u); break; } }
    }
    nloc = mine > 0u ? mine : 1u; nx = cnt > 0u ? cnt : 1u;
}
__device__ __forceinline__ void xcd_barrier(const XcdBarrier& b) {
    asm volatile("s_waitcnt vmcnt(0)" ::: "memory");
    __syncthreads();
    if (threadIdx.x == 0) {
        unsigned* bar = b.bar;
        __builtin_amdgcn_s_waitcnt(0);
        unsigned nloc = b.st[0], nx = b.st[1];
        if (nloc == 0u) { xcd_barrier_complete(bar, b.x, nloc, nx); b.st[0] = nloc; b.st[1] = nx; }
        const unsigned old = xb_add(&bar[XB_XSUB(b.x)], 1u);
        const unsigned gen = old / nloc;
        if (old + 1u == (gen + 1u) * nloc) {
            __builtin_amdgcn_fence(__ATOMIC_RELEASE, "agent");
            asm volatile("s_waitcnt vmcnt(0)" ::: "memory");
            const unsigned og = xb_add(&bar[XB_TOP], 1u);
            const unsigned tg = og / nx;
            if (og + 1u == (tg + 1u) * nx) xb_add(&bar[XB_TOPGEN], 1u);
            else XB_SPIN(xb_ld(&bar[XB_TOPGEN]) == tg, bar);
            __builtin_amdgcn_fence(__ATOMIC_ACQUIRE, "agent");
            xb_add(&bar[XB_XGEN(b.x)], 1u);
            asm volatile("s_waitcnt vmcnt(0)" ::: "memory");
        } else {
            XB_SPIN(xb_ld(&bar[XB_XGEN(b.x)]) == gen, bar);
            __builtin_amdgcn_fence(__ATOMIC_ACQUIRE, "agent");
            asm volatile("s_waitcnt vmcnt(0)" ::: "memory");
        }
    }
    __syncthreads();
}

__device__ __forceinline__ pg8::Seg mkseg(const void* A0, const void* B0, int nM, int nN, int kind, int ksplit = 1) { pg8::Seg s; s.A0 = (const char*)A0; s.B0 = (const char*)B0; s.nM = nM; s.nN = nN; s.kind = kind; s.ksplit = ksplit; return s; }
__device__ __forceinline__ pg8::Sched mksched(int K) { pg8::Sched S; S.s[0] = S.s[1] = S.s[2] = S.s[3] = mkseg(nullptr, nullptr, 0, 0, 0); S.G = gridDim.x; S.c = blockIdx.x; S.tstep = (size_t)256 * K * 2; S.ntk = K / 64; return S; }

__global__ void __launch_bounds__(NTHR) mega_fwd(Params p) {
    extern __shared__ __attribute__((aligned(16))) unsigned char lds_raw[];
    Frame F;
#define REFRAME() do { int t_ = threadIdx.x; asm volatile("" : "+v"(t_)); F.lds = (LAS unsigned char*)lds_raw; F.tid = t_; F.lane = t_ & 63; F.wave = __builtin_amdgcn_readfirstlane(t_ >> 6); \
        F.gw = blockIdx.x * NWAVE + F.wave; F.ngw = gridDim.x * NWAVE; } while (0)
    REFRAME();
    unsigned char* ws = p.ws; unsigned char* dout = (unsigned char*)p.out;
    volatile LAS unsigned* bst = (volatile LAS unsigned*)(F.lds + LDS_BYTES - 16);
    if (F.tid < 4) bst[F.tid] = 0u;
    __syncthreads();
    const XcdBarrier gbar = xcd_barrier_post((unsigned*)(ws + WS_BAR), bst);
#define GSYNC() do { xcd_barrier(gbar); REFRAME(); } while (0)

    ada_phase(F, p);
    wfour_phase(F, p);
    {
        constexpr int I13 = 16 * 176, I2 = 44 * 32, IIN = 16 * (WIN_ROWS / 32), ISQ = 16 * 32;
        Frame F2 = F; const bool extra = gridDim.x == 256 && blockIdx.x >= 144; F2.gw = (blockIdx.x - 144) * NWAVE + F.wave; F2.ngw = 112 * NWAVE;
#define CONV_SPLIT(CALL_A, CALL_B) do { CALL_A; if (gridDim.x != 256) { Frame F2 = F; CALL_B; } else if (extra) { CALL_B; } } while (0)
        { constexpr int A = I13 * 55 / 100; CONV_SPLIT(conv_w13(F, p.w13_a, (bf16*)(ws + WS_W13), 0, A), conv_w13(F2, p.w13_a, (bf16*)(ws + WS_W13), A, I13 - A)); }
        { constexpr int A = I2 * 55 / 100; CONV_SPLIT(conv_plain(F, p.w2_a, FF, D, (bf16*)(ws + WS_W2), 0, A), conv_plain(F2, p.w2_a, FF, D, (bf16*)(ws + WS_W2), A, I2 - A)); }
        { constexpr int A = IIN * 55 / 100; CONV_SPLIT(conv_win(F, p.w_in, (bf16*)(ws + WS_WIN), 0, A), conv_win(F2, p.w_in, (bf16*)(ws + WS_WIN), A, IIN - A)); }
        { constexpr int A = ISQ * 55 / 100; CONV_SPLIT(conv_plain(F, p.w_mproj, D, D, (bf16*)(ws + WS_WMPROJ), 0, A), conv_plain(F2, p.w_mproj, D, D, (bf16*)(ws + WS_WMPROJ), A, ISQ - A));
          CONV_SPLIT(conv_plain(F, p.w_out, D, D, (bf16*)(ws + WS_WOUT), 0, A), conv_plain(F2, p.w_out, D, D, (bf16*)(ws + WS_WOUT), A, ISQ - A)); }
#undef CONV_SPLIT
        { LAS float* scr = (LAS float*)(F.lds + F.wave * 16384);
          for (int it = F.gw; it < 16; it += F.ngw) transpose_item(p.w_in, D, INW, (bf16*)(ws + WS_WG), 0, COL_GATES, 64 * it, scr, F.lane);
          u32x4* z = (u32x4*)(ws + WS_WG + 32 * D * 2); for (int i = blockIdx.x * NTHR + F.tid; i < 224 * D * 2 / 16; i += gridDim.x * NTHR) z[i] = (u32x4){0u, 0u, 0u, 0u}; }
    }
    GSYNC();
    phase_u1(F, p);
    GSYNC();
    { pg8::Sched S = mksched(D); S.s[0] = mkseg(ws + WS_U, ws + WS_W13, MTOK / 256, 22, 0); EpiSwiglu E{(bf16*)(ws + WS_ACT)}; pg8::gemm_phase(F.lds, D, S, E); }
    GSYNC();
    { pg8::Sched S = mksched(FF); S.s[0] = mkseg(ws + WS_ACT, ws + WS_W2, TLAT / 256, 4, 0); S.s[1] = mkseg(ws + WS_ACT + (size_t)TLAT * FF * 2, ws + WS_W2, TCTX / 256, 4, 1, 8);
      EpiDownA E{(bf16*)(ws + WS_Y1), (float*)(ws + WS_Y1C)}; pg8::gemm_phase(F.lds, FF, S, E); }
    GSYNC();
    phase_post_ffn_a(F, p);
    GSYNC();
    { pg8::Sched S = mksched(D); const unsigned char* W = ws + WS_WIN;
      S.s[0] = mkseg(ws + WS_U2, W + (size_t)ROW_Q * D * 2, MTOK / 256, 8, 0);
      S.s[1] = mkseg(W + (size_t)ROW_V * D * 2, ws + WS_U2, 4, MTOK / 256, 2);
      S.s[2] = mkseg(W + (size_t)ROW_F * D * 2, ws + WS_U2, 2, TLAT / 256, 3);
      S.s[3] = mkseg(ws + WS_U2, ws + WS_WG, MTOK / 256, 1, 4);
      EpiProjA E{(bf16*)(ws + WS_QPRE), (bf16*)(ws + WS_KPRE), (bf16*)(ws + WS_VT), (bf16*)(ws + WS_XFT), p.b_in, (float*)(ws + WS_GATES)}; pg8::gemm_phase(F.lds, D, S, E); }
    GSYNC();
    for (int it = blockIdx.x; it < 16 * NCHK; it += gridDim.x) { if (it < 512) m1_item(F, p, it & 15, 2 + (it >> 4)); else m1_item(F, p, (it - 512) & 15, (it - 512) >> 4); }
    GSYNC();
    for (int sid = blockIdx.x; sid < 256; sid += gridDim.x) m2_stream(F, p, sid);
    GSYNC();
    for (int it = blockIdx.x; it < 256; it += gridDim.x) fourier_item(F, p, it);
    { constexpr int I13 = 16 * 176, I2 = 44 * 32; conv_w13(F, p.w13_b, (bf16*)(ws + WS_W13B), 0, I13); conv_plain(F, p.w2_b, FF, D, (bf16*)(ws + WS_W2B), 0, I2); }
    GSYNC();
    { pg8::Sched S = mksched(D); const pg8::Seg so = mkseg(ws + WS_U2, ws + WS_WIN + (size_t)ROW_O * D * 2, TLAT / 256, 4, 0), sf = mkseg(ws + WS_UF, ws + WS_WFOUR, TLAT / 256, 4, 1);
      const bool swp = gridDim.x == 256 && ((blockIdx.x >> 3) & 1);
      S.s[0] = swp ? sf : so; S.s[1] = swp ? so : sf;
      EpiX E{(bf16*)(ws + WS_HM), (bf16*)(dout + DO_TF), (const bf16*)(ws + WS_HF), (const bf16*)(ws + WS_HB), p.b_in, p.head_g, (LAS float*)(F.lds + pg8::STAGE_BYTES)}; pg8::gemm_phase(F.lds, D, S, E); }
    GSYNC();
    if (gridDim.x == 256) {
      pg8::SchedY S; S.base = mksched(D); S.base.s[0] = mkseg(ws + WS_HM, ws + WS_WMPROJ, TLAT / 256, 4, 1); S.Ag = (const char*)(ws + WS_U2); S.Bg = (const char*)(ws + WS_WIN + (size_t)ROW_GF * D * 2);
      EpiY E{(bf16*)(dout + DO_TF), (bf16*)(ws + WS_TM), p.b_in}; pg8::gemm_phase(F.lds, D, S, E);
    } else {
      { pg8::Sched S = mksched(D); S.s[0] = mkseg(ws + WS_HM, ws + WS_WMPROJ, TLAT / 256, 4, 1); EpiY E{(bf16*)(dout + DO_TF), (bf16*)(ws + WS_TM), p.b_in}; pg8::gemm_phase(F.lds, D, S, E); }
      GSYNC();
      { pg8::Sched S = mksched(D); S.s[0] = mkseg(ws + WS_U2, ws + WS_WIN + (size_t)ROW_GF * D * 2, TLAT / 256, 8, 0); EpiY E{(bf16*)(dout + DO_TF), (bf16*)(ws + WS_TM), p.b_in}; pg8::gemm_phase(F.lds, D, S, E); }
    }
    GSYNC();
    { pg8::Sched S = mksched(D); S.s[0] = mkseg(ws + WS_TM, ws + WS_WOUT, TLAT / 256, 4, 0);
      float* xb = (float*)(ws + WS_XCH); unsigned* xc = (unsigned*)(ws + WS_XCNT);
      EpiMix E{p.x, p.norm_g + 3 * D, p.norm_g + 4 * D, (const float*)(ws + WS_MOD), (const bf16*)(dout + DO_D1), (bf16*)(ws + WS_D12), (bf16*)(dout + DO_U3),
               PanelRms{xb, xc}, PanelRms{xb + 65536, xc + 64 * 64}, (LAS float*)(F.lds + pg8::STAGE_BYTES)};
      if (gridDim.x == 256) pg8::gemm_phase(F.lds, D, S, E); }
    GSYNC();
    { pg8::Sched S = mksched(D); S.s[0] = mkseg(dout + DO_U3, ws + WS_W13B, TLAT / 256, 22, 0); EpiSwiglu E{(bf16*)(ws + WS_ACT2)}; pg8::gemm_phase(F.lds, D, S, E); }
    GSYNC();
    { pg8::Sched S = mksched(FF); S.s[0] = mkseg(ws + WS_ACT2, ws + WS_W2B, TLAT / 256, 4, 0);
      EpiFinal E{p.x, p.norm_g + 5 * D, (const float*)(ws + WS_MOD), (const bf16*)(ws + WS_D12), p.out, PanelRms{(float*)(ws + WS_XCH) + 2 * 65536, (unsigned*)(ws + WS_XCNT) + 2 * 64 * 64}, (LAS float*)(F.lds + pg8::STAGE_BYTES)};
      if (gridDim.x == 256) pg8::gemm_phase(F.lds, FF, S, E); }
}

extern "C" void kernel_launch(void* const* d_in, const int* in_sizes, int n_in, void* d_out, int out_size, void* d_ws, size_t ws_size, hipStream_t stream) {
    static int grid = 0;
    if (grid == 0) {
        if (n_in != 19 || out_size != TLAT * D || ws_size < WS_NEED) { fprintf(stderr, "kernel_launch: unexpected problem (n_in %d, out %d, ws %zu)\n", n_in, out_size, ws_size); grid = -1; return; }
        int dev = 0, cus = 0, per_cu = 0;
        if (hipGetDevice(&dev) != hipSuccess || hipDeviceGetAttribute(&cus, hipDeviceAttributeMultiprocessorCount, dev) != hipSuccess) { grid = -1; return; }
        if (hipFuncSetAttribute((const void*)mega_fwd, hipFuncAttributeMaxDynamicSharedMemorySize, LDS_BYTES) != hipSuccess) { fprintf(stderr, "kernel_launch: hipFuncSetAttribute failed\n"); grid = -1; return; }
        if (hipOccupancyMaxActiveBlocksPerMultiprocessor(&per_cu, (const void*)mega_fwd, NTHR, LDS_BYTES) != hipSuccess || per_cu < 1) { fprintf(stderr, "kernel_launch: occupancy query failed (%d)\n", per_cu); (void)hipGetLastError(); grid = -1; return; }
        grid = cus * 1;
        if (grid != 256) fprintf(stderr, "kernel_launch: built for a 256-CU device (fused norm epilogues need one 256x256 unit per workgroup); got %d\n", grid);
        fprintf(stderr, "kernel_launch: %d CUs, %d blocks/CU by the occupancy query, grid %d\n", cus, per_cu, grid);
    }
    if (grid < 0) return;
    Params p{};
    const float** f = (const float**)&p;
    for (int i = 0; i < 19; ++i) f[i] = (const float*)d_in[i];
    p.out = (float*)d_out; p.ws = (unsigned char*)d_ws;
    (void)hipMemsetAsync((char*)d_ws + WS_BAR, 0, 64 * 1024, stream);
    void* args[] = {&p};
    hipError_t e = hipLaunchCooperativeKernel((const void*)mega_fwd, dim3(grid), dim3(NTHR), args, LDS_BYTES, stream);
    if (e != hipSuccess) fprintf(stderr, "kernel_launch: cooperative launch failed: %s (grid %d)\n", hipGetErrorString(e), grid);
}
```

```cpp
#include <hip/hip_runtime.h>
#include <hip/hip_cooperative_groups.h>
#include <cstdio>
#include <cstdint>
namespace cg = cooperative_groups;

#define LAS __attribute__((address_space(3)))
typedef unsigned short bf16;
typedef short bf16x8 __attribute__((ext_vector_type(8)));
typedef float f32x4 __attribute__((ext_vector_type(4)));
typedef float f32x2 __attribute__((ext_vector_type(2)));
typedef unsigned u32x4 __attribute__((ext_vector_type(4)));
typedef unsigned u32x2 __attribute__((ext_vector_type(2)));

constexpr int D = 1024, NB = 4, SEQ = 4096, CTXL = 256, FF = 2816, NH = 4, DH = 256, CH = 128;
constexpr int TLAT = NB * SEQ;
constexpr int TCTX = NB * CTXL;
constexpr int MTOK = TLAT + TCTX;
constexpr int INW = 6672;
constexpr int PLEN = CTXL + SEQ;
constexpr int NCHK = PLEN / CH;
constexpr float EPS = 1e-6f;
constexpr int NTHR = 512, NWAVE = 8;
constexpr int LDS_BYTES = 147456;

constexpr size_t MiB = 1u << 20;
constexpr size_t WS_MOD = 0;
constexpr size_t WS_BAR = 256 * 1024;
constexpr size_t WS_GATES = 512 * 1024;
constexpr size_t WS_TOKSC = 2 * MiB;
constexpr size_t WS_CHSC = 5 * MiB;
constexpr size_t WS_WG = 7 * MiB;
constexpr size_t WS_XCH = 6 * MiB;
constexpr size_t WS_XCNT = WS_BAR + 16 * 1024;
constexpr size_t WS_W13 = 8 * MiB, WS_W2 = 19 * MiB, WS_WIN = 25 * MiB, WS_WFOUR = 38 * MiB, WS_WMPROJ = 40 * MiB, WS_WOUT = 42 * MiB;
constexpr size_t WS_XFT = 8 * MiB;
constexpr size_t WS_U = 44 * MiB;
constexpr size_t WS_U2 = 210 * MiB;
constexpr size_t WS_ACT = 78 * MiB;
constexpr size_t WS_Y1 = 172 * MiB;
constexpr size_t WS_Y1C = 44 * MiB;
constexpr size_t WS_QPRE = 78 * MiB;
constexpr size_t WS_KPRE = 110 * MiB;
constexpr size_t WS_VT = 144 * MiB;
constexpr size_t WS_Q = 178 * MiB;
constexpr size_t WS_UF = 142 * MiB;
constexpr size_t WS_KT = 44 * MiB;
constexpr size_t WS_HF = 78 * MiB, WS_HB = 110 * MiB;
constexpr size_t WS_HM = 174 * MiB;
constexpr size_t DO_TF = 32 * MiB;
constexpr size_t WS_W13B = 44 * MiB, WS_W2B = 55 * MiB;
constexpr size_t WS_TM = 78 * MiB;
constexpr size_t WS_OUTL = 110 * MiB;
constexpr size_t WS_D12 = 110 * MiB;
constexpr size_t WS_ACT2 = 142 * MiB;
constexpr size_t WS_Y3 = 164 * MiB;
constexpr size_t WS_NEED = 256 * MiB;
constexpr size_t DO_D1 = 0, DO_P = 32 * MiB, DO_U3 = 32 * MiB;

constexpr int COL_F = 0, COL_Q = 512, COL_K = 1536, COL_V = 2560, COL_O = 3584, COL_GATES = 4608, COL_GF = 4624, COL_GM = 5648;
constexpr int ROW_Q = 0, ROW_K = 1024, ROW_V = 2048, ROW_F = 3072, ROW_O = 3584, ROW_GF = 4608, ROW_GM = 5632, WIN_ROWS = 6656;

struct Params {
    const float *x, *c, *ctx, *c_ctx, *w_ada, *b_ada, *norm_g, *w13_a, *w2_a, *w_in, *b_in, *conv_w, *conv_b, *head_g, *w_four, *w_mproj, *w_out, *w13_b, *w2_b;
    float* out; unsigned char* ws;
};

typedef __bf16 bf16x2_t __attribute__((ext_vector_type(2)));
__device__ __forceinline__ unsigned f2bf(float f) { return (unsigned)__builtin_bit_cast(unsigned short, (__bf16)f); }
__device__ __forceinline__ unsigned pk2(float lo, float hi) { bf16x2_t v; v[0] = (__bf16)lo; v[1] = (__bf16)hi; return __builtin_bit_cast(unsigned, v); }
__device__ __forceinline__ float bf2f(unsigned b) { return __builtin_bit_cast(float, b << 16); }
__device__ __forceinline__ float bflo(unsigned w) { return __builtin_bit_cast(float, w << 16); }
__device__ __forceinline__ float bfhi(unsigned w) { return __builtin_bit_cast(float, w & 0xffff0000u); }
__device__ __forceinline__ unsigned cvt_pk_bf16(float lo, float hi) { return pk2(lo, hi); }
#define DPP_F(v, ctrl) __builtin_bit_cast(float, __builtin_amdgcn_update_dpp(0, __builtin_bit_cast(int, (v)), (ctrl), 0xf, 0xf, false))
__device__ __forceinline__ float row16_sum(float v) {
    v += DPP_F(v, 0xB1);
    v += DPP_F(v, 0x4E);
    v += DPP_F(v, 0x141);
    v += DPP_F(v, 0x140);
    return v;
}
__device__ __forceinline__ float rlane(float v, int l) { return __builtin_bit_cast(float, __builtin_amdgcn_readlane(__builtin_bit_cast(int, v), l)); }
__device__ __forceinline__ float wave_sum(float v) { v = row16_sum(v); return (rlane(v, 0) + rlane(v, 16)) + (rlane(v, 32) + rlane(v, 48)); }
__device__ __forceinline__ float sigmoidf_(float x) { return __builtin_amdgcn_rcpf(1.0f + __expf(-x)); }
__device__ __forceinline__ float siluf_(float x) { return x * __builtin_amdgcn_rcpf(1.0f + __expf(-x)); }
#define LDS_WAIT() asm volatile("s_waitcnt lgkmcnt(0)" ::: "memory")
#define VM_WAIT() asm volatile("s_waitcnt vmcnt(0)" ::: "memory")

namespace pg8 {
constexpr int BM = 256, BK = 64, HALF = 128, HTB = HALF * BK * 2, STAGE_BYTES = 8 * HTB, NXCD = 8, WGM = 8;
__host__ __device__ __forceinline__ int lds_byte(int r, int c) { const int st = (r >> 4) * 2 + (c >> 5), rr = r & 15, cc = c & 31, ob = rr * 64 + cc * 2; return st * 1024 + (ob ^ (((ob >> 9) & 1) << 5)); }
__host__ __device__ __forceinline__ void stage_rc(int b, int& R, int& C) { const int st = b / 1024, sb = b % 1024, swz = sb ^ (((sb >> 9) & 1) << 5); R = (st >> 1) * 16 + swz / 64; C = (st & 1) * 32 + (swz % 64) / 2; }
__host__ __device__ __forceinline__ int perm32(int rho) { const int n = rho >> 4, i = rho & 15; return 8 * (i >> 2) + 4 * n + (i & 3); }

struct Unit { const char* A; const char* B; int kind, pm, pn, nt, kq; };
struct Seg { const char* A0; const char* B0; int nM, nN, kind, ksplit; };
struct Sched {
    Seg s[4]; int G, c; size_t tstep;
    int ntk;
    __device__ __forceinline__ bool pick(const Seg& sg, long& L, Unit& u) const {
        const int nwg = sg.nM * sg.nN * sg.ksplit;
        if (L >= nwg) { L -= nwg; return false; }
        if (sg.ksplit > 1) { const int tiles = sg.nM * sg.nN, kq = (int)L / tiles, tl = (int)L % tiles; u.pm = tl % sg.nM; u.pn = tl / sg.nM; u.kind = sg.kind;
            const int kt0 = kq * 6 - (kq > 6 ? 2 : 0); u.nt = kq < 6 ? 6 : 4; u.kq = kq;
            u.A = sg.A0 + (size_t)u.pm * tstep + kt0 * 128; u.B = sg.B0 + (size_t)u.pn * tstep + kt0 * 128; return true; }
        u.nt = ntk; u.kq = 0;
        int wgid = (int)L; { const int q = nwg / NXCD, r = nwg % NXCD, xcd = wgid % NXCD, off = wgid / NXCD; wgid = (xcd < r ? xcd * (q + 1) : r * (q + 1) + (xcd - r) * q) + off; }
        const int nig = WGM * sg.nN, gid = wgid / nig, fm = gid * WGM, gsz = (sg.nM - fm) < WGM ? (sg.nM - fm) : WGM;
        u.pm = fm + ((wgid % nig) % gsz); u.pn = (wgid % nig) / gsz; u.kind = sg.kind;
        u.A = sg.A0 + (size_t)u.pm * tstep; u.B = sg.B0 + (size_t)u.pn * tstep; return true;
    }
    __device__ __forceinline__ bool next(int i, Unit& u) const {
        long L = (long)i * G + c;
        if (pick(s[0], L, u)) return true;
        if (pick(s[1], L, u)) return true;
        if (pick(s[2], L, u)) return true;
        if (pick(s[3], L, u)) return true;
        return false;
    }
};

struct SchedY {
    Sched base; const char* Ag; const char* Bg;
    __device__ __forceinline__ bool next(int i, Unit& u) const {
        if (i > 2) return false;
        long L = base.c; Unit t; base.pick(base.s[0], L, t);
        if (i == 0) { u = t; return true; }
        u.kind = 0; u.pm = t.pm; u.pn = 2 * t.pn + (i - 1); u.nt = base.ntk; u.kq = 0;
        u.A = Ag + (size_t)u.pm * base.tstep; u.B = Bg + (size_t)u.pn * base.tstep; return true;
    }
};
template <class Epi, class SchedT>
__device__ __forceinline__ void gemm_phase(LAS unsigned char* lds, const int K, const SchedT& S, const Epi& E) {
    int tid_ = threadIdx.x; asm volatile("" : "+v"(tid_));
    const int tid = tid_, wid = __builtin_amdgcn_readfirstlane(tid >> 6), lane = tid & 63, wr = wid >> 2, wc = wid & 3, fr = lane & 15, fq = lane >> 4;
    unsigned voffA[2], voffB[2];
#pragma unroll
    for (int i = 0; i < 2; ++i) { int R, C; stage_rc(tid * 16 + i * 8192, R, C); const int Rb = (R & ~31) + perm32(R & 31);
        voffA[i] = (unsigned)(R * K + C) * 2u; voffB[i] = (unsigned)(Rb * K + C) * 2u; }
    const size_t kstep = (size_t)(BK * 2);
    const size_t hstep = (size_t)HALF * K * 2;
    const unsigned ldsw = (unsigned)wid * 1024u;
    const int aoff = lds_byte(wr * 64 + fr, fq * 8), boff = lds_byte(wc * 32 + fr, fq * 8);
#define PG8_SA(b, h) (((b) * 2 + (h)) * HTB)
#define PG8_SB(b, h) ((4 + (b) * 2 + (h)) * HTB)
#define PG8_STAGE(bufoff, gbase, voff) do { _Pragma("unroll") for (int _i = 0; _i < 2; ++_i) \
        __builtin_amdgcn_global_load_lds((const unsigned*)((const char*)(gbase) + (voff)[_i]), (LAS unsigned*)(lds + (bufoff) + ldsw + _i * 8192), 16, 0, 0); } while (0)
#define PG8_LDA(dst, b, h) do { _Pragma("unroll") for (int m = 0; m < 4; ++m) _Pragma("unroll") for (int k = 0; k < 2; ++k) dst[m][k] = *(const LAS bf16x8*)(lds + PG8_SA(b, h) + aoff + m * 2048 + k * 1024); } while (0)
#define PG8_LDB(dst, b, h) do { _Pragma("unroll") for (int n = 0; n < 2; ++n) _Pragma("unroll") for (int k = 0; k < 2; ++k) dst[n][k] = *(const LAS bf16x8*)(lds + PG8_SB(b, h) + boff + n * 2048 + k * 1024); } while (0)
#define PG8_MMA(ai, bj, At, Bt) do { __builtin_amdgcn_s_setprio(1); _Pragma("unroll") for (int m = 0; m < 4; ++m) _Pragma("unroll") for (int n = 0; n < 2; ++n) _Pragma("unroll") for (int k = 0; k < 2; ++k) \
        acc[ai][bj][m][n] = __builtin_amdgcn_mfma_f32_16x16x32_bf16(Bt[n][k], At[m][k], acc[ai][bj][m][n], 0, 0, 0); __builtin_amdgcn_s_setprio(0); } while (0)
#define PG8_WAIT_V(n) asm volatile("s_waitcnt vmcnt(" #n ")" ::: "memory")
#define PG8_WAIT_L(n) asm volatile("s_waitcnt lgkmcnt(" #n ")" ::: "memory")
#define PG8_BAR __builtin_amdgcn_s_barrier()
#define PG8_SCHED __builtin_amdgcn_sched_barrier(0)
    Unit cur, nxt; int ui = 0;
    if (!S.next(0, cur)) return;
    f32x4 acc[2][2][4][2];
#pragma unroll
    for (int a = 0; a < 2; ++a)
#pragma unroll
        for (int b = 0; b < 2; ++b)
#pragma unroll
            for (int m = 0; m < 4; ++m)
#pragma unroll
                for (int n = 0; n < 2; ++n) acc[a][b][m][n] = (f32x4){0.f, 0.f, 0.f, 0.f};
    bf16x8 At[4][2], B0[2][2], B1[2][2];
    const char* cA = cur.A; const char* cB = cur.B;
    PG8_STAGE(PG8_SB(0, 0), cB, voffB); PG8_STAGE(PG8_SB(0, 1), cB + hstep, voffB); PG8_STAGE(PG8_SA(0, 0), cA, voffA); PG8_STAGE(PG8_SA(0, 1), cA + hstep, voffA);
    if (wr == 1) PG8_BAR;
    PG8_WAIT_V(2); PG8_BAR;
    PG8_STAGE(PG8_SB(1, 0), cB + kstep, voffB); PG8_STAGE(PG8_SA(1, 0), cA + kstep, voffA); PG8_STAGE(PG8_SB(1, 1), cB + hstep + kstep, voffB);
    PG8_WAIT_V(6); PG8_BAR;
    for (;;) {
        const bool has_next = S.next(ui + 1, nxt);
        const char* nA = has_next ? nxt.A : cA; const char* nB = has_next ? nxt.B : cB;
        const int nt = cur.nt;
        for (int t = 0; t < nt; t += 2) {
            const bool last = (t == nt - 2);
            const char* a1 = cA + (size_t)(t + 1) * kstep;
            const char* a2 = last ? nA : cA + (size_t)(t + 2) * kstep; const char* b2 = last ? nB : cB + (size_t)(t + 2) * kstep;
            const char* a3 = a2 + kstep; const char* b3 = b2 + kstep;
            PG8_LDB(B0, 0, 0); PG8_LDB(B1, 0, 1); PG8_SCHED; PG8_LDA(At, 0, 0); PG8_STAGE(PG8_SA(1, 1), a1 + hstep, voffA);
            PG8_WAIT_V(8); PG8_WAIT_L(0); PG8_BAR; PG8_MMA(0, 0, At, B0); PG8_MMA(0, 1, At, B1); PG8_BAR; PG8_SCHED;
            PG8_LDA(At, 0, 1); PG8_STAGE(PG8_SB(0, 0), b2, voffB); PG8_STAGE(PG8_SB(0, 1), b2 + hstep, voffB); PG8_STAGE(PG8_SA(0, 0), a2, voffA);
            PG8_WAIT_V(8); PG8_WAIT_L(0); PG8_BAR; PG8_MMA(1, 0, At, B0); PG8_MMA(1, 1, At, B1); PG8_BAR; PG8_SCHED;
            PG8_LDB(B0, 1, 0); PG8_LDB(B1, 1, 1); PG8_SCHED; PG8_LDA(At, 1, 0); PG8_STAGE(PG8_SA(0, 1), a2 + hstep, voffA);
            PG8_WAIT_V(8); PG8_WAIT_L(0); PG8_BAR; PG8_MMA(0, 0, At, B0); PG8_MMA(0, 1, At, B1); PG8_BAR; PG8_SCHED;
            PG8_LDA(At, 1, 1); PG8_STAGE(PG8_SB(1, 0), b3, voffB); PG8_STAGE(PG8_SB(1, 1), b3 + hstep, voffB); PG8_STAGE(PG8_SA(1, 0), a3, voffA);
            PG8_WAIT_V(8); PG8_WAIT_L(0); PG8_BAR; PG8_MMA(1, 0, At, B0); PG8_MMA(1, 1, At, B1); PG8_BAR; PG8_SCHED;
        }
        if (wr == 0) PG8_BAR;
        { int fr2 = fr, fq2 = fq; asm volatile("" : "+v"(fr2), "+v"(fq2));
          E(acc, cur, wr, wc, fr2, fq2); }
        if (!has_next) break;
#pragma unroll
        for (int a = 0; a < 2; ++a)
#pragma unroll
            for (int b = 0; b < 2; ++b)
#pragma unroll
                for (int m = 0; m < 4; ++m)
#pragma unroll
                    for (int n = 0; n < 2; ++n) acc[a][b][m][n] = (f32x4){0.f, 0.f, 0.f, 0.f};
        cur = nxt; cA = nA; cB = nB; ++ui;
        if (wr == 1) PG8_BAR;
    }
    PG8_WAIT_V(0);
    PG8_BAR;
#undef PG8_SA
#undef PG8_SB
#undef PG8_STAGE
#undef PG8_LDA
#undef PG8_LDB
#undef PG8_MMA
#undef PG8_WAIT_V
#undef PG8_WAIT_L
#undef PG8_BAR
#undef PG8_SCHED
}
}

#define ACC_T const f32x4 (&acc)[2][2][4][2]
template <class T> __device__ __forceinline__ T ldg(const void* base, unsigned boff) { return *(const T*)((const char*)base + boff); }
#ifndef WT_STORES
#define WT_STORES 0
#endif
template <class T> __device__ __forceinline__ void stg(void* base, unsigned boff, const T& v) {
    static_assert(sizeof(T) == 16, "16-byte stores only");
#if WT_STORES
    const __amdgpu_buffer_rsrc_t rs = __builtin_amdgcn_make_buffer_rsrc(base, (short)0, 0x7fffffff, 0x00020000);
    __builtin_amdgcn_raw_buffer_store_b128(__builtin_bit_cast(u32x4, v), rs, boff, 0, 16);
#else
    *(T*)((char*)base + boff) = v;
#endif
}
__device__ __forceinline__ u32x4 pack8(const f32x4& v0, const f32x4& v1) { u32x4 w; w.x = cvt_pk_bf16(v0[0], v0[1]); w.y = cvt_pk_bf16(v0[2], v0[3]); w.z = cvt_pk_bf16(v1[0], v1[1]); w.w = cvt_pk_bf16(v1[2], v1[3]); return w; }
#define ROWGROUPS(ai, m) _Pragma("unroll") for (int ai = 0; ai < 2; ++ai) _Pragma("unroll") for (int m = 0; m < 4; ++m)

struct EpiSwiglu {
    bf16* O;
    __device__ __forceinline__ void operator()(ACC_T, const pg8::Unit& u, int wr, int wc, int fr, int fq) const {
        const unsigned off0 = (unsigned)((u.pm * 256 + wr * 64 + fr) * FF + u.pn * 128 + wc * 32 + 8 * fq) * 2u;
        ROWGROUPS(ai, m) {
            const f32x4 a0 = acc[ai][0][m][0], a1 = acc[ai][0][m][1], b0 = acc[ai][1][m][0], b1 = acc[ai][1][m][1];
            f32x4 h0, h1;
#pragma unroll
            for (int j = 0; j < 4; ++j) { h0[j] = a0[j] * b0[j] * __builtin_amdgcn_rcpf(1.0f + __builtin_amdgcn_exp2f(-a0[j])); h1[j] = a1[j] * b1[j] * __builtin_amdgcn_rcpf(1.0f + __builtin_amdgcn_exp2f(-a1[j])); }
            stg(O, off0 + (unsigned)((ai * 128 + m * 16) * FF * 2), pack8(h0, h1));
        }
    }
};

struct EpiProjA {
    bf16 *Oq, *Ok, *Ovt, *Oxt; const float* b_in; float* G;
    __device__ __forceinline__ void operator()(ACC_T, const pg8::Unit& u, int wr, int wc, int fr, int fq) const {
        const int row0 = u.pm * 256 + wr * 64 + fr, col0 = u.pn * 256 + wc * 32 + 8 * fq;
        if (u.kind == 4) {
            if (wc == 0 && fq < 2) { const f32x4 b0 = ldg<f32x4>(b_in, (unsigned)(COL_GATES + 8 * fq) * 4u), b1 = ldg<f32x4>(b_in, (unsigned)(COL_GATES + 8 * fq + 4) * 4u);
                const unsigned g0 = (unsigned)(row0 * 16 + 8 * fq) * 4u;
                ROWGROUPS(ai, m) { stg(G, g0 + (unsigned)((ai * 128 + m * 16) * 64), acc[ai][0][m][0] + b0); stg(G, g0 + (unsigned)((ai * 128 + m * 16) * 64) + 16, acc[ai][0][m][1] + b1); } }
            return; }
        if (u.kind == 0) {
            const bool isk = u.pn >= 4; if (!isk && u.pm >= TLAT / 256) return;
            bf16* O = isk ? Ok : Oq; const int colq = col0 - (isk ? 1024 : 0); const unsigned boff = (unsigned)((isk ? COL_K : COL_Q) + colq) * 4u;
            const unsigned off0 = (unsigned)(row0 * D + colq) * 2u;
#pragma unroll
            for (int bj = 0; bj < 2; ++bj) {
                const f32x4 bv0 = ldg<f32x4>(b_in, boff + bj * 512), bv1 = ldg<f32x4>(b_in, boff + bj * 512 + 16);
                ROWGROUPS(ai, m) stg(O, off0 + (unsigned)((ai * 128 + m * 16) * D * 2) + bj * 256, pack8(acc[ai][bj][m][0] + bv0, acc[ai][bj][m][1] + bv1));
            }
        } else {
            bf16* O = u.kind == 2 ? Ovt : Oxt; const int ldc = u.kind == 2 ? MTOK : TLAT; const unsigned boff = (unsigned)((u.kind == 2 ? COL_V : COL_F) + row0) * 4u;
            const unsigned off0 = (unsigned)(row0 * ldc + col0) * 2u;
            ROWGROUPS(ai, m) { const float bb = ldg<float>(b_in, boff + (unsigned)((ai * 128 + m * 16) * 4)); const unsigned o = off0 + (unsigned)((ai * 128 + m * 16) * ldc * 2);
#pragma unroll
                for (int bj = 0; bj < 2; ++bj) stg(O, o + bj * 256, pack8(acc[ai][bj][m][0] + bb, acc[ai][bj][m][1] + bb)); }
        }
    }
};
__device__ __forceinline__ void store_bf16_tile(bf16* O, ACC_T, const pg8::Unit& u, int wr, int wc, int fr, int fq) {
    const unsigned off0 = (unsigned)((u.pm * 256 + wr * 64 + fr) * D + u.pn * 256 + wc * 32 + 8 * fq) * 2u;
    ROWGROUPS(ai, m) { const unsigned o = off0 + (unsigned)((ai * 128 + m * 16) * D * 2);
#pragma unroll
        for (int bj = 0; bj < 2; ++bj) stg(O, o + bj * 256, pack8(acc[ai][bj][m][0], acc[ai][bj][m][1])); }
}
struct EpiBf16 { bf16* O; __device__ __forceinline__ void operator()(ACC_T, const pg8::Unit& u, int wr, int wc, int fr, int fq) const { store_bf16_tile(O, acc, u, wr, wc, fr, fq); } };
struct EpiDownA { bf16* Y1; float* Y1C;
    __device__ __forceinline__ void operator()(ACC_T, const pg8::Unit& u, int wr, int wc, int fr, int fq) const {
        if (u.kind == 0) { store_bf16_tile(Y1, acc, u, wr, wc, fr, fq); return; }
        const unsigned off0 = (unsigned)(((u.kq * TCTX + u.pm * 256 + wr * 64 + fr) * D) + u.pn * 256 + wc * 32 + 8 * fq) * 4u;
        ROWGROUPS(ai, m) { const unsigned o = off0 + (unsigned)((ai * 128 + m * 16) * D * 4);
#pragma unroll
            for (int bj = 0; bj < 2; ++bj) { stg(Y1C, o + bj * 512, acc[ai][bj][m][0]); stg(Y1C, o + bj * 512 + 16, acc[ai][bj][m][1]); } }
    }
};
struct EpiX {
    bf16 *HM, *TF; const bf16 *HF, *HB; const float *b_in, *head_g; LAS float* red;
    __device__ __forceinline__ void operator()(ACC_T, const pg8::Unit& u, int wr, int wc, int fr, int fq) const {
        if (u.kind == 1) { store_bf16_tile(TF, acc, u, wr, wc, fr, fq); return; }
        const int col0 = u.pn * 256 + wc * 32 + 8 * fq, rt0 = wr * 64 + fr;
        const unsigned off0 = (unsigned)((u.pm * 256 + rt0) * D + col0) * 2u;
#pragma unroll
        for (int am = 0; am < 4; ++am) { const int ai = am >> 1, mb = (am & 1) * 2;
            u32x4 hp[4][2];
#pragma unroll
            for (int m = mb; m < mb + 2; ++m) { const unsigned o = off0 + (unsigned)((ai * 128 + m * 16) * D * 2); float s = 0.f;
#pragma unroll
                for (int bj = 0; bj < 2; ++bj) { const u32x4 a = ldg<u32x4>(HF, o + bj * 256), b = ldg<u32x4>(HB, o + bj * 256); u32x4 hq;
#pragma unroll
                    for (int q = 0; q < 4; ++q) { const float h0 = bflo(a[q]) + bflo(b[q]), h1 = bfhi(a[q]) + bfhi(b[q]); hq[q] = pk2(h0, h1); const float g0 = bflo(hq[q]), g1 = bfhi(hq[q]); s += g0 * g0 + g1 * g1; }
                    hp[m][bj] = hq; }
                s += __shfl_xor(s, 16); s += __shfl_xor(s, 32);
                if (fq == 0) red[(ai * 128 + m * 16 + rt0) * 4 + wc] = s; }
            LDS_WAIT(); __builtin_amdgcn_s_barrier(); asm volatile("" ::: "memory");
#pragma unroll
            for (int bj = 0; bj < 2; ++bj) {
                const unsigned cb = (unsigned)(col0 + bj * 128) * 4u;
                const f32x4 bo0 = ldg<f32x4>(b_in, COL_O * 4 + cb), bo1 = ldg<f32x4>(b_in, COL_O * 4 + cb + 16), hg0 = ldg<f32x4>(head_g, cb), hg1 = ldg<f32x4>(head_g, cb + 16);
#pragma unroll
                for (int m = mb; m < mb + 2; ++m) { const f32x4 ps = *(const LAS f32x4*)(red + (ai * 128 + m * 16 + rt0) * 4);
                    const float rstd = rsqrtf(((ps[0] + ps[1]) + (ps[2] + ps[3])) * (1.0f / 256.0f) + EPS);
                    const unsigned o = off0 + (unsigned)((ai * 128 + m * 16) * D * 2) + bj * 256;
                    const u32x4 hq = hp[m][bj];
                    const f32x4 v0 = acc[ai][bj][m][0] + bo0, v1 = acc[ai][bj][m][1] + bo1;
                    f32x4 r0, r1;
                    r0[0] = sigmoidf_(v0[0]) * bflo(hq[0]) * rstd * hg0[0]; r0[1] = sigmoidf_(v0[1]) * bfhi(hq[0]) * rstd * hg0[1];
                    r0[2] = sigmoidf_(v0[2]) * bflo(hq[1]) * rstd * hg0[2]; r0[3] = sigmoidf_(v0[3]) * bfhi(hq[1]) * rstd * hg0[3];
                    r1[0] = sigmoidf_(v1[0]) * bflo(hq[2]) * rstd * hg1[0]; r1[1] = sigmoidf_(v1[1]) * bfhi(hq[2]) * rstd * hg1[1];
                    r1[2] = sigmoidf_(v1[2]) * bflo(hq[3]) * rstd * hg1[2]; r1[3] = sigmoidf_(v1[3]) * bfhi(hq[3]) * rstd * hg1[3];
                    stg(HM, o, pack8(r0, r1)); } }
            asm volatile("" ::: "memory");
        }
    }
};
struct EpiY {
    bf16 *TF, *TM; const float* b_in;
    __device__ __forceinline__ void operator()(ACC_T, const pg8::Unit& u, int wr, int wc, int fr, int fq) const {
        if (u.kind == 1) { store_bf16_tile(TM, acc, u, wr, wc, fr, fq); return; }
        const int ch0 = u.pn * 128 + wc * 32 + 8 * fq;
        const unsigned off0 = (unsigned)((u.pm * 256 + wr * 64 + fr) * D + ch0) * 2u;
        const f32x4 bf0 = ldg<f32x4>(b_in, (unsigned)(COL_GF + ch0) * 4u), bf1 = ldg<f32x4>(b_in, (unsigned)(COL_GF + ch0) * 4u + 16);
        const f32x4 bm0 = ldg<f32x4>(b_in, (unsigned)(COL_GM + ch0) * 4u), bm1 = ldg<f32x4>(b_in, (unsigned)(COL_GM + ch0) * 4u + 16);
        ROWGROUPS(ai, m) { const unsigned o = off0 + (unsigned)((ai * 128 + m * 16) * D * 2);
            const u32x4 t = ldg<u32x4>(TF, o), tm = ldg<u32x4>(TM, o);
            const f32x4 f0 = acc[ai][0][m][0] + bf0, f1 = acc[ai][0][m][1] + bf1, g0 = acc[ai][1][m][0] + bm0, g1 = acc[ai][1][m][1] + bm1;
            f32x4 r0, r1;
            r0[0] = sigmoidf_(f0[0]) * bflo(t[0]) + sigmoidf_(g0[0]) * bflo(tm[0]); r0[1] = sigmoidf_(f0[1]) * bfhi(t[0]) + sigmoidf_(g0[1]) * bfhi(tm[0]);
            r0[2] = sigmoidf_(f0[2]) * bflo(t[1]) + sigmoidf_(g0[2]) * bflo(tm[1]); r0[3] = sigmoidf_(f0[3]) * bfhi(t[1]) + sigmoidf_(g0[3]) * bfhi(tm[1]);
            r1[0] = sigmoidf_(f1[0]) * bflo(t[2]) + sigmoidf_(g1[0]) * bflo(tm[2]); r1[1] = sigmoidf_(f1[1]) * bfhi(t[2]) + sigmoidf_(g1[1]) * bfhi(tm[2]);
            r1[2] = sigmoidf_(f1[2]) * bflo(t[3]) + sigmoidf_(g1[2]) * bflo(tm[3]); r1[3] = sigmoidf_(f1[3]) * bfhi(t[3]) + sigmoidf_(g1[3]) * bfhi(tm[3]);
            stg(TM, o, pack8(r0, r1));
            asm volatile("" ::: "memory"); }
    }
};

struct PanelRms {
    float* xbuf; unsigned* cnt;
    __device__ __forceinline__ void run(const f32x4 (&v)[2][2][4][2], const pg8::Unit& u, int wr, int wc, int fr, int fq, LAS float* Pt, LAS float* S, int wid, int lane) const {
        ROWGROUPS(ai, m) { float s = 0.f;
#pragma unroll
            for (int bj = 0; bj < 2; ++bj)
#pragma unroll
                for (int n = 0; n < 2; ++n) { const f32x4 x = v[ai][bj][m][n]; s += (x[0] * x[0] + x[1] * x[1]) + (x[2] * x[2] + x[3] * x[3]); }
            s += __shfl_xor(s, 16); s += __shfl_xor(s, 32);
            if (fq == 0) Pt[(ai * 128 + wr * 64 + m * 16 + fr) * 4 + wc] = s; }
        LDS_WAIT(); __builtin_amdgcn_s_barrier(); asm volatile("" ::: "memory");
        const int row = wid * 32 + (lane & 31);
        if (lane < 32) { const f32x4 a = *(const LAS f32x4*)(Pt + row * 4);
            __hip_atomic_store(xbuf + (size_t)(u.pm * 256 + row) * 4 + u.pn, (a[0] + a[1]) + (a[2] + a[3]), __ATOMIC_RELAXED, __HIP_MEMORY_SCOPE_AGENT); }
        asm volatile("s_waitcnt vmcnt(0)" ::: "memory");
        if (lane == 0) __hip_atomic_fetch_add(cnt + 64 * u.pm, 1u, __ATOMIC_RELAXED, __HIP_MEMORY_SCOPE_AGENT);
        if (wid == 0) { unsigned sp = 0;
            while ((unsigned)__builtin_amdgcn_readfirstlane(__hip_atomic_load(cnt + 64 * u.pm, __ATOMIC_RELAXED, __HIP_MEMORY_SCOPE_AGENT)) < 32u) { __builtin_amdgcn_s_sleep(2); if (++sp > (1u << 22)) break; }
            __builtin_amdgcn_fence(__ATOMIC_ACQUIRE, "agent"); }
        asm volatile("s_waitcnt vmcnt(0) lgkmcnt(0)" ::: "memory"); __builtin_amdgcn_s_barrier(); asm volatile("" ::: "memory");
        if (lane < 32) { const float* sl = xbuf + (size_t)(u.pm * 256 + row) * 4; float t = 0.f;
#pragma unroll
            for (int k = 0; k < 4; ++k) t += __hip_atomic_load(sl + k, __ATOMIC_RELAXED, __HIP_MEMORY_SCOPE_AGENT);
            S[row] = rsqrtf(t * (1.0f / 1024.0f) + EPS); }
        LDS_WAIT(); __builtin_amdgcn_s_barrier(); asm volatile("" ::: "memory");
    }
};
struct EpiFinal {
    const float *x, *g5, *mod; const bf16* D12; float* out; PanelRms st; LAS float* tab;
    __device__ __forceinline__ void operator()(ACC_T, const pg8::Unit& u, int wr, int wc, int fr, int fq) const {
        const int wid = wr * 4 + wc, lane = fq * 16 + fr; LAS float* S = tab + 1024;
        st.run(acc, u, wr, wc, fr, fq, tab, S, wid, lane);
        const int col0 = u.pn * 256 + wc * 32 + 8 * fq, rt0 = wr * 64 + fr, v = (u.pm * 256) >> 12;
        const unsigned e0 = (unsigned)((u.pm * 256 + rt0) * D + col0);
        const float* gate = mod + (size_t)v * 9216 + 8 * 1024;
#pragma unroll
        for (int bj = 0; bj < 2; ++bj) {
            const unsigned cb = (unsigned)(col0 + bj * 128) * 4u;
            f32x4 g0 = ldg<f32x4>(g5, cb), g1 = ldg<f32x4>(g5, cb + 16); const f32x4 t0 = ldg<f32x4>(gate, cb), t1 = ldg<f32x4>(gate, cb + 16);
            g0 = g0 * t0 * 0.5f; g1 = g1 * t1 * 0.5f;
            ROWGROUPS(ai, m) { const float rs = S[ai * 128 + m * 16 + rt0]; const unsigned e = e0 + (unsigned)((ai * 128 + m * 16) * D) + bj * 128;
                const f32x4 x0 = ldg<f32x4>(x, e * 4u), x1 = ldg<f32x4>(x, e * 4u + 16); const u32x4 dd = ldg<u32x4>(D12, e * 2u);
                f32x4 o0, o1;
                o0[0] = x0[0] + bflo(dd[0]); o0[1] = x0[1] + bfhi(dd[0]); o0[2] = x0[2] + bflo(dd[1]); o0[3] = x0[3] + bfhi(dd[1]);
                o1[0] = x1[0] + bflo(dd[2]); o1[1] = x1[1] + bfhi(dd[2]); o1[2] = x1[2] + bflo(dd[3]); o1[3] = x1[3] + bfhi(dd[3]);
                o0 = o0 + acc[ai][bj][m][0] * rs * g0; o1 = o1 + acc[ai][bj][m][1] * rs * g1;
                stg(out, e * 4u, o0); stg(out, e * 4u + 16, o1);
                asm volatile("" ::: "memory"); } }
    }
};
struct EpiMix {
    const float *x, *g3, *g4, *mod; const bf16* D1; bf16 *D12, *U3; PanelRms st1, st2; LAS float* tab;
    __device__ __forceinline__ void operator()(f32x4 (&acc)[2][2][4][2], const pg8::Unit& u, int wr, int wc, int fr, int fq) const {
        const int wid = wr * 4 + wc, lane = fq * 16 + fr; LAS float* S = tab + 1024;
        st1.run(acc, u, wr, wc, fr, fq, tab, S, wid, lane);
        const int col0 = u.pn * 256 + wc * 32 + 8 * fq, rt0 = wr * 64 + fr, v = (u.pm * 256) >> 12;
        const unsigned e0 = (unsigned)((u.pm * 256 + rt0) * D + col0);
        const float* mv = mod + (size_t)v * 9216;
#pragma unroll
        for (int bj = 0; bj < 2; ++bj) {
            const unsigned cb = (unsigned)(col0 + bj * 128) * 4u;
            f32x4 g0 = ldg<f32x4>(g3, cb), g1 = ldg<f32x4>(g3, cb + 16); const f32x4 t0 = ldg<f32x4>(mv + 5 * 1024, cb), t1 = ldg<f32x4>(mv + 5 * 1024, cb + 16);
            g0 = g0 * t0; g1 = g1 * t1;
            ROWGROUPS(ai, m) { const float rs = S[ai * 128 + m * 16 + rt0]; const unsigned e = e0 + (unsigned)((ai * 128 + m * 16) * D) + bj * 128;
                const u32x4 dd = ldg<u32x4>(D1, e * 2u);
                f32x4 d0, d1;
                d0[0] = bflo(dd[0]); d0[1] = bfhi(dd[0]); d0[2] = bflo(dd[1]); d0[3] = bfhi(dd[1]); d1[0] = bflo(dd[2]); d1[1] = bfhi(dd[2]); d1[2] = bflo(dd[3]); d1[3] = bfhi(dd[3]);
                d0 = d0 + acc[ai][bj][m][0] * rs * g0; d1 = d1 + acc[ai][bj][m][1] * rs * g1;
                const u32x4 pk = pack8(d0, d1); stg(D12, e * 2u, pk);
                const f32x4 x0 = ldg<f32x4>(x, e * 4u), x1 = ldg<f32x4>(x, e * 4u + 16);
                f32x4 h0, h1;
                h0[0] = x0[0] + bflo(pk[0]); h0[1] = x0[1] + bfhi(pk[0]); h0[2] = x0[2] + bflo(pk[1]); h0[3] = x0[3] + bfhi(pk[1]);
                h1[0] = x1[0] + bflo(pk[2]); h1[1] = x1[1] + bfhi(pk[2]); h1[2] = x1[2] + bflo(pk[3]); h1[3] = x1[3] + bfhi(pk[3]);
                acc[ai][bj][m][0] = h0; acc[ai][bj][m][1] = h1;
                asm volatile("" ::: "memory"); } }
        st2.run(acc, u, wr, wc, fr, fq, tab, S, wid, lane);
#pragma unroll
        for (int bj = 0; bj < 2; ++bj) {
            const unsigned cb = (unsigned)(col0 + bj * 128) * 4u;
            f32x4 g0 = ldg<f32x4>(g4, cb), g1 = ldg<f32x4>(g4, cb + 16); const f32x4 c0 = ldg<f32x4>(mv + 7 * 1024, cb), c1 = ldg<f32x4>(mv + 7 * 1024, cb + 16);
            const f32x4 s0 = ldg<f32x4>(mv + 6 * 1024, cb), s1 = ldg<f32x4>(mv + 6 * 1024, cb + 16);
            g0 = g0 * (c0 + 1.0f); g1 = g1 * (c1 + 1.0f);
            ROWGROUPS(ai, m) { const float rs = S[ai * 128 + m * 16 + rt0]; const unsigned e = e0 + (unsigned)((ai * 128 + m * 16) * D) + bj * 128;
                stg(U3, e * 2u, pack8(acc[ai][bj][m][0] * rs * g0 + s0, acc[ai][bj][m][1] * rs * g1 + s1)); } }
    }
};

struct Frame { LAS unsigned char* lds; int tid, lane, wave, gw, ngw; };

__device__ __forceinline__ void transpose_item(const float* W, int K, int Nsrc, bf16* WT, int dst_row0, int src_col0, int k0, LAS float* scr, int lane, float scale = 1.0f) {
    float tv[32];
    { const float* wp = W + (size_t)(k0 + (lane >> 5)) * Nsrc + src_col0 + (lane & 31);
#pragma unroll
      for (int i = 0; i < 32; ++i) tv[i] = __builtin_nontemporal_load(wp + (size_t)(2 * i) * Nsrc); }
#pragma unroll
    for (int i = 0; i < 32; ++i) scr[(2 * i + (lane >> 5)) * 33 + (lane & 31)] = tv[i] * scale;
    LDS_WAIT(); asm volatile("" ::: "memory");
    const int c = lane & 7;
#pragma unroll
    for (int j = 0; j < 4; ++j) { const int n = (lane >> 3) + 8 * j; const LAS float* s = scr + (8 * c) * 33 + n;
        u32x4 o; o.x = pk2(s[0 * 33], s[1 * 33]); o.y = pk2(s[2 * 33], s[3 * 33]); o.z = pk2(s[4 * 33], s[5 * 33]); o.w = pk2(s[6 * 33], s[7 * 33]);
        *(u32x4*)(WT + (size_t)(dst_row0 + n) * K + k0 + 8 * c) = o; }
    LDS_WAIT(); asm volatile("" ::: "memory");
}
__device__ __forceinline__ void conv_w13(const Frame& F, const float* w13, bf16* dst, int it0, int its) {
    LAS float* scr = (LAS float*)(F.lds + F.wave * 16384);
    for (int it = it0 + F.gw; it < it0 + its; it += F.ngw) { const int r = it, kb = r / 176, nb = r % 176, n0 = 32 * nb, j = n0 >> 8, s = (n0 >> 7) & 1, i0 = n0 & 127;
        transpose_item(w13, D, 2 * FF, dst, n0, s * FF + 128 * j + i0, 64 * kb, scr, F.lane, s ? 0.6931471805599453f : 1.4426950408889634f); }
}
__device__ __forceinline__ void conv_plain(const Frame& F, const float* W, int K, int N, bf16* dst, int it0, int its) {
    LAS float* scr = (LAS float*)(F.lds + F.wave * 16384);
    const int nblk = N / 32;
    for (int it = it0 + F.gw; it < it0 + its; it += F.ngw) { const int r = it, kb = r / nblk, nb = r % nblk;
        transpose_item(W, K, N, dst, 32 * nb, 32 * nb, 64 * kb, scr, F.lane); }
}
__device__ __forceinline__ int win_src_col(int n0) {
    if (n0 < ROW_K) return COL_Q + n0;
    if (n0 < ROW_V) return COL_K + (n0 - ROW_K);
    if (n0 < ROW_F) return COL_V + (n0 - ROW_V);
    if (n0 < ROW_O) return COL_F + (n0 - ROW_F);
    if (n0 < ROW_GF) return COL_O + (n0 - ROW_O);
    { const int r = n0 - ROW_GF, j = r >> 8, sg = (r >> 7) & 1, i0 = r & 127; return (sg ? COL_GM : COL_GF) + 128 * j + i0; }
}
__device__ __forceinline__ void conv_win(const Frame& F, const float* w_in, bf16* dst, int it0, int its) {
    LAS float* scr = (LAS float*)(F.lds + F.wave * 16384);
    constexpr int nblk = WIN_ROWS / 32;
    for (int it = it0 + F.gw; it < it0 + its; it += F.ngw) { const int r = it, kb = r / nblk, nb = r % nblk;
        transpose_item(w_in, D, INW, dst, 32 * nb, win_src_col(32 * nb), 64 * kb, scr, F.lane); }
}

__device__ __forceinline__ void ada_phase(const Frame& F, const Params& p) {
    LAS float* sc = (LAS float*)F.lds;
    LAS float* part = sc + 5 * 1024;
    float* mod = (float*)(p.ws + WS_MOD);
    for (int i = F.tid; i < 5 * 1024; i += NTHR) { const int v = i >> 10, k = i & 1023; const float cv = v < 4 ? p.c[v * 1024 + k] : p.c_ctx[k]; sc[i] = siluf_(cv); }
    __syncthreads();
    for (int tile = blockIdx.x; tile < 144; tile += gridDim.x) {
        const int col = 64 * tile + F.lane;
        float a0 = 0.f, a1 = 0.f, a2 = 0.f, a3 = 0.f, a4 = 0.f;
#pragma unroll 32
        for (int it = 0; it < 128; ++it) { const int k = 128 * F.wave + it; const float w = __builtin_nontemporal_load(p.w_ada + (size_t)k * 9216 + col);
            a0 += sc[k] * w; a1 += sc[1024 + k] * w; a2 += sc[2048 + k] * w; a3 += sc[3072 + k] * w; a4 += sc[4096 + k] * w; }
        { LAS float* pp = part + F.wave * 320 + F.lane; pp[0] = a0; pp[64] = a1; pp[128] = a2; pp[192] = a3; pp[256] = a4; }
        __syncthreads();
        if (F.tid < 320) { float s = 0.f;
#pragma unroll
            for (int w = 0; w < 8; ++w) s += part[w * 320 + F.tid];
            const int v = F.tid >> 6, cc = 64 * tile + (F.tid & 63); mod[v * 9216 + cc] = s + p.b_ada[cc]; }
        __syncthreads();
    }
}
__device__ __forceinline__ void wfour_phase(const Frame& F, const Params& p) {
    LAS float* ct = (LAS float*)(F.lds + 32768);
    if (F.tid < 128) ct[F.tid] = cosf((float)F.tid * (6.283185307179586f / 128.0f));
    __syncthreads();
    bf16* WF = (bf16*)(p.ws + WS_WFOUR);
    for (int task = blockIdx.x * NTHR + F.tid; task < 1024 * 128; task += gridDim.x * NTHR) {
        const int n = task & 1023, jg = task >> 10, i = jg >> 1, pq = jg & 1, f0 = 8 * i, g = f0 >> 7, ch0 = f0 & 127;
        float a[8];
#pragma unroll
        for (int t = 0; t < 8; ++t) a[t] = 0.f;
        const float* wp = p.w_four + (size_t)(g * 128) * 1024 + n;
        const int sh = pq ? 96 : 0;
#pragma unroll 8
        for (int k3 = 0; k3 < 128; ++k3) { const float w = wp[(size_t)k3 * 1024];
#pragma unroll
            for (int t = 0; t < 8; ++t) a[t] += ct[(k3 * (ch0 + t) + sh) & 127] * w; }
        const float scl = pq ? -0.08838834764831845f : 0.08838834764831845f;
        u32x4 o; o.x = pk2(a[0] * scl, a[1] * scl); o.y = pk2(a[2] * scl, a[3] * scl); o.z = pk2(a[4] * scl, a[5] * scl); o.w = pk2(a[6] * scl, a[7] * scl);
        *(u32x4*)(WF + (size_t)n * 1024 + 8 * jg) = o;
    }
    __syncthreads();
}

struct Row { f32x4 v[4]; };
__device__ __forceinline__ Row ld_row_f32(const float* r, int lane) { Row o; const f32x4* q = (const f32x4*)r + lane;
#pragma unroll
    for (int j = 0; j < 4; ++j) o.v[j] = q[64 * j]; return o; }
__device__ __forceinline__ Row ld_row_bf16(const bf16* r, int lane) { Row o; const u32x2* q = (const u32x2*)r + lane;
#pragma unroll
    for (int j = 0; j < 4; ++j) { const u32x2 w = q[64 * j]; o.v[j] = (f32x4){bflo(w.x), bfhi(w.x), bflo(w.y), bfhi(w.y)}; } return o; }
__device__ __forceinline__ void st_row_bf16(bf16* r, int lane, const Row& a) { u32x2* q = (u32x2*)r + lane;
#pragma unroll
    for (int j = 0; j < 4; ++j) { u32x2 w; w.x = pk2(a.v[j][0], a.v[j][1]); w.y = pk2(a.v[j][2], a.v[j][3]); q[64 * j] = w; } }
__device__ __forceinline__ void st_row_f32(float* r, int lane, const Row& a) { f32x4* q = (f32x4*)r + lane;
#pragma unroll
    for (int j = 0; j < 4; ++j) q[64 * j] = a.v[j]; }
__device__ __forceinline__ float row_rstd(const Row& a) { float s = 0.f;
#pragma unroll
    for (int j = 0; j < 4; ++j) s += (a.v[j][0] * a.v[j][0] + a.v[j][1] * a.v[j][1]) + (a.v[j][2] * a.v[j][2] + a.v[j][3] * a.v[j][3]);
    return rsqrtf(wave_sum(s) * (1.0f / 1024.0f) + EPS); }
__device__ __forceinline__ Row round_bf16(const Row& a) { Row o;
#pragma unroll
    for (int j = 0; j < 4; ++j)
#pragma unroll
        for (int e = 0; e < 4; ++e) o.v[j][e] = bf2f(f2bf(a.v[j][e]));
    return o; }
__device__ __forceinline__ Row modnorm2(const Row& h, const Row& gs, const Row& sh) {
    const float rs = row_rstd(h); Row o;
#pragma unroll
    for (int j = 0; j < 4; ++j) o.v[j] = h.v[j] * rs * gs.v[j] + sh.v[j];
    return o; }
__device__ __forceinline__ Row gated_norm2(const Row& y, const Row& gg) {
    const float rs = row_rstd(y); Row o;
#pragma unroll
    for (int j = 0; j < 4; ++j) o.v[j] = y.v[j] * rs * gg.v[j];
    return o; }
__device__ __forceinline__ Row rmul(const Row& a, const Row& b) { Row o;
#pragma unroll
    for (int j = 0; j < 4; ++j) o.v[j] = a.v[j] * b.v[j]; return o; }
__device__ __forceinline__ Row rmul1p(const Row& g, const Row& sc) { Row o;
#pragma unroll
    for (int j = 0; j < 4; ++j) o.v[j] = g.v[j] * (sc.v[j] + 1.0f); return o; }
__device__ __forceinline__ Row rscale(const Row& a, float c) { Row o;
#pragma unroll
    for (int j = 0; j < 4; ++j) o.v[j] = a.v[j] * c; return o; }
__device__ __forceinline__ Row radd(const Row& a, const Row& b) { Row o;
#pragma unroll
    for (int j = 0; j < 4; ++j) o.v[j] = a.v[j] + b.v[j]; return o; }
__device__ __forceinline__ const float* modp(const Params& p, int v, int i) { return (const float*)(p.ws + WS_MOD) + (size_t)v * 9216 + i * 1024; }
__device__ __forceinline__ const float* xrow(const Params& p, int r) { return r < TLAT ? p.x + (size_t)r * D : p.ctx + (size_t)(r - TLAT) * D; }
__device__ __forceinline__ int rowvar(int r) { return r < TLAT ? (r >> 12) : 4; }

__device__ __forceinline__ int row_of(const Frame& F, int it) {
    const int per = F.ngw >> 2, nl = (SEQ + per - 1) / per;
    if (it < nl) { const int rl = (F.gw >> 2) + it * per; if (rl < SEQ) return (F.gw & 3) * SEQ + rl; it = nl; }
    const int rc = F.gw + (it - nl) * F.ngw; return rc < TCTX ? TLAT + rc : -1;
}
__device__ __forceinline__ int lat_row(const Frame& F, int k) { const int rl = (F.gw >> 2) + k * (F.ngw >> 2); return rl < SEQ ? (F.gw & 3) * SEQ + rl : -1; }
__device__ __forceinline__ void phase_u1(const Frame& F, const Params& p) {
    bf16* U = (bf16*)(p.ws + WS_U);
    { const int v = F.gw & 3; const Row gs = rmul1p(ld_row_f32(p.norm_g, F.lane), ld_row_f32(modp(p, v, 1), F.lane)), sh = ld_row_f32(modp(p, v, 0), F.lane);
      for (int k0 = 0; lat_row(F, k0) >= 0; k0 += 4) { Row xr[4]; int rr[4];
#pragma unroll
          for (int q = 0; q < 4; ++q) { rr[q] = lat_row(F, k0 + q); if (rr[q] >= 0) xr[q] = ld_row_f32(p.x + (size_t)rr[q] * D, F.lane); }
#pragma unroll
          for (int q = 0; q < 4; ++q) if (rr[q] >= 0) st_row_bf16(U + (size_t)rr[q] * D, F.lane, modnorm2(xr[q], gs, sh)); } }
    { const Row gs = rmul1p(ld_row_f32(p.norm_g, F.lane), ld_row_f32(modp(p, 4, 1), F.lane)), sh = ld_row_f32(modp(p, 4, 0), F.lane);
      for (int rc = F.gw; rc < TCTX; rc += F.ngw) st_row_bf16(U + (size_t)(TLAT + rc) * D, F.lane, modnorm2(ld_row_f32(p.ctx + (size_t)rc * D, F.lane), gs, sh)); }
}
__device__ __forceinline__ void phase_post_ffn_a(const Frame& F, const Params& p) {
    bf16* U = (bf16*)(p.ws + WS_U2); bf16* D1 = (bf16*)((unsigned char*)p.out + DO_D1); const bf16* Y1 = (const bf16*)(p.ws + WS_Y1);
    { const int v = F.gw & 3; const Row gg = rscale(rmul(ld_row_f32(p.norm_g + 1 * D, F.lane), ld_row_f32(modp(p, v, 2), F.lane)), 0.5f);
      const Row gs = rmul1p(ld_row_f32(p.norm_g + 2 * D, F.lane), ld_row_f32(modp(p, v, 4), F.lane)), sh = ld_row_f32(modp(p, v, 3), F.lane);
      for (int k0 = 0; lat_row(F, k0) >= 0; k0 += 4) { Row xr[4], yr[4]; int rr[4];
#pragma unroll
          for (int q = 0; q < 4; ++q) { rr[q] = lat_row(F, k0 + q); if (rr[q] >= 0) { yr[q] = ld_row_bf16(Y1 + (size_t)rr[q] * D, F.lane); xr[q] = ld_row_f32(p.x + (size_t)rr[q] * D, F.lane); } }
#pragma unroll
          for (int q = 0; q < 4; ++q) if (rr[q] >= 0) { const Row dl = round_bf16(gated_norm2(yr[q], gg)); st_row_bf16(D1 + (size_t)rr[q] * D, F.lane, dl);
              st_row_bf16(U + (size_t)rr[q] * D, F.lane, modnorm2(radd(xr[q], dl), gs, sh)); } } }
    { const Row gg = rscale(rmul(ld_row_f32(p.norm_g + 1 * D, F.lane), ld_row_f32(modp(p, 4, 2), F.lane)), 0.5f);
      const Row gs = rmul1p(ld_row_f32(p.norm_g + 2 * D, F.lane), ld_row_f32(modp(p, 4, 4), F.lane)), sh = ld_row_f32(modp(p, 4, 3), F.lane);
      for (int rc = F.gw; rc < TCTX; rc += F.ngw) { const float* yc = (const float*)(p.ws + WS_Y1C) + (size_t)rc * D;
          Row y = radd(radd(ld_row_f32(yc, F.lane), ld_row_f32(yc + (size_t)TCTX * D, F.lane)), radd(ld_row_f32(yc + (size_t)2 * TCTX * D, F.lane), ld_row_f32(yc + (size_t)3 * TCTX * D, F.lane)));
          y = radd(y, radd(radd(ld_row_f32(yc + (size_t)4 * TCTX * D, F.lane), ld_row_f32(yc + (size_t)5 * TCTX * D, F.lane)), radd(ld_row_f32(yc + (size_t)6 * TCTX * D, F.lane), ld_row_f32(yc + (size_t)7 * TCTX * D, F.lane))));
          const Row dl = round_bf16(gated_norm2(y, gg));
          st_row_bf16(U + (size_t)(TLAT + rc) * D, F.lane, modnorm2(radd(ld_row_f32(p.ctx + (size_t)rc * D, F.lane), dl), gs, sh)); } }
}
__device__ __forceinline__ void phase_u2_again(const Frame& F, const Params& p) {
    bf16* U = (bf16*)(p.ws + WS_U); const bf16* D1 = (const bf16*)((unsigned char*)p.out + DO_D1);
    const int v = F.gw & 3; const Row gs = rmul1p(ld_row_f32(p.norm_g + 2 * D, F.lane), ld_row_f32(modp(p, v, 4), F.lane)), sh = ld_row_f32(modp(p, v, 3), F.lane);
    for (int k0 = 0; lat_row(F, k0) >= 0; k0 += 4) { Row xr[4], dr[4]; int rr[4];
#pragma unroll
        for (int q = 0; q < 4; ++q) { rr[q] = lat_row(F, k0 + q); if (rr[q] >= 0) { xr[q] = ld_row_f32(p.x + (size_t)rr[q] * D, F.lane); dr[q] = ld_row_bf16(D1 + (size_t)rr[q] * D, F.lane); } }
#pragma unroll
        for (int q = 0; q < 4; ++q) if (rr[q] >= 0) st_row_bf16(U + (size_t)rr[q] * D, F.lane, modnorm2(radd(xr[q], dr[q]), gs, sh)); }
}

constexpr int SQK_STRIDE = 544;
constexpr int M1_SQ = 0, M1_SK = 128 * SQK_STRIDE, M1_TAB = 2 * 128 * SQK_STRIDE;
__device__ __forceinline__ float logsigmoidf_(float x) { return fminf(x, 0.f) - log1pf(__expf(-fabsf(x))); }

__device__ __forceinline__ void m1_item(const Frame& F, const Params& p, int bh, int cp) {
    const int b = bh >> 2, h = bh & 3; const bool is_lat = cp >= 2;
    const int seqlen = is_lat ? SEQ : CTXL, t0 = is_lat ? CH * (cp - 2) : CH * cp, rowbase = is_lat ? b * SEQ : TLAT + b * CTXL, pbase = CH * cp;
    const bf16* QPRE = (const bf16*)(p.ws + WS_QPRE); const bf16* KPRE = (const bf16*)(p.ws + WS_KPRE);
    LAS unsigned char* sQ = F.lds + M1_SQ; LAS unsigned char* sK = F.lds + M1_SK; LAS float* tab = (LAS float*)(F.lds + M1_TAB);
    const int lane = F.lane, w = F.wave, fr = lane & 15, fq = lane >> 4;
    {
        const int ch = 8 * (F.tid & 31), rb = 8 * (F.tid >> 5);
#define M1_CONV(SRC, CCH, SCALE, DST) do { \
        float w0[8], w1[8], w2[8], bb[8]; \
        _Pragma("unroll") for (int e = 0; e < 8; ++e) { const int cc = (CCH) + h * 256 + ch + e; w0[e] = p.conv_w[cc]; w1[e] = p.conv_w[2048 + cc]; w2[e] = p.conv_w[4096 + cc]; bb[e] = p.conv_b[cc]; } \
        u32x4 xr[10]; const bf16* base = (SRC) + (size_t)(rowbase + t0 + rb) * D + h * 256 + ch; \
        _Pragma("unroll") for (int i = 0; i < 10; ++i) { const int sq = t0 + rb + i - 1; xr[i] = (sq >= 0 && sq < seqlen) ? *(const u32x4*)(base + (ptrdiff_t)(i - 1) * D) : (u32x4){0u, 0u, 0u, 0u}; } \
        _Pragma("unroll") for (int i = 0; i < 8; ++i) { float o[8]; \
            _Pragma("unroll") for (int q = 0; q < 4; ++q) { \
                const float y0 = w0[2 * q] * bflo(xr[i][q]) + w1[2 * q] * bflo(xr[i + 1][q]) + w2[2 * q] * bflo(xr[i + 2][q]) + bb[2 * q]; \
                const float y1 = w0[2 * q + 1] * bfhi(xr[i][q]) + w1[2 * q + 1] * bfhi(xr[i + 1][q]) + w2[2 * q + 1] * bfhi(xr[i + 2][q]) + bb[2 * q + 1]; \
                o[2 * q] = siluf_(y0) * (SCALE); o[2 * q + 1] = siluf_(y1) * (SCALE); } \
            u32x4 wv; wv.x = pk2(o[0], o[1]); wv.y = pk2(o[2], o[3]); wv.z = pk2(o[4], o[5]); wv.w = pk2(o[6], o[7]); \
            *(LAS u32x4*)((DST) + (rb + i) * SQK_STRIDE + ch * 2) = wv; } } while (0)
        M1_CONV(KPRE, 1024, 0.0625f, sK);
        if (is_lat) M1_CONV(QPRE, 0, 1.0f, sQ);
#undef M1_CONV
    }
    if (w < 2) {
        const int dir = w; const float* G = (const float*)(p.ws + WS_GATES);
        const int i0 = 2 * lane, i1 = 2 * lane + 1, ta = dir ? 127 - i0 : i0, tb = dir ? 127 - i1 : i1;
        const float li0 = G[(size_t)(rowbase + t0 + ta) * 16 + dir * 8 + h], li1 = G[(size_t)(rowbase + t0 + tb) * 16 + dir * 8 + h];
        const float lf0 = logsigmoidf_(G[(size_t)(rowbase + t0 + ta) * 16 + dir * 8 + 4 + h]), lf1 = logsigmoidf_(G[(size_t)(rowbase + t0 + tb) * 16 + dir * 8 + 4 + h]);
        float ps = lf0 + lf1;
#pragma unroll
        for (int o = 1; o < 64; o <<= 1) { const float v = __shfl_up(ps, o); if (lane >= o) ps += v; }
        const float ex = ps - (lf0 + lf1), b0 = ex + lf0, b1 = ex + lf0 + lf1;
        const float r0 = li0 - b0, r1 = li1 - b1;
        float pm = fmaxf(r0, r1);
#pragma unroll
        for (int o = 1; o < 64; o <<= 1) { const float v = __shfl_up(pm, o); if (lane >= o) pm = fmaxf(pm, v); }
        const float pmex = __shfl_up(pm, 1); const float m0 = lane ? fmaxf(pmex, r0) : r0, m1 = pm;
        LAS float* tb_ = tab + dir * 384;
        tb_[ta] = b0; tb_[128 + ta] = r0; tb_[256 + ta] = m0; tb_[tb] = b1; tb_[128 + tb] = r1; tb_[256 + tb] = m1;
        float* TS = (float*)(p.ws + WS_TOKSC) + ((size_t)(dir * 16 + bh) * PLEN + pbase) * 4;
        TS[ta * 4 + 0] = b0; TS[ta * 4 + 1] = li0; TS[ta * 4 + 2] = b0 + m0; TS[tb * 4 + 0] = b1; TS[tb * 4 + 1] = li1; TS[tb * 4 + 2] = b1 + m1;
        if (lane == 63) { float* CS = (float*)(p.ws + WS_CHSC) + ((size_t)(dir * 16 + bh) * NCHK + cp) * 2; CS[0] = b1; CS[1] = b1 + m1; }
    }
    __syncthreads();
    {
        u32x4* KT = (u32x4*)(p.ws + WS_KT) + ((size_t)bh * NCHK + cp) * 4096;
        const int d = F.tid & 255, sgp = F.tid >> 8;
#pragma unroll
        for (int it = 0; it < 8; ++it) { const int sg = 2 * it + sgp; unsigned short e[8];
#pragma unroll
            for (int j = 0; j < 8; ++j) e[j] = *(const LAS unsigned short*)(sK + (8 * sg + j) * SQK_STRIDE + d * 2);
            u32x4 o; o.x = e[0] | ((unsigned)e[1] << 16); o.y = e[2] | ((unsigned)e[3] << 16); o.z = e[4] | ((unsigned)e[5] << 16); o.w = e[6] | ((unsigned)e[7] << 16);
            KT[((((d >> 5) * 2 + ((d >> 4) & 1)) * 4 + (sg >> 2)) * 64) + (sg & 3) * 16 + (d & 15)] = o; }
        if (is_lat) { u32x4* Q = (u32x4*)(p.ws + WS_Q) + ((size_t)bh * 32 + (cp - 2)) * 4096;
#pragma unroll
            for (int it = 0; it < 8; ++it) { const int piece = F.tid + 512 * it, row = piece >> 5, c16 = piece & 31;
                Q[((row >> 4) * 8 + (c16 >> 2)) * 64 + (c16 & 3) * 16 + (row & 15)] = *(const LAS u32x4*)(sQ + row * SQK_STRIDE + c16 * 16); } }
    }
    if (is_lat) {
        bf16x8 bq[8];
#pragma unroll
        for (int k = 0; k < 8; ++k) bq[k] = *(const LAS bf16x8*)(sQ + (16 * w + fr) * SQK_STRIDE + (32 * k + 8 * fq) * 2);
        f32x4 acc[8];
#pragma unroll
        for (int mt = 0; mt < 8; ++mt) { acc[mt] = (f32x4){0.f, 0.f, 0.f, 0.f};
#pragma unroll
            for (int k = 0; k < 8; ++k) { const bf16x8 a = *(const LAS bf16x8*)(sK + (16 * mt + fr) * SQK_STRIDE + (32 * k + 8 * fq) * 2);
                acc[mt] = __builtin_amdgcn_mfma_f32_16x16x32_bf16(a, bq[k], acc[mt], 0, 0, 0); } }
        const int t = 16 * w + fr, c = cp - 2;
        bf16* P = (bf16*)((unsigned char*)p.out + DO_P);
#pragma unroll
        for (int dir = 0; dir < 2; ++dir) {
            const LAS float* tb_ = tab + dir * 384; const float mx = tb_[256 + t]; float dsum = 0.f;
            unsigned char* pblk = (unsigned char*)(P + ((size_t)(dir * 16 + bh) * 32 + c) * 128 * 128);
#pragma unroll
            for (int mt = 0; mt < 8; ++mt) { const int s0 = 16 * mt + 4 * fq; const f32x4 rs = *(const LAS f32x4*)(tb_ + 128 + s0); float pv[4];
#pragma unroll
                for (int r = 0; r < 4; ++r) { const int s = s0 + r; const bool valid = dir ? (s >= t) : (s <= t);
                    const float wgt = valid ? __expf(fminf(rs[r] - mx, 0.f)) : 0.f; pv[r] = bf2f(f2bf(acc[mt][r] * wgt)); dsum += pv[r]; }
                u32x2 o; o.x = pk2(pv[0], pv[1]); o.y = pk2(pv[2], pv[3]); const int s8 = 2 * mt + (fq >> 1);
                *(u32x2*)(pblk + ((w * 4 + (s8 >> 2)) * 64 + (s8 & 3) * 16 + fr) * 16 + (fq & 1) * 8) = o; }
            dsum += __shfl_xor(dsum, 16); dsum += __shfl_xor(dsum, 32);
            if (fq == 0) ((float*)(p.ws + WS_TOKSC))[((size_t)(dir * 16 + bh) * PLEN + pbase + t) * 4 + 3] = dsum;
        }
    }
    __syncthreads();
}

constexpr int FO_TAB = 131072;
__device__ __forceinline__ int fo_off(int R, int r) { return R * 128 + ((((r >> 3) ^ ((R >> 1) & 7))) << 4) + (r & 7) * 2; }
__device__ __forceinline__ void fourier_item(const Frame& F, const Params& p, int item) {
    const int b = item >> 6, i = item & 63; const int lane = F.lane, w = F.wave, fr = lane & 15, fq = lane >> 4;
    LAS unsigned char* sPQ = F.lds; LAS float* ct = (LAS float*)(F.lds + FO_TAB);
    if (F.tid < 64) ct[F.tid] = cosf((float)F.tid * (6.283185307179586f / 64.0f));
    __syncthreads();
    const bf16* XT = (const bf16*)(p.ws + WS_XFT);
    {
        const bf16* xrow_ = XT + (size_t)(8 * i + w) * TLAT + b * SEQ;
        bf16x8 xv[4][2];
#pragma unroll
        for (int nt = 0; nt < 4; ++nt) { const int r = 16 * nt + fr; xv[nt][0] = *(const bf16x8*)(xrow_ + r * 64 + 8 * fq); xv[nt][1] = *(const bf16x8*)(xrow_ + r * 64 + 32 + 8 * fq); }
#pragma unroll 1
        for (int mt = 0; mt < 8; ++mt) {
            bf16x8 WA[2];
#pragma unroll
            for (int k = 0; k < 2; ++k) { const int kc = (16 * mt + fr) & 63, sh = (mt >> 2) * 48; bf16x8 v;
#pragma unroll
                for (int j = 0; j < 8; ++j) { const int c = 32 * k + 8 * fq + j; v[j] = (short)f2bf(ct[(kc * c + sh) & 63]); }
                WA[k] = v; }
#pragma unroll
            for (int nt = 0; nt < 4; ++nt) { const int r = 16 * nt + fr; f32x4 a = (f32x4){0.f, 0.f, 0.f, 0.f};
                a = __builtin_amdgcn_mfma_f32_16x16x32_bf16(WA[0], xv[nt][0], a, 0, 0, 0); a = __builtin_amdgcn_mfma_f32_16x16x32_bf16(WA[1], xv[nt][1], a, 0, 0, 0);
#pragma unroll
                for (int rg = 0; rg < 4; ++rg) { const int kcp = 16 * mt + 4 * fq + rg; *(LAS unsigned short*)(sPQ + fo_off(kcp * 8 + w, r)) = (unsigned short)f2bf(a[rg]); } } }
    }
    __syncthreads();
    {
        bf16x8 WB[4];
        const int kr = (16 * w + fr) & 63, half = w >> 2;
#pragma unroll
        for (int ks = 0; ks < 4; ++ks) { const int pq = ks >> 1; unsigned short e[8];
#pragma unroll
            for (int j = 0; j < 8; ++j) { const int r = 32 * (ks & 1) + 8 * fq + j;
                float v; if (half == pq) v = ct[(kr * r) & 63]; else { v = ct[(kr * r + 48) & 63]; if (half == 0) v = -v; }
                e[j] = (unsigned short)f2bf(v * 0.015625f); }
            bf16x8 v; v[0] = (short)e[0]; v[1] = (short)e[1]; v[2] = (short)e[2]; v[3] = (short)e[3]; v[4] = (short)e[4]; v[5] = (short)e[5]; v[6] = (short)e[6]; v[7] = (short)e[7]; WB[ks] = v; }
        bf16* UF = (bf16*)(p.ws + WS_UF) + (size_t)(b * SEQ + (16 * (w & 3) + fr) * 64) * D + 16 * i + 8 * half + 4 * (fq & 1);
#pragma unroll 2
        for (int nt = 0; nt < 32; ++nt) { f32x4 a = (f32x4){0.f, 0.f, 0.f, 0.f};
#pragma unroll
            for (int ks = 0; ks < 4; ++ks) { const int R = (ks >> 1) * 512 + 16 * nt + fr, q = 4 * (ks & 1) + fq;
                const bf16x8 bb = *(const LAS bf16x8*)(sPQ + R * 128 + ((q ^ ((R >> 1) & 7)) << 4));
                a = __builtin_amdgcn_mfma_f32_16x16x32_bf16(bb, WB[ks], a, 0, 0, 0); }
            u32x2 o; o.x = pk2(a[0], a[1]); o.y = pk2(a[2], a[3]);
            *(u32x2*)(UF + (size_t)(2 * nt + (fq >> 1)) * D) = o; }
    }
    __syncthreads();
}

constexpr int M2_CT = 0, M2_CTB = 48 * 544, M2_VT = 2 * M2_CTB, M2_VTB = 32 * 288, M2_VW = M2_VT + 2 * M2_VTB, M2_VWB = 48 * 288, M2_TAB = M2_VW + 2 * M2_VWB, M2_TABB = 5 * 512, M2_SC = M2_TAB + 3 * M2_TABB, M2_HS = M2_SC + 1024;
struct M2Step { int cp, is_lat, p0, tl0, tokrow0; };
__device__ __forceinline__ M2Step m2_step(int dir, int b, int j) {
    M2Step s; const int jj = j < NCHK ? j : NCHK - 1;
    s.cp = dir ? (jj == 0 ? 1 : (jj == 1 ? 0 : 35 - jj)) : jj; s.is_lat = s.cp >= 2; s.p0 = CH * s.cp; s.tl0 = s.is_lat ? CH * (s.cp - 2) : 0;
    s.tokrow0 = s.is_lat ? b * SEQ + s.tl0 : TLAT + b * CTXL + CH * s.cp; return s;
}
__device__ __forceinline__ void m2_stream(const Frame& F, const Params& p, int sid) {
    const int x = sid & 7, jj_ = sid >> 3, gl = jj_ >> 3, slice = jj_ & 7, g = x + 8 * gl, dir = g >> 4, bh = g & 15, b = bh >> 2, h = bh & 3;
    int tid = F.tid; asm volatile("" : "+v"(tid)); const int lane = tid & 63, w = F.wave, fr = lane & 15, fq = lane >> 4, wa = w & 3, tr = tid & 255;
    const bool roleA = w < 4;
    LAS unsigned char* L = F.lds;
    LAS float* smst = (LAS float*)(L + M2_SC); LAS float* smnw = smst + 34; LAS float* sdec = smst + 68; LAS float* scs = smst + 102;
    const float* TS = (const float*)(p.ws + WS_TOKSC) + (size_t)(dir * 16 + bh) * PLEN * 4;
    const float* CS = (const float*)(p.ws + WS_CHSC) + (size_t)(dir * 16 + bh) * NCHK * 2;
    const bf16* VT = (const bf16*)(p.ws + WS_VT) + (size_t)(h * 256 + slice * 32 + (tr >> 4)) * MTOK + 8 * (tr & 15);
    const bf16x8* KT = (const bf16x8*)(p.ws + WS_KT) + (size_t)bh * NCHK * 4096 + wa * 1024 + lane;
    const bf16x8* Q = (const bf16x8*)(p.ws + WS_Q) + (size_t)bh * 32 * 4096 + wa * 1024 + lane;
    const bf16x8* P = (const bf16x8*)((const unsigned char*)p.out + DO_P) + (size_t)(dir * 16 + bh) * 32 * 2048 + wa * 512 + lane;
    bf16* H = (bf16*)(p.ws + (dir ? WS_HB : WS_HF)) + (size_t)(b * SEQ) * D + h * 256 + slice * 32;
    for (int i = tid; i < M2_TAB / 4; i += NTHR) ((LAS unsigned*)L)[i] = 0u;
    if (tid < 2 * NCHK) scs[tid] = CS[tid];
    __syncthreads();
    if (tid == 0) { float m = 0.f;
        for (int j = 0; j < NCHK; ++j) { const M2Step st = m2_step(dir, b, j); const float bL = scs[st.cp * 2], gmax = scs[st.cp * 2 + 1];
            const float mn = fmaxf(bL + m, gmax); smst[j] = m; smnw[j] = mn; sdec[j] = __expf(bL + m - mn); m = mn; } }
    __syncthreads();
#define M2_TABLES(jj, stp, sc) do { if (tr < 128 && (jj) < NCHK) { LAS float* tb_ = (LAS float*)(L + M2_TAB + ((jj) % 3) * M2_TABB); const float bL = scs[(stp).cp * 2], mst_ = smst[jj], mnw_ = smnw[jj]; \
        tb_[512 + tr] = __expf(fminf(bL - (sc)[0] + (sc)[1] - mnw_, 0.f)); \
        const float mt_ = fmaxf((sc)[0] + mst_, (sc)[2]); const float c_ = __expf((sc)[2] - mt_); \
        *(LAS f32x4*)(tb_ + 4 * tr) = (f32x4){__expf((sc)[0] + mst_ - mt_), c_, c_ * (sc)[3], __expf(-mt_)}; } } while (0)
#define M2_VSTAGE(jj, va, vb) do { if ((jj) < NCHK) { const LAS float* tb_ = (const LAS float*)(L + M2_TAB + ((jj) % 3) * M2_TABB); const int e = tr >> 4, sg = tr & 15; \
        const f32x4 wa_ = *(const LAS f32x4*)(tb_ + 512 + 8 * sg), wb_ = *(const LAS f32x4*)(tb_ + 516 + 8 * sg); u32x4 o_; \
        *(LAS u32x4*)(L + M2_VT + ((jj) & 1) * M2_VTB + e * 288 + sg * 16) = (va); *(LAS u32x4*)(L + M2_VT + ((jj) & 1) * M2_VTB + (e + 16) * 288 + sg * 16) = (vb); \
        o_[0] = pk2(bflo((va)[0]) * wa_[0], bfhi((va)[0]) * wa_[1]); o_[1] = pk2(bflo((va)[1]) * wa_[2], bfhi((va)[1]) * wa_[3]); o_[2] = pk2(bflo((va)[2]) * wb_[0], bfhi((va)[2]) * wb_[1]); o_[3] = pk2(bflo((va)[3]) * wb_[2], bfhi((va)[3]) * wb_[3]); \
        *(LAS u32x4*)(L + M2_VW + ((jj) & 1) * M2_VWB + e * 288 + sg * 16) = o_; \
        o_[0] = pk2(bflo((vb)[0]) * wa_[0], bfhi((vb)[0]) * wa_[1]); o_[1] = pk2(bflo((vb)[1]) * wa_[2], bfhi((vb)[1]) * wa_[3]); o_[2] = pk2(bflo((vb)[2]) * wb_[0], bfhi((vb)[2]) * wb_[1]); o_[3] = pk2(bflo((vb)[3]) * wb_[2], bfhi((vb)[3]) * wb_[3]); \
        *(LAS u32x4*)(L + M2_VW + ((jj) & 1) * M2_VWB + (e + 16) * 288 + sg * 16) = o_; \
        if (tr < 16) { u32x4 o2; o2[0] = pk2(wa_[0], wa_[1]); o2[1] = pk2(wa_[2], wa_[3]); o2[2] = pk2(wb_[0], wb_[1]); o2[3] = pk2(wb_[2], wb_[3]); \
            *(LAS u32x4*)(L + M2_VW + ((jj) & 1) * M2_VWB + 32 * 288 + tr * 16) = o2; } } } while (0)
#define M2_LDQ(QQ, st) do { const bf16x8* q_ = Q + (size_t)((st).is_lat ? (st).cp - 2 : 0) * 4096; _Pragma("unroll") for (int k = 0; k < 8; ++k) { (QQ)[0][k] = q_[k * 64]; (QQ)[1][k] = q_[(8 + k) * 64]; } } while (0)
#define M2_LDP(st) do { const bf16x8* p_ = P + (size_t)((st).is_lat ? (st).cp - 2 : 0) * 2048; _Pragma("unroll") for (int k = 0; k < 4; ++k) { pa[0][k] = p_[k * 64]; pa[1][k] = p_[(4 + k) * 64]; } } while (0)
#define M2_LDK(KK, st) do { const bf16x8* k_ = KT + (size_t)(st).cp * 4096; _Pragma("unroll") for (int mt = 0; mt < 4; ++mt) _Pragma("unroll") for (int k = 0; k < 4; ++k) (KK)[mt][k] = k_[(mt * 4 + k) * 64]; } while (0)
    const M2Step s0 = m2_step(dir, b, 0), s1 = m2_step(dir, b, 1);
    if (!roleA) { const f32x4 t0 = *(const f32x4*)(TS + (size_t)(s0.p0 + (tr & 127)) * 4), t1 = *(const f32x4*)(TS + (size_t)(s1.p0 + (tr & 127)) * 4);
        M2_TABLES(0, s0, t0); M2_TABLES(1, s1, t1); }
    __syncthreads();
    if (!roleA) { const u32x4 v0a = *(const u32x4*)(VT + s0.tokrow0), v0b = *(const u32x4*)(VT + (size_t)16 * MTOK + s0.tokrow0); M2_VSTAGE(0, v0a, v0b); }
    if (roleA) {
        bf16x8 qa[2][2][8], pa[2][4];
        M2_LDQ(qa[0], s0); M2_LDP(s0);
        __syncthreads();
        for (int jj = 0; jj < NCHK; jj += 2) {
#pragma unroll
          for (int u = 0; u < 2; ++u) { const int j = jj + u;
            const M2Step sj = m2_step(dir, b, j), sn = m2_step(dir, b, j + 1);
            M2_LDQ(qa[u ^ 1], sn);
            if (j > 0) { const M2Step sp = m2_step(dir, b, j - 1);
                if (sp.is_lat) {
#pragma unroll
                    for (int i2 = 0; i2 < 2; ++i2) { const int pc = tr + 256 * i2; const u32x4 hv = *(const LAS u32x4*)(L + M2_HS + ((j - 1) & 1) * 8192 + pc * 16);
                        *(u32x4*)(H + (size_t)(sp.tl0 + (pc >> 2)) * D + (pc & 3) * 8) = hv; } } }
            if (sj.is_lat) {
                const LAS unsigned char* sCT = L + M2_CT + (j & 1) * M2_CTB; const LAS unsigned char* sVT = L + M2_VT + (j & 1) * M2_VTB;
                const LAS float* tb = (const LAS float*)(L + M2_TAB + (j % 3) * M2_TABB);
                f32x4 aI[2][3], aA[2][2];
#pragma unroll
                for (int mt = 0; mt < 2; ++mt) {
#pragma unroll
                    for (int nt = 0; nt < 3; ++nt) aI[mt][nt] = (f32x4){0.f, 0.f, 0.f, 0.f};
                    aA[mt][0] = (f32x4){0.f, 0.f, 0.f, 0.f}; aA[mt][1] = (f32x4){0.f, 0.f, 0.f, 0.f}; }
                bf16x8 bc[3], bn[3];
#pragma unroll
                for (int nt = 0; nt < 3; ++nt) bc[nt] = *(const LAS bf16x8*)(sCT + (16 * nt + fr) * 544 + (8 * fq) * 2);
#pragma unroll
                for (int k = 0; k < 8; ++k) {
                    if (k < 7) {
#pragma unroll
                        for (int nt = 0; nt < 3; ++nt) bn[nt] = *(const LAS bf16x8*)(sCT + (16 * nt + fr) * 544 + (32 * (k + 1) + 8 * fq) * 2); }
#pragma unroll
                    for (int nt = 0; nt < 3; ++nt) {
                        aI[0][nt] = __builtin_amdgcn_mfma_f32_16x16x32_bf16(qa[u][0][k], bc[nt], aI[0][nt], 0, 0, 0);
                        aI[1][nt] = __builtin_amdgcn_mfma_f32_16x16x32_bf16(qa[u][1][k], bc[nt], aI[1][nt], 0, 0, 0); }
#pragma unroll
                    for (int nt = 0; nt < 3; ++nt) bc[nt] = bn[nt]; }
                { bf16x8 vc[2], vn2[2];
#pragma unroll
                  for (int nt = 0; nt < 2; ++nt) vc[nt] = *(const LAS bf16x8*)(sVT + (16 * nt + fr) * 288 + (8 * fq) * 2);
#pragma unroll
                  for (int k = 0; k < 4; ++k) {
                    if (k < 3) {
#pragma unroll
                        for (int nt = 0; nt < 2; ++nt) vn2[nt] = *(const LAS bf16x8*)(sVT + (16 * nt + fr) * 288 + (32 * (k + 1) + 8 * fq) * 2); }
#pragma unroll
                    for (int nt = 0; nt < 2; ++nt) {
                        aA[0][nt] = __builtin_amdgcn_mfma_f32_16x16x32_bf16(pa[0][k], vc[nt], aA[0][nt], 0, 0, 0);
                        aA[1][nt] = __builtin_amdgcn_mfma_f32_16x16x32_bf16(pa[1][k], vc[nt], aA[1][nt], 0, 0, 0); }
                    vc[0] = vn2[0]; vc[1] = vn2[1]; } }
                M2_LDP(sn);
                LAS unsigned short* sH = (LAS unsigned short*)(L + M2_HS + (j & 1) * 8192);
#pragma unroll
                for (int mt = 0; mt < 2; ++mt)
#pragma unroll
                    for (int rg = 0; rg < 4; ++rg) { const int t = 32 * wa + 16 * mt + 4 * fq + rg;
                        const float qn_ = __shfl(aI[mt][2][rg], lane & 48);
                        const f32x4 tv = *(const LAS f32x4*)(tb + 4 * t);
                        const float inv = __builtin_amdgcn_rcpf(fmaxf(fabsf(tv[0] * qn_ + tv[2]), tv[3]));
                        const unsigned hp = pk2((tv[0] * aI[mt][0][rg] + tv[1] * aA[mt][0][rg]) * inv, (tv[0] * aI[mt][1][rg] + tv[1] * aA[mt][1][rg]) * inv);
                        sH[t * 32 + fr] = (unsigned short)hp; sH[t * 32 + 16 + fr] = (unsigned short)(hp >> 16); }
            } else { M2_LDP(sn); }
            __syncthreads();
          }
        }
        { const M2Step sp = m2_step(dir, b, NCHK - 1);
          if (sp.is_lat) {
#pragma unroll
            for (int i2 = 0; i2 < 2; ++i2) { const int pc = tr + 256 * i2; const u32x4 hv = *(const LAS u32x4*)(L + M2_HS + ((NCHK - 1) & 1) * 8192 + pc * 16);
                *(u32x4*)(H + (size_t)(sp.tl0 + (pc >> 2)) * D + (pc & 3) * 8) = hv; } } }
    } else {
        bf16x8 ka[2][4][4];
        f32x4 accC[4][3];
#pragma unroll
        for (int mt = 0; mt < 4; ++mt)
#pragma unroll
            for (int nt = 0; nt < 3; ++nt) accC[mt][nt] = (f32x4){0.f, 0.f, 0.f, 0.f};
        M2_LDK(ka[0], s0);
        u32x4 vna = *(const u32x4*)(VT + s1.tokrow0), vnb = *(const u32x4*)(VT + (size_t)16 * MTOK + s1.tokrow0);
        f32x4 tn2 = *(const f32x4*)(TS + (size_t)(m2_step(dir, b, 2).p0 + (tr & 127)) * 4);
        __syncthreads();
        for (int jj = 0; jj < NCHK; jj += 2) {
#pragma unroll
          for (int u = 0; u < 2; ++u) { const int j = jj + u;
            const M2Step sn = m2_step(dir, b, j + 1), sn2 = m2_step(dir, b, j + 2);
            M2_LDK(ka[u ^ 1], sn);
            const LAS unsigned char* sVW = L + M2_VW + (j & 1) * M2_VWB; const float dec = sdec[j];
            const u32x4 vxa = *(const u32x4*)(VT + sn2.tokrow0), vxb = *(const u32x4*)(VT + (size_t)16 * MTOK + sn2.tokrow0);
            const f32x4 tn3 = *(const f32x4*)(TS + (size_t)(m2_step(dir, b, j + 3).p0 + (tr & 127)) * 4);
#pragma unroll
            for (int mt = 0; mt < 4; ++mt)
#pragma unroll
                for (int nt = 0; nt < 3; ++nt) accC[mt][nt] = accC[mt][nt] * dec;
            { bf16x8 wc[3], wn[3];
#pragma unroll
              for (int nt = 0; nt < 3; ++nt) wc[nt] = *(const LAS bf16x8*)(sVW + (16 * nt + fr) * 288 + (8 * fq) * 2);
#pragma unroll
              for (int k = 0; k < 4; ++k) {
                if (k < 3) {
#pragma unroll
                    for (int nt = 0; nt < 3; ++nt) wn[nt] = *(const LAS bf16x8*)(sVW + (16 * nt + fr) * 288 + (32 * (k + 1) + 8 * fq) * 2); }
#pragma unroll
                for (int nt = 0; nt < 3; ++nt)
#pragma unroll
                    for (int mt = 0; mt < 4; ++mt) accC[mt][nt] = __builtin_amdgcn_mfma_f32_16x16x32_bf16(ka[u][mt][k], wc[nt], accC[mt][nt], 0, 0, 0);
#pragma unroll
                for (int nt = 0; nt < 3; ++nt) wc[nt] = wn[nt]; } }
            { LAS unsigned char* dCT = L + M2_CT + ((j + 1) & 1) * M2_CTB;
#pragma unroll
              for (int mt = 0; mt < 4; ++mt)
#pragma unroll
                for (int nt = 0; nt < 3; ++nt) { u32x2 o; o.x = pk2(accC[mt][nt][0], accC[mt][nt][1]); o.y = pk2(accC[mt][nt][2], accC[mt][nt][3]);
                    *(LAS u32x2*)(dCT + (16 * nt + fr) * 544 + (64 * wa + 16 * mt + 4 * fq) * 2) = o; } }
            M2_VSTAGE(j + 1, vna, vnb);
            M2_TABLES(j + 2, sn2, tn2);
            vna = vxa; vnb = vxb; tn2 = tn3;
            __syncthreads();
          }
        }
    }
    __syncthreads();
#undef M2_LDQ
#undef M2_LDP
#undef M2_LDK
#undef M2_TABLES
#undef M2_VSTAGE
}

#define XB_TMO      128
#define XB_XCNT(j)  (256  + 64 * (j))
#define XB_XSUB(j)  (1280 + 64 * (j))
#define XB_XGEN(j)  (2304 + 64 * (j))
#define XB_TOP      3328
#define XB_TOPGEN   3392
#define XB_SPIN_CAP (1u << 22)
__device__ __forceinline__ unsigned xb_ld(unsigned* p)              { return __hip_atomic_load(p, __ATOMIC_RELAXED, __HIP_MEMORY_SCOPE_AGENT); }
__device__ __forceinline__ unsigned xb_add(unsigned* p, unsigned v) { return __hip_atomic_fetch_add(p, v, __ATOMIC_RELAXED, __HIP_MEMORY_SCOPE_AGENT); }
__device__ __forceinline__ unsigned xb_xcc_id() { return (unsigned)__builtin_amdgcn_s_getreg((3 << 11) | 20) & 0xFu; }
#define XB_SPIN(cond, bar) do { unsigned _sp = 0; while (cond) { __builtin_amdgcn_s_sleep(1); \
    if ((++_sp & 255u) == 0u) { if (xb_ld(&(bar)[XB_TMO])) break; if (_sp > XB_SPIN_CAP) { atomicAdd(&(bar)[XB_TMO], 1u); break; } } } } while (0)
struct XcdBarrier { unsigned* bar; unsigned x; volatile LAS unsigned* st; };
__device__ __forceinline__ XcdBarrier xcd_barrier_post(unsigned* bar, volatile LAS unsigned* st) {
    XcdBarrier b; b.bar = bar; b.x = xb_xcc_id(); b.st = st;
    if (threadIdx.x == 0) (void)xb_add(&bar[XB_XCNT(b.x)], 1u);
    return b;
}
__device__ __forceinline__ void xcd_barrier_complete(unsigned* bar, unsigned x, unsigned& nloc, unsigned& nx) {
    const unsigned G = gridDim.x * gridDim.y * gridDim.z;
    unsigned sum, cnt, mine, sp = 0u;
    for (;;) {
        sum = 0u; cnt = 0u; mine = 0u;
#pragma unroll
        for (unsigned j = 0; j < 16; ++j) { const unsigned c = xb_ld(&bar[XB_XCNT(j)]); sum += c; cnt += (c > 0u) ? 1u : 0u; mine = (j == x) ? c : mine; }
        if (sum == G) break;
        __builtin_amdgcn_s_sleep(1);
        if ((++sp & 255u) == 0u) { if (xb_ld(&bar[XB_TMO])) break; if (sp > XB_SPIN_CAP) { atomicAdd(&bar[XB_TMO], 1u); break; } }
    }
    nloc = mine > 0u ? mine : 1u; nx = cnt > 0u ? cnt : 1u;
}
__device__ __forceinline__ void xcd_barrier(const XcdBarrier& b) {
    asm volatile("s_waitcnt vmcnt(0)" ::: "memory");
    __syncthreads();
    if (threadIdx.x == 0) {
        unsigned* bar = b.bar;
        __builtin_amdgcn_s_waitcnt(0);
        unsigned nloc = b.st[0], nx = b.st[1];
        if (nloc == 0u) { xcd_barrier_complete(bar, b.x, nloc, nx); b.st[0] = nloc; b.st[1] = nx; }
        const unsigned old = xb_add(&bar[XB_XSUB(b.x)], 1u);
        const unsigned gen = old / nloc;
        if (old + 1u == (gen + 1u) * nloc) {
            __builtin_amdgcn_fence(__ATOMIC_RELEASE, "agent");
            asm volatile("s_waitcnt vmcnt(0)" ::: "memory");
            const unsigned og = xb_add(&bar[XB_TOP], 1u);
            const unsigned tg = og / nx;
            if (og + 1u == (tg + 1u) * nx) xb_add(&bar[XB_TOPGEN], 1u);
            else XB_SPIN(xb_ld(&bar[XB_TOPGEN]) == tg, bar);
            __builtin_amdgcn_fence(__ATOMIC_ACQUIRE, "agent");
            xb_add(&bar[XB_XGEN(b.x)], 1u);
            asm volatile("s_waitcnt vmcnt(0)" ::: "memory");
        } else {
            XB_SPIN(xb_ld(&bar[XB_XGEN(b.x)]) == gen, bar);
            __builtin_amdgcn_fence(__ATOMIC_ACQUIRE, "agent");
            asm volatile("s_waitcnt vmcnt(0)" ::: "memory");
        }
    }
    __syncthreads();
}

__device__ __forceinline__ pg8::Seg mkseg(const void* A0, const void* B0, int nM, int nN, int kind, int ksplit = 1) { pg8::Seg s; s.A0 = (const char*)A0; s.B0 = (const char*)B0; s.nM = nM; s.nN = nN; s.kind = kind; s.ksplit = ksplit; return s; }
__device__ __forceinline__ pg8::Sched mksched(int K) { pg8::Sched S; S.s[0] = S.s[1] = S.s[2] = S.s[3] = mkseg(nullptr, nullptr, 0, 0, 0); S.G = gridDim.x; S.c = blockIdx.x; S.tstep = (size_t)256 * K * 2; S.ntk = K / 64; return S; }

__global__ void __launch_bounds__(NTHR) mega_fwd(Params p) {
    extern __shared__ __attribute__((aligned(16))) unsigned char lds_raw[];
    Frame F;
#define REFRAME() do { int t_ = threadIdx.x; asm volatile("" : "+v"(t_)); F.lds = (LAS unsigned char*)lds_raw; F.tid = t_; F.lane = t_ & 63; F.wave = __builtin_amdgcn_readfirstlane(t_ >> 6); \
        F.gw = blockIdx.x * NWAVE + F.wave; F.ngw = gridDim.x * NWAVE; } while (0)
    REFRAME();
    unsigned char* ws = p.ws; unsigned char* dout = (unsigned char*)p.out;
    volatile LAS unsigned* bst = (volatile LAS unsigned*)(F.lds + LDS_BYTES - 16);
    if (F.tid < 4) bst[F.tid] = 0u;
    __syncthreads();
    const XcdBarrier gbar = xcd_barrier_post((unsigned*)(ws + WS_BAR), bst);
#define GSYNC() do { xcd_barrier(gbar); REFRAME(); } while (0)

    ada_phase(F, p);
    wfour_phase(F, p);
    {
        constexpr int I13 = 16 * 176, I2 = 44 * 32, IIN = 16 * (WIN_ROWS / 32), ISQ = 16 * 32;
        Frame F2 = F; const bool extra = gridDim.x == 256 && blockIdx.x >= 144; F2.gw = (blockIdx.x - 144) * NWAVE + F.wave; F2.ngw = 112 * NWAVE;
#define CONV_SPLIT(CALL_A, CALL_B) do { CALL_A; if (gridDim.x != 256) { Frame F2 = F; CALL_B; } else if (extra) { CALL_B; } } while (0)
        { constexpr int A = I13 * 55 / 100; CONV_SPLIT(conv_w13(F, p.w13_a, (bf16*)(ws + WS_W13), 0, A), conv_w13(F2, p.w13_a, (bf16*)(ws + WS_W13), A, I13 - A)); }
        { constexpr int A = I2 * 55 / 100; CONV_SPLIT(conv_plain(F, p.w2_a, FF, D, (bf16*)(ws + WS_W2), 0, A), conv_plain(F2, p.w2_a, FF, D, (bf16*)(ws + WS_W2), A, I2 - A)); }
        { constexpr int A = IIN * 55 / 100; CONV_SPLIT(conv_win(F, p.w_in, (bf16*)(ws + WS_WIN), 0, A), conv_win(F2, p.w_in, (bf16*)(ws + WS_WIN), A, IIN - A)); }
        { constexpr int A = ISQ * 55 / 100; CONV_SPLIT(conv_plain(F, p.w_mproj, D, D, (bf16*)(ws + WS_WMPROJ), 0, A), conv_plain(F2, p.w_mproj, D, D, (bf16*)(ws + WS_WMPROJ), A, ISQ - A));
          CONV_SPLIT(conv_plain(F, p.w_out, D, D, (bf16*)(ws + WS_WOUT), 0, A), conv_plain(F2, p.w_out, D, D, (bf16*)(ws + WS_WOUT), A, ISQ - A)); }
#undef CONV_SPLIT
        { LAS float* scr = (LAS float*)(F.lds + F.wave * 16384);
          for (int it = F.gw; it < 16; it += F.ngw) transpose_item(p.w_in, D, INW, (bf16*)(ws + WS_WG), 0, COL_GATES, 64 * it, scr, F.lane);
          u32x4* z = (u32x4*)(ws + WS_WG + 32 * D * 2); for (int i = blockIdx.x * NTHR + F.tid; i < 224 * D * 2 / 16; i += gridDim.x * NTHR) z[i] = (u32x4){0u, 0u, 0u, 0u}; }
    }
    GSYNC();
    phase_u1(F, p);
    GSYNC();
    { pg8::Sched S = mksched(D); S.s[0] = mkseg(ws + WS_U, ws + WS_W13, MTOK / 256, 22, 0); EpiSwiglu E{(bf16*)(ws + WS_ACT)}; pg8::gemm_phase(F.lds, D, S, E); }
    GSYNC();
    { pg8::Sched S = mksched(FF); S.s[0] = mkseg(ws + WS_ACT, ws + WS_W2, TLAT / 256, 4, 0); S.s[1] = mkseg(ws + WS_ACT + (size_t)TLAT * FF * 2, ws + WS_W2, TCTX / 256, 4, 1, 8);
      EpiDownA E{(bf16*)(ws + WS_Y1), (float*)(ws + WS_Y1C)}; pg8::gemm_phase(F.lds, FF, S, E); }
    GSYNC();
    phase_post_ffn_a(F, p);
    GSYNC();
    { pg8::Sched S = mksched(D); const unsigned char* W = ws + WS_WIN;
      S.s[0] = mkseg(ws + WS_U2, W + (size_t)ROW_Q * D * 2, MTOK / 256, 8, 0);
      S.s[1] = mkseg(W + (size_t)ROW_V * D * 2, ws + WS_U2, 4, MTOK / 256, 2);
      S.s[2] = mkseg(W + (size_t)ROW_F * D * 2, ws + WS_U2, 2, TLAT / 256, 3);
      S.s[3] = mkseg(ws + WS_U2, ws + WS_WG, MTOK / 256, 1, 4);
      EpiProjA E{(bf16*)(ws + WS_QPRE), (bf16*)(ws + WS_KPRE), (bf16*)(ws + WS_VT), (bf16*)(ws + WS_XFT), p.b_in, (float*)(ws + WS_GATES)}; pg8::gemm_phase(F.lds, D, S, E); }
    GSYNC();
    for (int it = blockIdx.x; it < 16 * NCHK; it += gridDim.x) { if (it < 512) m1_item(F, p, it & 15, 2 + (it >> 4)); else m1_item(F, p, (it - 512) & 15, (it - 512) >> 4); }
    GSYNC();
    for (int sid = blockIdx.x; sid < 256; sid += gridDim.x) m2_stream(F, p, sid);
    GSYNC();
    for (int it = blockIdx.x; it < 256; it += gridDim.x) fourier_item(F, p, it);
    { constexpr int I13 = 16 * 176, I2 = 44 * 32; conv_w13(F, p.w13_b, (bf16*)(ws + WS_W13B), 0, I13); conv_plain(F, p.w2_b, FF, D, (bf16*)(ws + WS_W2B), 0, I2); }
    GSYNC();
    { pg8::Sched S = mksched(D); const pg8::Seg so = mkseg(ws + WS_U2, ws + WS_WIN + (size_t)ROW_O * D * 2, TLAT / 256, 4, 0), sf = mkseg(ws + WS_UF, ws + WS_WFOUR, TLAT / 256, 4, 1);
      const bool swp = gridDim.x == 256 && ((blockIdx.x >> 3) & 1);
      S.s[0] = swp ? sf : so; S.s[1] = swp ? so : sf;
      EpiX E{(bf16*)(ws + WS_HM), (bf16*)(dout + DO_TF), (const bf16*)(ws + WS_HF), (const bf16*)(ws + WS_HB), p.b_in, p.head_g, (LAS float*)(F.lds + pg8::STAGE_BYTES)}; pg8::gemm_phase(F.lds, D, S, E); }
    GSYNC();
    if (gridDim.x == 256) {
      pg8::SchedY S; S.base = mksched(D); S.base.s[0] = mkseg(ws + WS_HM, ws + WS_WMPROJ, TLAT / 256, 4, 1); S.Ag = (const char*)(ws + WS_U2); S.Bg = (const char*)(ws + WS_WIN + (size_t)ROW_GF * D * 2);
      EpiY E{(bf16*)(dout + DO_TF), (bf16*)(ws + WS_TM), p.b_in}; pg8::gemm_phase(F.lds, D, S, E);
    } else {
      { pg8::Sched S = mksched(D); S.s[0] = mkseg(ws + WS_HM, ws + WS_WMPROJ, TLAT / 256, 4, 1); EpiY E{(bf16*)(dout + DO_TF), (bf16*)(ws + WS_TM), p.b_in}; pg8::gemm_phase(F.lds, D, S, E); }
      GSYNC();
      { pg8::Sched S = mksched(D); S.s[0] = mkseg(ws + WS_U2, ws + WS_WIN + (size_t)ROW_GF * D * 2, TLAT / 256, 8, 0); EpiY E{(bf16*)(dout + DO_TF), (bf16*)(ws + WS_TM), p.b_in}; pg8::gemm_phase(F.lds, D, S, E); }
    }
    GSYNC();
    { pg8::Sched S = mksched(D); S.s[0] = mkseg(ws + WS_TM, ws + WS_WOUT, TLAT / 256, 4, 0);
      float* xb = (float*)(ws + WS_XCH); unsigned* xc = (unsigned*)(ws + WS_XCNT);
      EpiMix E{p.x, p.norm_g + 3 * D, p.norm_g + 4 * D, (const float*)(ws + WS_MOD), (const bf16*)(dout + DO_D1), (bf16*)(ws + WS_D12), (bf16*)(dout + DO_U3),
               PanelRms{xb, xc}, PanelRms{xb + 65536, xc + 64 * 64}, (LAS float*)(F.lds + pg8::STAGE_BYTES)};
      if (gridDim.x == 256) pg8::gemm_phase(F.lds, D, S, E); }
    GSYNC();
    { pg8::Sched S = mksched(D); S.s[0] = mkseg(dout + DO_U3, ws + WS_W13B, TLAT / 256, 22, 0); EpiSwiglu E{(bf16*)(ws + WS_ACT2)}; pg8::gemm_phase(F.lds, D, S, E); }
    GSYNC();
    { pg8::Sched S = mksched(FF); S.s[0] = mkseg(ws + WS_ACT2, ws + WS_W2B, TLAT / 256, 4, 0);
      EpiFinal E{p.x, p.norm_g + 5 * D, (const float*)(ws + WS_MOD), (const bf16*)(ws + WS_D12), p.out, PanelRms{(float*)(ws + WS_XCH) + 2 * 65536, (unsigned*)(ws + WS_XCNT) + 2 * 64 * 64}, (LAS float*)(F.lds + pg8::STAGE_BYTES)};
      if (gridDim.x == 256) pg8::gemm_phase(F.lds, FF, S, E); }
}

extern "C" void kernel_launch(void* const* d_in, const int* in_sizes, int n_in, void* d_out, int out_size, void* d_ws, size_t ws_size, hipStream_t stream) {
    static int grid = 0;
    if (grid == 0) {
        if (n_in != 19 || out_size != TLAT * D || ws_size < WS_NEED) { fprintf(stderr, "kernel_launch: unexpected problem (n_in %d, out %d, ws %zu)\n", n_in, out_size, ws_size); grid = -1; return; }
        int dev = 0, cus = 0, per_cu = 0;
        if (hipGetDevice(&dev) != hipSuccess || hipDeviceGetAttribute(&cus, hipDeviceAttributeMultiprocessorCount, dev) != hipSuccess) { grid = -1; return; }
        if (hipFuncSetAttribute((const void*)mega_fwd, hipFuncAttributeMaxDynamicSharedMemorySize, LDS_BYTES) != hipSuccess) { fprintf(stderr, "kernel_launch: hipFuncSetAttribute failed\n"); grid = -1; return; }
        if (hipOccupancyMaxActiveBlocksPerMultiprocessor(&per_cu, (const void*)mega_fwd, NTHR, LDS_BYTES) != hipSuccess || per_cu < 1) { fprintf(stderr, "kernel_launch: occupancy query failed (%d)\n", per_cu); (void)hipGetLastError(); grid = -1; return; }
        grid = cus * 1;
        if (grid != 256) fprintf(stderr, "kernel_launch: built for a 256-CU device (fused norm epilogues need one 256x256 unit per workgroup); got %d\n", grid);
        fprintf(stderr, "kernel_launch: %d CUs, %d blocks/CU by the occupancy query, grid %d\n", cus, per_cu, grid);
    }
    if (grid < 0) return;
    Params p{};
    const float** f = (const float**)&p;
    for (int i = 0; i < 19; ++i) f[i] = (const float*)d_in[i];
    p.out = (float*)d_out; p.ws = (unsigned char*)d_ws;
    (void)hipMemsetAsync((char*)d_ws + WS_BAR, 0, 64 * 1024, stream);
    void* args[] = {&p};
    hipError_t e = hipLaunchCooperativeKernel((const void*)mega_fwd, dim3(grid), dim3(NTHR), args, LDS_BYTES, stream);
    if (e != hipSuccess) fprintf(stderr, "kernel_launch: cooperative launch failed: %s (grid %d)\n", hipGetErrorString(e), grid);
}
```

```cpp
#include <hip/hip_runtime.h>
#include <hip/hip_cooperative_groups.h>
#include <cstdio>
#include <cstdint>
namespace cg = cooperative_groups;

#define LAS __attribute__((address_space(3)))
typedef unsigned short bf16;
typedef short bf16x8 __attribute__((ext_vector_type(8)));
typedef float f32x4 __attribute__((ext_vector_type(4)));
typedef float f32x2 __attribute__((ext_vector_type(2)));
typedef unsigned u32x4 __attribute__((ext_vector_type(4)));
typedef unsigned u32x2 __attribute__((ext_vector_type(2)));

constexpr int D = 1024, NB = 4, SEQ = 4096, CTXL = 256, FF = 2816, NH = 4, DH = 256, CH = 128;
constexpr int TLAT = NB * SEQ;
constexpr int TCTX = NB * CTXL;
constexpr int MTOK = TLAT + TCTX;
constexpr int INW = 6672;
constexpr int PLEN = CTXL + SEQ;
constexpr int NCHK = PLEN / CH;
constexpr float EPS = 1e-6f;
constexpr int NTHR = 512, NWAVE = 8;
constexpr int LDS_BYTES = 147456;

constexpr size_t MiB = 1u << 20;
constexpr size_t WS_MOD = 0;
constexpr size_t WS_BAR = 256 * 1024;
constexpr size_t WS_GATES = 512 * 1024;
constexpr size_t WS_TOKSC = 2 * MiB;
constexpr size_t WS_CHSC = 5 * MiB;
constexpr size_t WS_WG = 7 * MiB;
constexpr size_t WS_XCH = 6 * MiB;
constexpr size_t WS_XCNT = WS_BAR + 16 * 1024;
constexpr size_t WS_W13 = 8 * MiB, WS_W2 = 19 * MiB, WS_WIN = 25 * MiB, WS_WFOUR = 38 * MiB, WS_WMPROJ = 40 * MiB, WS_WOUT = 42 * MiB;
constexpr size_t WS_XFT = 8 * MiB;
constexpr size_t WS_U = 44 * MiB;
constexpr size_t WS_U2 = 210 * MiB;
constexpr size_t WS_ACT = 78 * MiB;
constexpr size_t WS_Y1 = 172 * MiB;
constexpr size_t WS_Y1C = 44 * MiB;
constexpr size_t WS_QPRE = 78 * MiB;
constexpr size_t WS_KPRE = 110 * MiB;
constexpr size_t WS_VT = 144 * MiB;
constexpr size_t WS_Q = 178 * MiB;
constexpr size_t WS_UF = 142 * MiB;
constexpr size_t WS_KT = 44 * MiB;
constexpr size_t WS_HF = 78 * MiB, WS_HB = 110 * MiB;
constexpr size_t WS_HM = 174 * MiB;
constexpr size_t DO_TF = 32 * MiB;
constexpr size_t WS_W13B = 44 * MiB, WS_W2B = 55 * MiB;
constexpr size_t WS_TM = 78 * MiB;
constexpr size_t WS_OUTL = 110 * MiB;
constexpr size_t WS_D12 = 110 * MiB;
constexpr size_t WS_ACT2 = 142 * MiB;
constexpr size_t WS_Y3 = 164 * MiB;
constexpr size_t WS_NEED = 256 * MiB;
constexpr size_t DO_D1 = 0, DO_P = 32 * MiB, DO_U3 = 32 * MiB;

constexpr int COL_F = 0, COL_Q = 512, COL_K = 1536, COL_V = 2560, COL_O = 3584, COL_GATES = 4608, COL_GF = 4624, COL_GM = 5648;
constexpr int ROW_Q = 0, ROW_K = 1024, ROW_V = 2048, ROW_F = 3072, ROW_O = 3584, ROW_GF = 4608, ROW_GM = 5632, WIN_ROWS = 6656;

struct Params {
    const float *x, *c, *ctx, *c_ctx, *w_ada, *b_ada, *norm_g, *w13_a, *w2_a, *w_in, *b_in, *conv_w, *conv_b, *head_g, *w_four, *w_mproj, *w_out, *w13_b, *w2_b;
    float* out; unsigned char* ws;
};

typedef __bf16 bf16x2_t __attribute__((ext_vector_type(2)));
__device__ __forceinline__ unsigned f2bf(float f) { return (unsigned)__builtin_bit_cast(unsigned short, (__bf16)f); }
__device__ __forceinline__ unsigned pk2(float lo, float hi) { bf16x2_t v; v[0] = (__bf16)lo; v[1] = (__bf16)hi; return __builtin_bit_cast(unsigned, v); }
__device__ __forceinline__ float bf2f(unsigned b) { return __builtin_bit_cast(float, b << 16); }
__device__ __forceinline__ float bflo(unsigned w) { return __builtin_bit_cast(float, w << 16); }
__device__ __forceinline__ float bfhi(unsigned w) { return __builtin_bit_cast(float, w & 0xffff0000u); }
__device__ __forceinline__ unsigned cvt_pk_bf16(float lo, float hi) { return pk2(lo, hi); }
#define DPP_F(v, ctrl) __builtin_bit_cast(float, __builtin_amdgcn_update_dpp(0, __builtin_bit_cast(int, (v)), (ctrl), 0xf, 0xf, false))
__device__ __forceinline__ float row16_sum(float v) {
    v += DPP_F(v, 0xB1);
    v += DPP_F(v, 0x4E);
    v += DPP_F(v, 0x141);
    v += DPP_F(v, 0x140);
    return v;
}
__device__ __forceinline__ float rlane(float v, int l) { return __builtin_bit_cast(float, __builtin_amdgcn_readlane(__builtin_bit_cast(int, v), l)); }
__device__ __forceinline__ float wave_sum(float v) { v = row16_sum(v); return (rlane(v, 0) + rlane(v, 16)) + (rlane(v, 32) + rlane(v, 48)); }
__device__ __forceinline__ float sigmoidf_(float x) { return __builtin_amdgcn_rcpf(1.0f + __expf(-x)); }
__device__ __forceinline__ float siluf_(float x) { return x * __builtin_amdgcn_rcpf(1.0f + __expf(-x)); }
#define LDS_WAIT() asm volatile("s_waitcnt lgkmcnt(0)" ::: "memory")
#define VM_WAIT() asm volatile("s_waitcnt vmcnt(0)" ::: "memory")

namespace pg8 {
constexpr int BM = 256, BK = 64, HALF = 128, HTB = HALF * BK * 2, STAGE_BYTES = 8 * HTB, NXCD = 8, WGM = 8;
__host__ __device__ __forceinline__ int lds_byte(int r, int c) { const int st = (r >> 4) * 2 + (c >> 5), rr = r & 15, cc = c & 31, ob = rr * 64 + cc * 2; return st * 1024 + (ob ^ (((ob >> 9) & 1) << 5)); }
__host__ __device__ __forceinline__ void stage_rc(int b, int& R, int& C) { const int st = b / 1024, sb = b % 1024, swz = sb ^ (((sb >> 9) & 1) << 5); R = (st >> 1) * 16 + swz / 64; C = (st & 1) * 32 + (swz % 64) / 2; }
__host__ __device__ __forceinline__ int perm32(int rho) { const int n = rho >> 4, i = rho & 15; return 8 * (i >> 2) + 4 * n + (i & 3); }

struct Unit { const char* A; const char* B; int kind, pm, pn, nt, kq; };
struct Seg { const char* A0; const char* B0; int nM, nN, kind, ksplit; };
struct Sched {
    Seg s[4]; int G, c; size_t tstep;
    int ntk;
    __device__ __forceinline__ bool pick(const Seg& sg, long& L, Unit& u) const {
        const int nwg = sg.nM * sg.nN * sg.ksplit;
        if (L >= nwg) { L -= nwg; return false; }
        if (sg.ksplit > 1) { const int tiles = sg.nM * sg.nN, kq = (int)L / tiles, tl = (int)L % tiles; u.pm = tl % sg.nM; u.pn = tl / sg.nM; u.kind = sg.kind;
            const int kt0 = kq * 6 - (kq > 6 ? 2 : 0); u.nt = kq < 6 ? 6 : 4; u.kq = kq;
            u.A = sg.A0 + (size_t)u.pm * tstep + kt0 * 128; u.B = sg.B0 + (size_t)u.pn * tstep + kt0 * 128; return true; }
        u.nt = ntk; u.kq = 0;
        int wgid = (int)L; { const int q = nwg / NXCD, r = nwg % NXCD, xcd = wgid % NXCD, off = wgid / NXCD; wgid = (xcd < r ? xcd * (q + 1) : r * (q + 1) + (xcd - r) * q) + off; }
        const int nig = WGM * sg.nN, gid = wgid / nig, fm = gid * WGM, gsz = (sg.nM - fm) < WGM ? (sg.nM - fm) : WGM;
        u.pm = fm + ((wgid % nig) % gsz); u.pn = (wgid % nig) / gsz; u.kind = sg.kind;
        u.A = sg.A0 + (size_t)u.pm * tstep; u.B = sg.B0 + (size_t)u.pn * tstep; return true;
    }
    __device__ __forceinline__ bool next(int i, Unit& u) const {
        long L = (long)i * G + c;
        if (pick(s[0], L, u)) return true;
        if (pick(s[1], L, u)) return true;
        if (pick(s[2], L, u)) return true;
        if (pick(s[3], L, u)) return true;
        return false;
    }
};

struct SchedY {
    Sched base; const char* Ag; const char* Bg;
    __device__ __forceinline__ bool next(int i, Unit& u) const {
        if (i > 2) return false;
        long L = base.c; Unit t; base.pick(base.s[0], L, t);
        if (i == 0) { u = t; return true; }
        u.kind = 0; u.pm = t.pm; u.pn = 2 * t.pn + (i - 1); u.nt = base.ntk; u.kq = 0;
        u.A = Ag + (size_t)u.pm * base.tstep; u.B = Bg + (size_t)u.pn * base.tstep; return true;
    }
};
template <class Epi, class SchedT>
__device__ __forceinline__ void gemm_phase(LAS unsigned char* lds, const int K, const SchedT& S, const Epi& E) {
    int tid_ = threadIdx.x; asm volatile("" : "+v"(tid_));
    const int tid = tid_, wid = __builtin_amdgcn_readfirstlane(tid >> 6), lane = tid & 63, wr = wid >> 2, wc = wid & 3, fr = lane & 15, fq = lane >> 4;
    unsigned voffA[2], voffB[2];
#pragma unroll
    for (int i = 0; i < 2; ++i) { int R, C; stage_rc(tid * 16 + i * 8192, R, C); const int Rb = (R & ~31) + perm32(R & 31);
        voffA[i] = (unsigned)(R * K + C) * 2u; voffB[i] = (unsigned)(Rb * K + C) * 2u; }
    const size_t kstep = (size_t)(BK * 2);
    const size_t hstep = (size_t)HALF * K * 2;
    const unsigned ldsw = (unsigned)wid * 1024u;
    const int aoff = lds_byte(wr * 64 + fr, fq * 8), boff = lds_byte(wc * 32 + fr, fq * 8);
#define PG8_SA(b, h) (((b) * 2 + (h)) * HTB)
#define PG8_SB(b, h) ((4 + (b) * 2 + (h)) * HTB)
#define PG8_STAGE(bufoff, gbase, voff) do { _Pragma("unroll") for (int _i = 0; _i < 2; ++_i) \
        __builtin_amdgcn_global_load_lds((const unsigned*)((const char*)(gbase) + (voff)[_i]), (LAS unsigned*)(lds + (bufoff) + ldsw + _i * 8192), 16, 0, 0); } while (0)
#define PG8_LDA(dst, b, h) do { _Pragma("unroll") for (int m = 0; m < 4; ++m) _Pragma("unroll") for (int k = 0; k < 2; ++k) dst[m][k] = *(const LAS bf16x8*)(lds + PG8_SA(b, h) + aoff + m * 2048 + k * 1024); } while (0)
#define PG8_LDB(dst, b, h) do { _Pragma("unroll") for (int n = 0; n < 2; ++n) _Pragma("unroll") for (int k = 0; k < 2; ++k) dst[n][k] = *(const LAS bf16x8*)(lds + PG8_SB(b, h) + boff + n * 2048 + k * 1024); } while (0)
#define PG8_MMA(ai, bj, At, Bt) do { __builtin_amdgcn_s_setprio(1); _Pragma("unroll") for (int m = 0; m < 4; ++m) _Pragma("unroll") for (int n = 0; n < 2; ++n) _Pragma("unroll") for (int k = 0; k < 2; ++k) \
        acc[ai][bj][m][n] = __builtin_amdgcn_mfma_f32_16x16x32_bf16(Bt[n][k], At[m][k], acc[ai][bj][m][n], 0, 0, 0); __builtin_amdgcn_s_setprio(0); } while (0)
#define PG8_WAIT_V(n) asm volatile("s_waitcnt vmcnt(" #n ")" ::: "memory")
#define PG8_WAIT_L(n) asm volatile("s_waitcnt lgkmcnt(" #n ")" ::: "memory")
#define PG8_BAR __builtin_amdgcn_s_barrier()
#define PG8_SCHED __builtin_amdgcn_sched_barrier(0)
    Unit cur, nxt; int ui = 0;
    if (!S.next(0, cur)) return;
    f32x4 acc[2][2][4][2];
#pragma unroll
    for (int a = 0; a < 2; ++a)
#pragma unroll
        for (int b = 0; b < 2; ++b)
#pragma unroll
            for (int m = 0; m < 4; ++m)
#pragma unroll
                for (int n = 0; n < 2; ++n) acc[a][b][m][n] = (f32x4){0.f, 0.f, 0.f, 0.f};
    bf16x8 At[4][2], B0[2][2], B1[2][2];
    const char* cA = cur.A; const char* cB = cur.B;
    PG8_STAGE(PG8_SB(0, 0), cB, voffB); PG8_STAGE(PG8_SB(0, 1), cB + hstep, voffB); PG8_STAGE(PG8_SA(0, 0), cA, voffA); PG8_STAGE(PG8_SA(0, 1), cA + hstep, voffA);
    if (wr == 1) PG8_BAR;
    PG8_WAIT_V(2); PG8_BAR;
    PG8_STAGE(PG8_SB(1, 0), cB + kstep, voffB); PG8_STAGE(PG8_SA(1, 0), cA + kstep, voffA); PG8_STAGE(PG8_SB(1, 1), cB + hstep + kstep, voffB);
    PG8_WAIT_V(6); PG8_BAR;
    for (;;) {
        const bool has_next = S.next(ui + 1, nxt);
        const char* nA = has_next ? nxt.A : cA; const char* nB = has_next ? nxt.B : cB;
        const int nt = cur.nt;
        for (int t = 0; t < nt; t += 2) {
            const bool last = (t == nt - 2);
            const char* a1 = cA + (size_t)(t + 1) * kstep;
            const char* a2 = last ? nA : cA + (size_t)(t + 2) * kstep; const char* b2 = last ? nB : cB + (size_t)(t + 2) * kstep;
            const char* a3 = a2 + kstep; const char* b3 = b2 + kstep;
            PG8_LDB(B0, 0, 0); PG8_LDB(B1, 0, 1); PG8_SCHED; PG8_LDA(At, 0, 0); PG8_STAGE(PG8_SA(1, 1), a1 + hstep, voffA);
            PG8_WAIT_V(8); PG8_WAIT_L(0); PG8_BAR; PG8_MMA(0, 0, At, B0); PG8_MMA(0, 1, At, B1); PG8_BAR; PG8_SCHED;
            PG8_LDA(At, 0, 1); PG8_STAGE(PG8_SB(0, 0), b2, voffB); PG8_STAGE(PG8_SB(0, 1), b2 + hstep, voffB); PG8_STAGE(PG8_SA(0, 0), a2, voffA);
            PG8_WAIT_V(8); PG8_WAIT_L(0); PG8_BAR; PG8_MMA(1, 0, At, B0); PG8_MMA(1, 1, At, B1); PG8_BAR; PG8_SCHED;
            PG8_LDB(B0, 1, 0); PG8_LDB(B1, 1, 1); PG8_SCHED; PG8_LDA(At, 1, 0); PG8_STAGE(PG8_SA(0, 1), a2 + hstep, voffA);
            PG8_WAIT_V(8); PG8_WAIT_L(0); PG8_BAR; PG8_MMA(0, 0, At, B0); PG8_MMA(0, 1, At, B1); PG8_BAR; PG8_SCHED;
            PG8_LDA(At, 1, 1); PG8_STAGE(PG8_SB(1, 0), b3, voffB); PG8_STAGE(PG8_SB(1, 1), b3 + hstep, voffB); PG8_STAGE(PG8_SA(1, 0), a3, voffA);
            PG8_WAIT_V(8); PG8_WAIT_L(0); PG8_BAR; PG8_MMA(1, 0, At, B0); PG8_MMA(1, 1, At, B1); PG8_BAR; PG8_SCHED;
        }
        if (wr == 0) PG8_BAR;
        { int fr2 = fr, fq2 = fq; asm volatile("" : "+v"(fr2), "+v"(fq2));
          E(acc, cur, wr, wc, fr2, fq2); }
        if (!has_next) break;
#pragma unroll
        for (int a = 0; a < 2; ++a)
#pragma unroll
            for (int b = 0; b < 2; ++b)
#pragma unroll
                for (int m = 0; m < 4; ++m)
#pragma unroll
                    for (int n = 0; n < 2; ++n) acc[a][b][m][n] = (f32x4){0.f, 0.f, 0.f, 0.f};
        cur = nxt; cA = nA; cB = nB; ++ui;
        if (wr == 1) PG8_BAR;
    }
    PG8_WAIT_V(0);
    PG8_BAR;
#undef PG8_SA
#undef PG8_SB
#undef PG8_STAGE
#undef PG8_LDA
#undef PG8_LDB
#undef PG8_MMA
#undef PG8_WAIT_V
#undef PG8_WAIT_L
#undef PG8_BAR
#undef PG8_SCHED
}
}

#define ACC_T const f32x4 (&acc)[2][2][4][2]
template <class T> __device__ __forceinline__ T ldg(const void* base, unsigned boff) { return *(const T*)((const char*)base + boff); }
#ifndef WT_STORES
#define WT_STORES 0
#endif
template <class T> __device__ __forceinline__ void stg(void* base, unsigned boff, const T& v) {
    static_assert(sizeof(T) == 16, "16-byte stores only");
#if WT_STORES
    const __amdgpu_buffer_rsrc_t rs = __builtin_amdgcn_make_buffer_rsrc(base, (short)0, 0x7fffffff, 0x00020000);
    __builtin_amdgcn_raw_buffer_store_b128(__builtin_bit_cast(u32x4, v), rs, boff, 0, 16);
#else
    *(T*)((char*)base + boff) = v;
#endif
}
__device__ __forceinline__ u32x4 pack8(const f32x4& v0, const f32x4& v1) { u32x4 w; w.x = cvt_pk_bf16(v0[0], v0[1]); w.y = cvt_pk_bf16(v0[2], v0[3]); w.z = cvt_pk_bf16(v1[0], v1[1]); w.w = cvt_pk_bf16(v1[2], v1[3]); return w; }
#define ROWGROUPS(ai, m) _Pragma("unroll") for (int ai = 0; ai < 2; ++ai) _Pragma("unroll") for (int m = 0; m < 4; ++m)

struct EpiSwiglu {
    bf16* O;
    __device__ __forceinline__ void operator()(ACC_T, const pg8::Unit& u, int wr, int wc, int fr, int fq) const {
        const unsigned off0 = (unsigned)((u.pm * 256 + wr * 64 + fr) * FF + u.pn * 128 + wc * 32 + 8 * fq) * 2u;
        ROWGROUPS(ai, m) {
            const f32x4 a0 = acc[ai][0][m][0], a1 = acc[ai][0][m][1], b0 = acc[ai][1][m][0], b1 = acc[ai][1][m][1];
            f32x4 h0, h1;
#pragma unroll
            for (int j = 0; j < 4; ++j) { h0[j] = a0[j] * b0[j] * __builtin_amdgcn_rcpf(1.0f + __builtin_amdgcn_exp2f(-a0[j])); h1[j] = a1[j] * b1[j] * __builtin_amdgcn_rcpf(1.0f + __builtin_amdgcn_exp2f(-a1[j])); }
            stg(O, off0 + (unsigned)((ai * 128 + m * 16) * FF * 2), pack8(h0, h1));
        }
    }
};

struct EpiProjA {
    bf16 *Oq, *Ok, *Ovt, *Oxt; const float* b_in; float* G;
    __device__ __forceinline__ void operator()(ACC_T, const pg8::Unit& u, int wr, int wc, int fr, int fq) const {
        const int row0 = u.pm * 256 + wr * 64 + fr, col0 = u.pn * 256 + wc * 32 + 8 * fq;
        if (u.kind == 4) {
            if (wc == 0 && fq < 2) { const f32x4 b0 = ldg<f32x4>(b_in, (unsigned)(COL_GATES + 8 * fq) * 4u), b1 = ldg<f32x4>(b_in, (unsigned)(COL_GATES + 8 * fq + 4) * 4u);
                const unsigned g0 = (unsigned)(row0 * 16 + 8 * fq) * 4u;
                ROWGROUPS(ai, m) { stg(G, g0 + (unsigned)((ai * 128 + m * 16) * 64), acc[ai][0][m][0] + b0); stg(G, g0 + (unsigned)((ai * 128 + m * 16) * 64) + 16, acc[ai][0][m][1] + b1); } }
            return; }
        if (u.kind == 0) {
            const bool isk = u.pn >= 4; if (!isk && u.pm >= TLAT / 256) return;
            bf16* O = isk ? Ok : Oq; const int colq = col0 - (isk ? 1024 : 0); const unsigned boff = (unsigned)((isk ? COL_K : COL_Q) + colq) * 4u;
            const unsigned off0 = (unsigned)(row0 * D + colq) * 2u;
#pragma unroll
            for (int bj = 0; bj < 2; ++bj) {
                const f32x4 bv0 = ldg<f32x4>(b_in, boff + bj * 512), bv1 = ldg<f32x4>(b_in, boff + bj * 512 + 16);
                ROWGROUPS(ai, m) stg(O, off0 + (unsigned)((ai * 128 + m * 16) * D * 2) + bj * 256, pack8(acc[ai][bj][m][0] + bv0, acc[ai][bj][m][1] + bv1));
            }
        } else {
            bf16* O = u.kind == 2 ? Ovt : Oxt; const int ldc = u.kind == 2 ? MTOK : TLAT; const unsigned boff = (unsigned)((u.kind == 2 ? COL_V : COL_F) + row0) * 4u;
            const unsigned off0 = (unsigned)(row0 * ldc + col0) * 2u;
            ROWGROUPS(ai, m) { const float bb = ldg<float>(b_in, boff + (unsigned)((ai * 128 + m * 16) * 4)); const unsigned o = off0 + (unsigned)((ai * 128 + m * 16) * ldc * 2);
#pragma unroll
                for (int bj = 0; bj < 2; ++bj) stg(O, o + bj * 256, pack8(acc[ai][bj][m][0] + bb, acc[ai][bj][m][1] + bb)); }
        }
    }
};
__device__ __forceinline__ void store_bf16_tile(bf16* O, ACC_T, const pg8::Unit& u, int wr, int wc, int fr, int fq) {
    const unsigned off0 = (unsigned)((u.pm * 256 + wr * 64 + fr) * D + u.pn * 256 + wc * 32 + 8 * fq) * 2u;
    ROWGROUPS(ai, m) { const unsigned o = off0 + (unsigned)((ai * 128 + m * 16) * D * 2);
#pragma unroll
        for (int bj = 0; bj < 2; ++bj) stg(O, o + bj * 256, pack8(acc[ai][bj][m][0], acc[ai][bj][m][1])); }
}
struct EpiBf16 { bf16* O; __device__ __forceinline__ void operator()(ACC_T, const pg8::Unit& u, int wr, int wc, int fr, int fq) const { store_bf16_tile(O, acc, u, wr, wc, fr, fq); } };
struct EpiDownA { bf16* Y1; float* Y1C;
    __device__ __forceinline__ void operator()(ACC_T, const pg8::Unit& u, int wr, int wc, int fr, int fq) const {
        if (u.kind == 0) { store_bf16_tile(Y1, acc, u, wr, wc, fr, fq); return; }
        const unsigned off0 = (unsigned)(((u.kq * TCTX + u.pm * 256 + wr * 64 + fr) * D) + u.pn * 256 + wc * 32 + 8 * fq) * 4u;
        ROWGROUPS(ai, m) { const unsigned o = off0 + (unsigned)((ai * 128 + m * 16) * D * 4);
#pragma unroll
            for (int bj = 0; bj < 2; ++bj) { stg(Y1C, o + bj * 512, acc[ai][bj][m][0]); stg(Y1C, o + bj * 512 + 16, acc[ai][bj][m][1]); } }
    }
};
struct EpiX {
    bf16 *HM, *TF; const bf16 *HF, *HB; const float *b_in, *head_g; LAS float* red;
    __device__ __forceinline__ void operator()(ACC_T, const pg8::Unit& u, int wr, int wc, int fr, int fq) const {
        if (u.kind == 1) { store_bf16_tile(TF, acc, u, wr, wc, fr, fq); return; }
        const int col0 = u.pn * 256 + wc * 32 + 8 * fq, rt0 = wr * 64 + fr;
        const unsigned off0 = (unsigned)((u.pm * 256 + rt0) * D + col0) * 2u;
#pragma unroll
        for (int am = 0; am < 4; ++am) { const int ai = am >> 1, mb = (am & 1) * 2;
            u32x4 hp[4][2];
#pragma unroll
            for (int m = mb; m < mb + 2; ++m) { const unsigned o = off0 + (unsigned)((ai * 128 + m * 16) * D * 2); float s = 0.f;
#pragma unroll
                for (int bj = 0; bj < 2; ++bj) { const u32x4 a = ldg<u32x4>(HF, o + bj * 256), b = ldg<u32x4>(HB, o + bj * 256); u32x4 hq;
#pragma unroll
                    for (int q = 0; q < 4; ++q) { const float h0 = bflo(a[q]) + bflo(b[q]), h1 = bfhi(a[q]) + bfhi(b[q]); hq[q] = pk2(h0, h1); const float g0 = bflo(hq[q]), g1 = bfhi(hq[q]); s += g0 * g0 + g1 * g1; }
                    hp[m][bj] = hq; }
                s += __shfl_xor(s, 16); s += __shfl_xor(s, 32);
                if (fq == 0) red[(ai * 128 + m * 16 + rt0) * 4 + wc] = s; }
            LDS_WAIT(); __builtin_amdgcn_s_barrier(); asm volatile("" ::: "memory");
#pragma unroll
            for (int bj = 0; bj < 2; ++bj) {
                const unsigned cb = (unsigned)(col0 + bj * 128) * 4u;
                const f32x4 bo0 = ldg<f32x4>(b_in, COL_O * 4 + cb), bo1 = ldg<f32x4>(b_in, COL_O * 4 + cb + 16), hg0 = ldg<f32x4>(head_g, cb), hg1 = ldg<f32x4>(head_g, cb + 16);
#pragma unroll
                for (int m = mb; m < mb + 2; ++m) { const f32x4 ps = *(const LAS f32x4*)(red + (ai * 128 + m * 16 + rt0) * 4);
                    const float rstd = rsqrtf(((ps[0] + ps[1]) + (ps[2] + ps[3])) * (1.0f / 256.0f) + EPS);
                    const unsigned o = off0 + (unsigned)((ai * 128 + m * 16) * D * 2) + bj * 256;
                    const u32x4 hq = hp[m][bj];
                    const f32x4 v0 = acc[ai][bj][m][0] + bo0, v1 = acc[ai][bj][m][1] + bo1;
                    f32x4 r0, r1;
                    r0[0] = sigmoidf_(v0[0]) * bflo(hq[0]) * rstd * hg0[0]; r0[1] = sigmoidf_(v0[1]) * bfhi(hq[0]) * rstd * hg0[1];
                    r0[2] = sigmoidf_(v0[2]) * bflo(hq[1]) * rstd * hg0[2]; r0[3] = sigmoidf_(v0[3]) * bfhi(hq[1]) * rstd * hg0[3];
                    r1[0] = sigmoidf_(v1[0]) * bflo(hq[2]) * rstd * hg1[0]; r1[1] = sigmoidf_(v1[1]) * bfhi(hq[2]) * rstd * hg1[1];
                    r1[2] = sigmoidf_(v1[2]) * bflo(hq[3]) * rstd * hg1[2]; r1[3] = sigmoidf_(v1[3]) * bfhi(hq[3]) * rstd * hg1[3];
                    stg(HM, o, pack8(r0, r1)); } }
            asm volatile("" ::: "memory");
        }
    }
};
struct EpiY {
    bf16 *TF, *TM; const float* b_in;
    __device__ __forceinline__ void operator()(ACC_T, const pg8::Unit& u, int wr, int wc, int fr, int fq) const {
        if (u.kind == 1) { store_bf16_tile(TM, acc, u, wr, wc, fr, fq); return; }
        const int ch0 = u.pn * 128 + wc * 32 + 8 * fq;
        const unsigned off0 = (unsigned)((u.pm * 256 + wr * 64 + fr) * D + ch0) * 2u;
        const f32x4 bf0 = ldg<f32x4>(b_in, (unsigned)(COL_GF + ch0) * 4u), bf1 = ldg<f32x4>(b_in, (unsigned)(COL_GF + ch0) * 4u + 16);
        const f32x4 bm0 = ldg<f32x4>(b_in, (unsigned)(COL_GM + ch0) * 4u), bm1 = ldg<f32x4>(b_in, (unsigned)(COL_GM + ch0) * 4u + 16);
#pragma unroll
        for (int am = 0; am < 4; ++am) { const int ai = am >> 1, mb = (am & 1) * 2;
            u32x4 tq[4], tmq[4];
#pragma unroll
            for (int m = mb; m < mb + 2; ++m) { const unsigned o = off0 + (unsigned)((ai * 128 + m * 16) * D * 2); tq[m] = ldg<u32x4>(TF, o); tmq[m] = ldg<u32x4>(TM, o); }
#pragma unroll
            for (int m = mb; m < mb + 2; ++m) { const unsigned o = off0 + (unsigned)((ai * 128 + m * 16) * D * 2);
                const u32x4 t = tq[m], tm = tmq[m];
                const f32x4 f0 = acc[ai][0][m][0] + bf0, f1 = acc[ai][0][m][1] + bf1, g0 = acc[ai][1][m][0] + bm0, g1 = acc[ai][1][m][1] + bm1;
                f32x4 r0, r1;
                r0[0] = sigmoidf_(f0[0]) * bflo(t[0]) + sigmoidf_(g0[0]) * bflo(tm[0]); r0[1] = sigmoidf_(f0[1]) * bfhi(t[0]) + sigmoidf_(g0[1]) * bfhi(tm[0]);
                r0[2] = sigmoidf_(f0[2]) * bflo(t[1]) + sigmoidf_(g0[2]) * bflo(tm[1]); r0[3] = sigmoidf_(f0[3]) * bfhi(t[1]) + sigmoidf_(g0[3]) * bfhi(tm[1]);
                r1[0] = sigmoidf_(f1[0]) * bflo(t[2]) + sigmoidf_(g1[0]) * bflo(tm[2]); r1[1] = sigmoidf_(f1[1]) * bfhi(t[2]) + sigmoidf_(g1[1]) * bfhi(tm[2]);
                r1[2] = sigmoidf_(f1[2]) * bflo(t[3]) + sigmoidf_(g1[2]) * bflo(tm[3]); r1[3] = sigmoidf_(f1[3]) * bfhi(t[3]) + sigmoidf_(g1[3]) * bfhi(tm[3]);
                stg(TM, o, pack8(r0, r1)); }
            asm volatile("" ::: "memory"); }
    }
};

struct PanelRms {
    float* xbuf; unsigned* cnt;
    __device__ __forceinline__ void run(const f32x4 (&v)[2][2][4][2], const pg8::Unit& u, int wr, int wc, int fr, int fq, LAS float* Pt, LAS float* S, int wid, int lane) const {
        ROWGROUPS(ai, m) { float s = 0.f;
#pragma unroll
            for (int bj = 0; bj < 2; ++bj)
#pragma unroll
                for (int n = 0; n < 2; ++n) { const f32x4 x = v[ai][bj][m][n]; s += (x[0] * x[0] + x[1] * x[1]) + (x[2] * x[2] + x[3] * x[3]); }
            s += __shfl_xor(s, 16); s += __shfl_xor(s, 32);
            if (fq == 0) Pt[(ai * 128 + wr * 64 + m * 16 + fr) * 4 + wc] = s; }
        LDS_WAIT(); __builtin_amdgcn_s_barrier(); asm volatile("" ::: "memory");
        const int row = wid * 32 + (lane & 31);
        if (lane < 32) { const f32x4 a = *(const LAS f32x4*)(Pt + row * 4);
            __hip_atomic_store(xbuf + (size_t)(u.pm * 256 + row) * 4 + u.pn, (a[0] + a[1]) + (a[2] + a[3]), __ATOMIC_RELAXED, __HIP_MEMORY_SCOPE_AGENT); }
        asm volatile("s_waitcnt vmcnt(0)" ::: "memory");
        if (lane == 0) __hip_atomic_fetch_add(cnt + 64 * u.pm, 1u, __ATOMIC_RELAXED, __HIP_MEMORY_SCOPE_AGENT);
        if (wid == 0) { unsigned sp = 0;
            while ((unsigned)__builtin_amdgcn_readfirstlane(__hip_atomic_load(cnt + 64 * u.pm, __ATOMIC_RELAXED, __HIP_MEMORY_SCOPE_AGENT)) < 32u) { __builtin_amdgcn_s_sleep(2); if (++sp > (1u << 22)) break; }
            __builtin_amdgcn_fence(__ATOMIC_ACQUIRE, "agent"); }
        asm volatile("s_waitcnt vmcnt(0) lgkmcnt(0)" ::: "memory"); __builtin_amdgcn_s_barrier(); asm volatile("" ::: "memory");
        if (lane < 32) { const float* sl = xbuf + (size_t)(u.pm * 256 + row) * 4; float t = 0.f;
#pragma unroll
            for (int k = 0; k < 4; ++k) t += __hip_atomic_load(sl + k, __ATOMIC_RELAXED, __HIP_MEMORY_SCOPE_AGENT);
            S[row] = rsqrtf(t * (1.0f / 1024.0f) + EPS); }
        LDS_WAIT(); __builtin_amdgcn_s_barrier(); asm volatile("" ::: "memory");
    }
};
struct EpiFinal {
    const float *x, *g5, *mod; const bf16* D12; float* out; PanelRms st; LAS float* tab;
    __device__ __forceinline__ void operator()(ACC_T, const pg8::Unit& u, int wr, int wc, int fr, int fq) const {
        const int wid = wr * 4 + wc, lane = fq * 16 + fr; LAS float* S = tab + 1024;
        st.run(acc, u, wr, wc, fr, fq, tab, S, wid, lane);
        const int col0 = u.pn * 256 + wc * 32 + 8 * fq, rt0 = wr * 64 + fr, v = (u.pm * 256) >> 12;
        const unsigned e0 = (unsigned)((u.pm * 256 + rt0) * D + col0);
        const float* gate = mod + (size_t)v * 9216 + 8 * 1024;
#pragma unroll
        for (int bj = 0; bj < 2; ++bj) {
            const unsigned cb = (unsigned)(col0 + bj * 128) * 4u;
            f32x4 g0 = ldg<f32x4>(g5, cb), g1 = ldg<f32x4>(g5, cb + 16); const f32x4 t0 = ldg<f32x4>(gate, cb), t1 = ldg<f32x4>(gate, cb + 16);
            g0 = g0 * t0 * 0.5f; g1 = g1 * t1 * 0.5f;
            ROWGROUPS(ai, m) { const float rs = S[ai * 128 + m * 16 + rt0]; const unsigned e = e0 + (unsigned)((ai * 128 + m * 16) * D) + bj * 128;
                const f32x4 x0 = ldg<f32x4>(x, e * 4u), x1 = ldg<f32x4>(x, e * 4u + 16); const u32x4 dd = ldg<u32x4>(D12, e * 2u);
                f32x4 o0, o1;
                o0[0] = x0[0] + bflo(dd[0]); o0[1] = x0[1] + bfhi(dd[0]); o0[2] = x0[2] + bflo(dd[1]); o0[3] = x0[3] + bfhi(dd[1]);
                o1[0] = x1[0] + bflo(dd[2]); o1[1] = x1[1] + bfhi(dd[2]); o1[2] = x1[2] + bflo(dd[3]); o1[3] = x1[3] + bfhi(dd[3]);
                o0 = o0 + acc[ai][bj][m][0] * rs * g0; o1 = o1 + acc[ai][bj][m][1] * rs * g1;
                stg(out, e * 4u, o0); stg(out, e * 4u + 16, o1);
                asm volatile("" ::: "memory"); } }
    }
};
struct EpiMix {
    const float *x, *g3, *g4, *mod; const bf16* D1; bf16 *D12, *U3; PanelRms st1, st2; LAS float* tab;
    __device__ __forceinline__ void operator()(f32x4 (&acc)[2][2][4][2], const pg8::Unit& u, int wr, int wc, int fr, int fq) const {
        const int wid = wr * 4 + wc, lane = fq * 16 + fr; LAS float* S = tab + 1024;
        st1.run(acc, u, wr, wc, fr, fq, tab, S, wid, lane);
        const int col0 = u.pn * 256 + wc * 32 + 8 * fq, rt0 = wr * 64 + fr, v = (u.pm * 256) >> 12;
        const unsigned e0 = (unsigned)((u.pm * 256 + rt0) * D + col0);
        const float* mv = mod + (size_t)v * 9216;
#pragma unroll
        for (int bj = 0; bj < 2; ++bj) {
            const unsigned cb = (unsigned)(col0 + bj * 128) * 4u;
            f32x4 g0 = ldg<f32x4>(g3, cb), g1 = ldg<f32x4>(g3, cb + 16); const f32x4 t0 = ldg<f32x4>(mv + 5 * 1024, cb), t1 = ldg<f32x4>(mv + 5 * 1024, cb + 16);
            g0 = g0 * t0; g1 = g1 * t1;
            ROWGROUPS(ai, m) { const float rs = S[ai * 128 + m * 16 + rt0]; const unsigned e = e0 + (unsigned)((ai * 128 + m * 16) * D) + bj * 128;
                const u32x4 dd = ldg<u32x4>(D1, e * 2u);
                f32x4 d0, d1;
                d0[0] = bflo(dd[0]); d0[1] = bfhi(dd[0]); d0[2] = bflo(dd[1]); d0[3] = bfhi(dd[1]); d1[0] = bflo(dd[2]); d1[1] = bfhi(dd[2]); d1[2] = bflo(dd[3]); d1[3] = bfhi(dd[3]);
                d0 = d0 + acc[ai][bj][m][0] * rs * g0; d1 = d1 + acc[ai][bj][m][1] * rs * g1;
                const u32x4 pk = pack8(d0, d1); stg(D12, e * 2u, pk);
                const f32x4 x0 = ldg<f32x4>(x, e * 4u), x1 = ldg<f32x4>(x, e * 4u + 16);
                f32x4 h0, h1;
                h0[0] = x0[0] + bflo(pk[0]); h0[1] = x0[1] + bfhi(pk[0]); h0[2] = x0[2] + bflo(pk[1]); h0[3] = x0[3] + bfhi(pk[1]);
                h1[0] = x1[0] + bflo(pk[2]); h1[1] = x1[1] + bfhi(pk[2]); h1[2] = x1[2] + bflo(pk[3]); h1[3] = x1[3] + bfhi(pk[3]);
                acc[ai][bj][m][0] = h0; acc[ai][bj][m][1] = h1;
                asm volatile("" ::: "memory"); } }
        st2.run(acc, u, wr, wc, fr, fq, tab, S, wid, lane);
#pragma unroll
        for (int bj = 0; bj < 2; ++bj) {
            const unsigned cb = (unsigned)(col0 + bj * 128) * 4u;
            f32x4 g0 = ldg<f32x4>(g4, cb), g1 = ldg<f32x4>(g4, cb + 16); const f32x4 c0 = ldg<f32x4>(mv + 7 * 1024, cb), c1 = ldg<f32x4>(mv + 7 * 1024, cb + 16);
            const f32x4 s0 = ldg<f32x4>(mv + 6 * 1024, cb), s1 = ldg<f32x4>(mv + 6 * 1024, cb + 16);
            g0 = g0 * (c0 + 1.0f); g1 = g1 * (c1 + 1.0f);
            ROWGROUPS(ai, m) { const float rs = S[ai * 128 + m * 16 + rt0]; const unsigned e = e0 + (unsigned)((ai * 128 + m * 16) * D) + bj * 128;
                stg(U3, e * 2u, pack8(acc[ai][bj][m][0] * rs * g0 + s0, acc[ai][bj][m][1] * rs * g1 + s1)); } }
    }
};

struct Frame { LAS unsigned char* lds; int tid, lane, wave, gw, ngw; };

__device__ __forceinline__ void transpose_item(const float* W, int K, int Nsrc, bf16* WT, int dst_row0, int src_col0, int k0, LAS float* scr, int lane, float scale = 1.0f) {
    float tv[32];
    { const float* wp = W + (size_t)(k0 + (lane >> 5)) * Nsrc + src_col0 + (lane & 31);
#pragma unroll
      for (int i = 0; i < 32; ++i) tv[i] = __builtin_nontemporal_load(wp + (size_t)(2 * i) * Nsrc); }
#pragma unroll
    for (int i = 0; i < 32; ++i) scr[(2 * i + (lane >> 5)) * 33 + (lane & 31)] = tv[i] * scale;
    LDS_WAIT(); asm volatile("" ::: "memory");
    const int c = lane & 7;
#pragma unroll
    for (int j = 0; j < 4; ++j) { const int n = (lane >> 3) + 8 * j; const LAS float* s = scr + (8 * c) * 33 + n;
        u32x4 o; o.x = pk2(s[0 * 33], s[1 * 33]); o.y = pk2(s[2 * 33], s[3 * 33]); o.z = pk2(s[4 * 33], s[5 * 33]); o.w = pk2(s[6 * 33], s[7 * 33]);
        *(u32x4*)(WT + (size_t)(dst_row0 + n) * K + k0 + 8 * c) = o; }
    LDS_WAIT(); asm volatile("" ::: "memory");
}
__device__ __forceinline__ void conv_w13(const Frame& F, const float* w13, bf16* dst, int it0, int its) {
    LAS float* scr = (LAS float*)(F.lds + F.wave * 16384);
    for (int it = it0 + F.gw; it < it0 + its; it += F.ngw) { const int r = it, kb = r / 176, nb = r % 176, n0 = 32 * nb, j = n0 >> 8, s = (n0 >> 7) & 1, i0 = n0 & 127;
        transpose_item(w13, D, 2 * FF, dst, n0, s * FF + 128 * j + i0, 64 * kb, scr, F.lane, s ? 0.6931471805599453f : 1.4426950408889634f); }
}
__device__ __forceinline__ void conv_plain(const Frame& F, const float* W, int K, int N, bf16* dst, int it0, int its) {
    LAS float* scr = (LAS float*)(F.lds + F.wave * 16384);
    const int nblk = N / 32;
    for (int it = it0 + F.gw; it < it0 + its; it += F.ngw) { const int r = it, kb = r / nblk, nb = r % nblk;
        transpose_item(W, K, N, dst, 32 * nb, 32 * nb, 64 * kb, scr, F.lane); }
}
__device__ __forceinline__ int win_src_col(int n0) {
    if (n0 < ROW_K) return COL_Q + n0;
    if (n0 < ROW_V) return COL_K + (n0 - ROW_K);
    if (n0 < ROW_F) return COL_V + (n0 - ROW_V);
    if (n0 < ROW_O) return COL_F + (n0 - ROW_F);
    if (n0 < ROW_GF) return COL_O + (n0 - ROW_O);
    { const int r = n0 - ROW_GF, j = r >> 8, sg = (r >> 7) & 1, i0 = r & 127; return (sg ? COL_GM : COL_GF) + 128 * j + i0; }
}
__device__ __forceinline__ void conv_win(const Frame& F, const float* w_in, bf16* dst, int it0, int its) {
    LAS float* scr = (LAS float*)(F.lds + F.wave * 16384);
    constexpr int nblk = WIN_ROWS / 32;
    for (int it = it0 + F.gw; it < it0 + its; it += F.ngw) { const int r = it, kb = r / nblk, nb = r % nblk;
        transpose_item(w_in, D, INW, dst, 32 * nb, win_src_col(32 * nb), 64 * kb, scr, F.lane); }
}

__device__ __forceinline__ void ada_phase(const Frame& F, const Params& p) {
    LAS float* sc = (LAS float*)F.lds;
    LAS float* part = sc + 5 * 1024;
    float* mod = (float*)(p.ws + WS_MOD);
    for (int i = F.tid; i < 5 * 1024; i += NTHR) { const int v = i >> 10, k = i & 1023; const float cv = v < 4 ? p.c[v * 1024 + k] : p.c_ctx[k]; sc[i] = siluf_(cv); }
    __syncthreads();
    for (int tile = blockIdx.x; tile < 144; tile += gridDim.x) {
        const int col = 64 * tile + F.lane;
        float a0 = 0.f, a1 = 0.f, a2 = 0.f, a3 = 0.f, a4 = 0.f;
#pragma unroll 32
        for (int it = 0; it < 128; ++it) { const int k = 128 * F.wave + it; const float w = __builtin_nontemporal_load(p.w_ada + (size_t)k * 9216 + col);
            a0 += sc[k] * w; a1 += sc[1024 + k] * w; a2 += sc[2048 + k] * w; a3 += sc[3072 + k] * w; a4 += sc[4096 + k] * w; }
        { LAS float* pp = part + F.wave * 320 + F.lane; pp[0] = a0; pp[64] = a1; pp[128] = a2; pp[192] = a3; pp[256] = a4; }
        __syncthreads();
        if (F.tid < 320) { float s = 0.f;
#pragma unroll
            for (int w = 0; w < 8; ++w) s += part[w * 320 + F.tid];
            const int v = F.tid >> 6, cc = 64 * tile + (F.tid & 63); mod[v * 9216 + cc] = s + p.b_ada[cc]; }
        __syncthreads();
    }
}
__device__ __forceinline__ void wfour_phase(const Frame& F, const Params& p) {
    LAS float* ct = (LAS float*)(F.lds + 32768);
    if (F.tid < 128) ct[F.tid] = cosf((float)F.tid * (6.283185307179586f / 128.0f));
    __syncthreads();
    bf16* WF = (bf16*)(p.ws + WS_WFOUR);
    for (int task = blockIdx.x * NTHR + F.tid; task < 1024 * 128; task += gridDim.x * NTHR) {
        const int n = task & 1023, jg = task >> 10, i = jg >> 1, pq = jg & 1, f0 = 8 * i, g = f0 >> 7, ch0 = f0 & 127;
        float a[8];
#pragma unroll
        for (int t = 0; t < 8; ++t) a[t] = 0.f;
        const float* wp = p.w_four + (size_t)(g * 128) * 1024 + n;
        const int sh = pq ? 96 : 0;
#pragma unroll 8
        for (int k3 = 0; k3 < 128; ++k3) { const float w = wp[(size_t)k3 * 1024];
#pragma unroll
            for (int t = 0; t < 8; ++t) a[t] += ct[(k3 * (ch0 + t) + sh) & 127] * w; }
        const float scl = pq ? -0.08838834764831845f : 0.08838834764831845f;
        u32x4 o; o.x = pk2(a[0] * scl, a[1] * scl); o.y = pk2(a[2] * scl, a[3] * scl); o.z = pk2(a[4] * scl, a[5] * scl); o.w = pk2(a[6] * scl, a[7] * scl);
        *(u32x4*)(WF + (size_t)n * 1024 + 8 * jg) = o;
    }
    __syncthreads();
}

struct Row { f32x4 v[4]; };
__device__ __forceinline__ Row ld_row_f32(const float* r, int lane) { Row o; const f32x4* q = (const f32x4*)r + lane;
#pragma unroll
    for (int j = 0; j < 4; ++j) o.v[j] = q[64 * j]; return o; }
__device__ __forceinline__ Row ld_row_bf16(const bf16* r, int lane) { Row o; const u32x2* q = (const u32x2*)r + lane;
#pragma unroll
    for (int j = 0; j < 4; ++j) { const u32x2 w = q[64 * j]; o.v[j] = (f32x4){bflo(w.x), bfhi(w.x), bflo(w.y), bfhi(w.y)}; } return o; }
__device__ __forceinline__ void st_row_bf16(bf16* r, int lane, const Row& a) { u32x2* q = (u32x2*)r + lane;
#pragma unroll
    for (int j = 0; j < 4; ++j) { u32x2 w; w.x = pk2(a.v[j][0], a.v[j][1]); w.y = pk2(a.v[j][2], a.v[j][3]); q[64 * j] = w; } }
__device__ __forceinline__ void st_row_f32(float* r, int lane, const Row& a) { f32x4* q = (f32x4*)r + lane;
#pragma unroll
    for (int j = 0; j < 4; ++j) q[64 * j] = a.v[j]; }
__device__ __forceinline__ float row_rstd(const Row& a) { float s = 0.f;
#pragma unroll
    for (int j = 0; j < 4; ++j) s += (a.v[j][0] * a.v[j][0] + a.v[j][1] * a.v[j][1]) + (a.v[j][2] * a.v[j][2] + a.v[j][3] * a.v[j][3]);
    return rsqrtf(wave_sum(s) * (1.0f / 1024.0f) + EPS); }
__device__ __forceinline__ Row round_bf16(const Row& a) { Row o;
#pragma unroll
    for (int j = 0; j < 4; ++j)
#pragma unroll
        for (int e = 0; e < 4; ++e) o.v[j][e] = bf2f(f2bf(a.v[j][e]));
    return o; }
__device__ __forceinline__ Row modnorm2(const Row& h, const Row& gs, const Row& sh) {
    const float rs = row_rstd(h); Row o;
#pragma unroll
    for (int j = 0; j < 4; ++j) o.v[j] = h.v[j] * rs * gs.v[j] + sh.v[j];
    return o; }
__device__ __forceinline__ Row gated_norm2(const Row& y, const Row& gg) {
    const float rs = row_rstd(y); Row o;
#pragma unroll
    for (int j = 0; j < 4; ++j) o.v[j] = y.v[j] * rs * gg.v[j];
    return o; }
__device__ __forceinline__ Row rmul(const Row& a, const Row& b) { Row o;
#pragma unroll
    for (int j = 0; j < 4; ++j) o.v[j] = a.v[j] * b.v[j]; return o; }
__device__ __forceinline__ Row rmul1p(const Row& g, const Row& sc) { Row o;
#pragma unroll
    for (int j = 0; j < 4; ++j) o.v[j] = g.v[j] * (sc.v[j] + 1.0f); return o; }
__device__ __forceinline__ Row rscale(const Row& a, float c) { Row o;
#pragma unroll
    for (int j = 0; j < 4; ++j) o.v[j] = a.v[j] * c; return o; }
__device__ __forceinline__ Row radd(const Row& a, const Row& b) { Row o;
#pragma unroll
    for (int j = 0; j < 4; ++j) o.v[j] = a.v[j] + b.v[j]; return o; }
__device__ __forceinline__ const float* modp(const Params& p, int v, int i) { return (const float*)(p.ws + WS_MOD) + (size_t)v * 9216 + i * 1024; }
__device__ __forceinline__ const float* xrow(const Params& p, int r) { return r < TLAT ? p.x + (size_t)r * D : p.ctx + (size_t)(r - TLAT) * D; }
__device__ __forceinline__ int rowvar(int r) { return r < TLAT ? (r >> 12) : 4; }

__device__ __forceinline__ int row_of(const Frame& F, int it) {
    const int per = F.ngw >> 2, nl = (SEQ + per - 1) / per;
    if (it < nl) { const int rl = (F.gw >> 2) + it * per; if (rl < SEQ) return (F.gw & 3) * SEQ + rl; it = nl; }
    const int rc = F.gw + (it - nl) * F.ngw; return rc < TCTX ? TLAT + rc : -1;
}
__device__ __forceinline__ int lat_row(const Frame& F, int k) { const int rl = (F.gw >> 2) + k * (F.ngw >> 2); return rl < SEQ ? (F.gw & 3) * SEQ + rl : -1; }
__device__ __forceinline__ void phase_u1(const Frame& F, const Params& p) {
    bf16* U = (bf16*)(p.ws + WS_U);
    { const int v = F.gw & 3; const Row gs = rmul1p(ld_row_f32(p.norm_g, F.lane), ld_row_f32(modp(p, v, 1), F.lane)), sh = ld_row_f32(modp(p, v, 0), F.lane);
      for (int k0 = 0; lat_row(F, k0) >= 0; k0 += 4) { Row xr[4]; int rr[4];
#pragma unroll
          for (int q = 0; q < 4; ++q) { rr[q] = lat_row(F, k0 + q); if (rr[q] >= 0) xr[q] = ld_row_f32(p.x + (size_t)rr[q] * D, F.lane); }
#pragma unroll
          for (int q = 0; q < 4; ++q) if (rr[q] >= 0) st_row_bf16(U + (size_t)rr[q] * D, F.lane, modnorm2(xr[q], gs, sh)); } }
    { const Row gs = rmul1p(ld_row_f32(p.norm_g, F.lane), ld_row_f32(modp(p, 4, 1), F.lane)), sh = ld_row_f32(modp(p, 4, 0), F.lane);
      for (int rc = F.gw; rc < TCTX; rc += F.ngw) st_row_bf16(U + (size_t)(TLAT + rc) * D, F.lane, modnorm2(ld_row_f32(p.ctx + (size_t)rc * D, F.lane), gs, sh)); }
}
__device__ __forceinline__ void phase_post_ffn_a(const Frame& F, const Params& p) {
    bf16* U = (bf16*)(p.ws + WS_U2); bf16* D1 = (bf16*)((unsigned char*)p.out + DO_D1); const bf16* Y1 = (const bf16*)(p.ws + WS_Y1);
    { const int v = F.gw & 3; const Row gg = rscale(rmul(ld_row_f32(p.norm_g + 1 * D, F.lane), ld_row_f32(modp(p, v, 2), F.lane)), 0.5f);
      const Row gs = rmul1p(ld_row_f32(p.norm_g + 2 * D, F.lane), ld_row_f32(modp(p, v, 4), F.lane)), sh = ld_row_f32(modp(p, v, 3), F.lane);
      for (int k0 = 0; lat_row(F, k0) >= 0; k0 += 4) { Row xr[4], yr[4]; int rr[4];
#pragma unroll
          for (int q = 0; q < 4; ++q) { rr[q] = lat_row(F, k0 + q); if (rr[q] >= 0) { yr[q] = ld_row_bf16(Y1 + (size_t)rr[q] * D, F.lane); xr[q] = ld_row_f32(p.x + (size_t)rr[q] * D, F.lane); } }
#pragma unroll
          for (int q = 0; q < 4; ++q) if (rr[q] >= 0) { const Row dl = round_bf16(gated_norm2(yr[q], gg)); st_row_bf16(D1 + (size_t)rr[q] * D, F.lane, dl);
              st_row_bf16(U + (size_t)rr[q] * D, F.lane, modnorm2(radd(xr[q], dl), gs, sh)); } } }
    { const Row gg = rscale(rmul(ld_row_f32(p.norm_g + 1 * D, F.lane), ld_row_f32(modp(p, 4, 2), F.lane)), 0.5f);
      const Row gs = rmul1p(ld_row_f32(p.norm_g + 2 * D, F.lane), ld_row_f32(modp(p, 4, 4), F.lane)), sh = ld_row_f32(modp(p, 4, 3), F.lane);
      for (int rc = F.gw; rc < TCTX; rc += F.ngw) { const float* yc = (const float*)(p.ws + WS_Y1C) + (size_t)rc * D;
          Row y = radd(radd(ld_row_f32(yc, F.lane), ld_row_f32(yc + (size_t)TCTX * D, F.lane)), radd(ld_row_f32(yc + (size_t)2 * TCTX * D, F.lane), ld_row_f32(yc + (size_t)3 * TCTX * D, F.lane)));
          y = radd(y, radd(radd(ld_row_f32(yc + (size_t)4 * TCTX * D, F.lane), ld_row_f32(yc + (size_t)5 * TCTX * D, F.lane)), radd(ld_row_f32(yc + (size_t)6 * TCTX * D, F.lane), ld_row_f32(yc + (size_t)7 * TCTX * D, F.lane))));
          const Row dl = round_bf16(gated_norm2(y, gg));
          st_row_bf16(U + (size_t)(TLAT + rc) * D, F.lane, modnorm2(radd(ld_row_f32(p.ctx + (size_t)rc * D, F.lane), dl), gs, sh)); } }
}
__device__ __forceinline__ void phase_u2_again(const Frame& F, const Params& p) {
    bf16* U = (bf16*)(p.ws + WS_U); const bf16* D1 = (const bf16*)((unsigned char*)p.out + DO_D1);
    const int v = F.gw & 3; const Row gs = rmul1p(ld_row_f32(p.norm_g + 2 * D, F.lane), ld_row_f32(modp(p, v, 4), F.lane)), sh = ld_row_f32(modp(p, v, 3), F.lane);
    for (int k0 = 0; lat_row(F, k0) >= 0; k0 += 4) { Row xr[4], dr[4]; int rr[4];
#pragma unroll
        for (int q = 0; q < 4; ++q) { rr[q] = lat_row(F, k0 + q); if (rr[q] >= 0) { xr[q] = ld_row_f32(p.x + (size_t)rr[q] * D, F.lane); dr[q] = ld_row_bf16(D1 + (size_t)rr[q] * D, F.lane); } }
#pragma unroll
        for (int q = 0; q < 4; ++q) if (rr[q] >= 0) st_row_bf16(U + (size_t)rr[q] * D, F.lane, modnorm2(radd(xr[q], dr[q]), gs, sh)); }
}

constexpr int SQK_STRIDE = 544;
constexpr int M1_SQ = 0, M1_SK = 128 * SQK_STRIDE, M1_TAB = 2 * 128 * SQK_STRIDE;
__device__ __forceinline__ float logsigmoidf_(float x) { return fminf(x, 0.f) - log1pf(__expf(-fabsf(x))); }

__device__ __forceinline__ void m1_item(const Frame& F, const Params& p, int bh, int cp) {
    const int b = bh >> 2, h = bh & 3; const bool is_lat = cp >= 2;
    const int seqlen = is_lat ? SEQ : CTXL, t0 = is_lat ? CH * (cp - 2) : CH * cp, rowbase = is_lat ? b * SEQ : TLAT + b * CTXL, pbase = CH * cp;
    const bf16* QPRE = (const bf16*)(p.ws + WS_QPRE); const bf16* KPRE = (const bf16*)(p.ws + WS_KPRE);
    LAS unsigned char* sQ = F.lds + M1_SQ; LAS unsigned char* sK = F.lds + M1_SK; LAS float* tab = (LAS float*)(F.lds + M1_TAB);
    const int lane = F.lane, w = F.wave, fr = lane & 15, fq = lane >> 4;
    {
        const int ch = 8 * (F.tid & 31), rb = 8 * (F.tid >> 5);
#define M1_CONV(SRC, CCH, SCALE, DST) do { \
        float w0[8], w1[8], w2[8], bb[8]; \
        _Pragma("unroll") for (int e = 0; e < 8; ++e) { const int cc = (CCH) + h * 256 + ch + e; w0[e] = p.conv_w[cc]; w1[e] = p.conv_w[2048 + cc]; w2[e] = p.conv_w[4096 + cc]; bb[e] = p.conv_b[cc]; } \
        u32x4 xr[10]; const bf16* base = (SRC) + (size_t)(rowbase + t0 + rb) * D + h * 256 + ch; \
        _Pragma("unroll") for (int i = 0; i < 10; ++i) { const int sq = t0 + rb + i - 1; xr[i] = (sq >= 0 && sq < seqlen) ? *(const u32x4*)(base + (ptrdiff_t)(i - 1) * D) : (u32x4){0u, 0u, 0u, 0u}; } \
        _Pragma("unroll") for (int i = 0; i < 8; ++i) { float o[8]; \
            _Pragma("unroll") for (int q = 0; q < 4; ++q) { \
                const float y0 = w0[2 * q] * bflo(xr[i][q]) + w1[2 * q] * bflo(xr[i + 1][q]) + w2[2 * q] * bflo(xr[i + 2][q]) + bb[2 * q]; \
                const float y1 = w0[2 * q + 1] * bfhi(xr[i][q]) + w1[2 * q + 1] * bfhi(xr[i + 1][q]) + w2[2 * q + 1] * bfhi(xr[i + 2][q]) + bb[2 * q + 1]; \
                o[2 * q] = siluf_(y0) * (SCALE); o[2 * q + 1] = siluf_(y1) * (SCALE); } \
            u32x4 wv; wv.x = pk2(o[0], o[1]); wv.y = pk2(o[2], o[3]); wv.z = pk2(o[4], o[5]); wv.w = pk2(o[6], o[7]); \
            *(LAS u32x4*)((DST) + (rb + i) * SQK_STRIDE + ch * 2) = wv; } } while (0)
        M1_CONV(KPRE, 1024, 0.0625f, sK);
        if (is_lat) M1_CONV(QPRE, 0, 1.0f, sQ);
#undef M1_CONV
    }
    if (w < 2) {
        const int dir = w; const float* G = (const float*)(p.ws + WS_GATES);
        const int i0 = 2 * lane, i1 = 2 * lane + 1, ta = dir ? 127 - i0 : i0, tb = dir ? 127 - i1 : i1;
        const float li0 = G[(size_t)(rowbase + t0 + ta) * 16 + dir * 8 + h], li1 = G[(size_t)(rowbase + t0 + tb) * 16 + dir * 8 + h];
        const float lf0 = logsigmoidf_(G[(size_t)(rowbase + t0 + ta) * 16 + dir * 8 + 4 + h]), lf1 = logsigmoidf_(G[(size_t)(rowbase + t0 + tb) * 16 + dir * 8 + 4 + h]);
        float ps = lf0 + lf1;
#pragma unroll
        for (int o = 1; o < 64; o <<= 1) { const float v = __shfl_up(ps, o); if (lane >= o) ps += v; }
        const float ex = ps - (lf0 + lf1), b0 = ex + lf0, b1 = ex + lf0 + lf1;
        const float r0 = li0 - b0, r1 = li1 - b1;
        float pm = fmaxf(r0, r1);
#pragma unroll
        for (int o = 1; o < 64; o <<= 1) { const float v = __shfl_up(pm, o); if (lane >= o) pm = fmaxf(pm, v); }
        const float pmex = __shfl_up(pm, 1); const float m0 = lane ? fmaxf(pmex, r0) : r0, m1 = pm;
        LAS float* tb_ = tab + dir * 384;
        tb_[ta] = b0; tb_[128 + ta] = r0; tb_[256 + ta] = m0; tb_[tb] = b1; tb_[128 + tb] = r1; tb_[256 + tb] = m1;
        float* TS = (float*)(p.ws + WS_TOKSC) + ((size_t)(dir * 16 + bh) * PLEN + pbase) * 4;
        TS[ta * 4 + 0] = b0; TS[ta * 4 + 1] = li0; TS[ta * 4 + 2] = b0 + m0; TS[tb * 4 + 0] = b1; TS[tb * 4 + 1] = li1; TS[tb * 4 + 2] = b1 + m1;
        if (lane == 63) { float* CS = (float*)(p.ws + WS_CHSC) + ((size_t)(dir * 16 + bh) * NCHK + cp) * 2; CS[0] = b1; CS[1] = b1 + m1; }
    }
    __syncthreads();
    {
        u32x4* KT = (u32x4*)(p.ws + WS_KT) + ((size_t)bh * NCHK + cp) * 4096;
        const int d = F.tid & 255, sgp = F.tid >> 8;
#pragma unroll
        for (int it = 0; it < 8; ++it) { const int sg = 2 * it + sgp; unsigned short e[8];
#pragma unroll
            for (int j = 0; j < 8; ++j) e[j] = *(const LAS unsigned short*)(sK + (8 * sg + j) * SQK_STRIDE + d * 2);
            u32x4 o; o.x = e[0] | ((unsigned)e[1] << 16); o.y = e[2] | ((unsigned)e[3] << 16); o.z = e[4] | ((unsigned)e[5] << 16); o.w = e[6] | ((unsigned)e[7] << 16);
            KT[((((d >> 5) * 2 + ((d >> 4) & 1)) * 4 + (sg >> 2)) * 64) + (sg & 3) * 16 + (d & 15)] = o; }
        if (is_lat) { u32x4* Q = (u32x4*)(p.ws + WS_Q) + ((size_t)bh * 32 + (cp - 2)) * 4096;
#pragma unroll
            for (int it = 0; it < 8; ++it) { const int piece = F.tid + 512 * it, row = piece >> 5, c16 = piece & 31;
                Q[((row >> 4) * 8 + (c16 >> 2)) * 64 + (c16 & 3) * 16 + (row & 15)] = *(const LAS u32x4*)(sQ + row * SQK_STRIDE + c16 * 16); } }
    }
    if (is_lat) {
        bf16x8 bq[8];
#pragma unroll
        for (int k = 0; k < 8; ++k) bq[k] = *(const LAS bf16x8*)(sQ + (16 * w + fr) * SQK_STRIDE + (32 * k + 8 * fq) * 2);
        f32x4 acc[8];
        { bf16x8 ac[8], an[8];
#pragma unroll
          for (int k = 0; k < 8; ++k) ac[k] = *(const LAS bf16x8*)(sK + fr * SQK_STRIDE + (32 * k + 8 * fq) * 2);
#pragma unroll
          for (int mt = 0; mt < 8; ++mt) { acc[mt] = (f32x4){0.f, 0.f, 0.f, 0.f};
            if (mt < 7) {
#pragma unroll
                for (int k = 0; k < 8; ++k) an[k] = *(const LAS bf16x8*)(sK + (16 * (mt + 1) + fr) * SQK_STRIDE + (32 * k + 8 * fq) * 2); }
#pragma unroll
            for (int k = 0; k < 8; ++k) acc[mt] = __builtin_amdgcn_mfma_f32_16x16x32_bf16(ac[k], bq[k], acc[mt], 0, 0, 0);
#pragma unroll
            for (int k = 0; k < 8; ++k) ac[k] = an[k]; } }
        const int t = 16 * w + fr, c = cp - 2;
        bf16* P = (bf16*)((unsigned char*)p.out + DO_P);
#pragma unroll
        for (int dir = 0; dir < 2; ++dir) {
            const LAS float* tb_ = tab + dir * 384; const float mx = tb_[256 + t]; float dsum = 0.f;
            unsigned char* pblk = (unsigned char*)(P + ((size_t)(dir * 16 + bh) * 32 + c) * 128 * 128);
#pragma unroll
            for (int mt = 0; mt < 8; ++mt) { const int s0 = 16 * mt + 4 * fq; const f32x4 rs = *(const LAS f32x4*)(tb_ + 128 + s0); float pv[4];
#pragma unroll
                for (int r = 0; r < 4; ++r) { const int s = s0 + r; const bool valid = dir ? (s >= t) : (s <= t);
                    const float wgt = valid ? __expf(fminf(rs[r] - mx, 0.f)) : 0.f; pv[r] = bf2f(f2bf(acc[mt][r] * wgt)); dsum += pv[r]; }
                u32x2 o; o.x = pk2(pv[0], pv[1]); o.y = pk2(pv[2], pv[3]); const int s8 = 2 * mt + (fq >> 1);
                *(u32x2*)(pblk + ((w * 4 + (s8 >> 2)) * 64 + (s8 & 3) * 16 + fr) * 16 + (fq & 1) * 8) = o; }
            dsum += __shfl_xor(dsum, 16); dsum += __shfl_xor(dsum, 32);
            if (fq == 0) ((float*)(p.ws + WS_TOKSC))[((size_t)(dir * 16 + bh) * PLEN + pbase + t) * 4 + 3] = dsum;
        }
    }
    __syncthreads();
}

constexpr int FO_TAB = 131072;
__device__ __forceinline__ int fo_off(int R, int r) { return R * 128 + ((((r >> 3) ^ ((R >> 1) & 7))) << 4) + (r & 7) * 2; }
__device__ __forceinline__ void fourier_item(const Frame& F, const Params& p, int item) {
    const int b = item >> 6, i = item & 63; const int lane = F.lane, w = F.wave, fr = lane & 15, fq = lane >> 4;
    LAS unsigned char* sPQ = F.lds; LAS float* ct = (LAS float*)(F.lds + FO_TAB);
    if (F.tid < 64) ct[F.tid] = cosf((float)F.tid * (6.283185307179586f / 64.0f));
    __syncthreads();
    const bf16* XT = (const bf16*)(p.ws + WS_XFT);
    {
        const bf16* xrow_ = XT + (size_t)(8 * i + w) * TLAT + b * SEQ;
        bf16x8 xv[4][2];
#pragma unroll
        for (int nt = 0; nt < 4; ++nt) { const int r = 16 * nt + fr; xv[nt][0] = *(const bf16x8*)(xrow_ + r * 64 + 8 * fq); xv[nt][1] = *(const bf16x8*)(xrow_ + r * 64 + 32 + 8 * fq); }
#pragma unroll 1
        for (int mt = 0; mt < 8; ++mt) {
            bf16x8 WA[2];
#pragma unroll
            for (int k = 0; k < 2; ++k) { const int kc = (16 * mt + fr) & 63, sh = (mt >> 2) * 48; bf16x8 v;
#pragma unroll
                for (int j = 0; j < 8; ++j) { const int c = 32 * k + 8 * fq + j; v[j] = (short)f2bf(ct[(kc * c + sh) & 63]); }
                WA[k] = v; }
#pragma unroll
            for (int nt = 0; nt < 4; ++nt) { const int r = 16 * nt + fr; f32x4 a = (f32x4){0.f, 0.f, 0.f, 0.f};
                a = __builtin_amdgcn_mfma_f32_16x16x32_bf16(WA[0], xv[nt][0], a, 0, 0, 0); a = __builtin_amdgcn_mfma_f32_16x16x32_bf16(WA[1], xv[nt][1], a, 0, 0, 0);
#pragma unroll
                for (int rg = 0; rg < 4; ++rg) { const int kcp = 16 * mt + 4 * fq + rg; *(LAS unsigned short*)(sPQ + fo_off(kcp * 8 + w, r)) = (unsigned short)f2bf(a[rg]); } } }
    }
    __syncthreads();
    {
        bf16x8 WB[4];
        const int kr = (16 * w + fr) & 63, half = w >> 2;
#pragma unroll
        for (int ks = 0; ks < 4; ++ks) { const int pq = ks >> 1; unsigned short e[8];
#pragma unroll
            for (int j = 0; j < 8; ++j) { const int r = 32 * (ks & 1) + 8 * fq + j;
                float v; if (half == pq) v = ct[(kr * r) & 63]; else { v = ct[(kr * r + 48) & 63]; if (half == 0) v = -v; }
                e[j] = (unsigned short)f2bf(v * 0.015625f); }
            bf16x8 v; v[0] = (short)e[0]; v[1] = (short)e[1]; v[2] = (short)e[2]; v[3] = (short)e[3]; v[4] = (short)e[4]; v[5] = (short)e[5]; v[6] = (short)e[6]; v[7] = (short)e[7]; WB[ks] = v; }
        bf16* UF = (bf16*)(p.ws + WS_UF) + (size_t)(b * SEQ + (16 * (w & 3) + fr) * 64) * D + 16 * i + 8 * half + 4 * (fq & 1);
#pragma unroll 4
        for (int nt = 0; nt < 32; ++nt) { f32x4 a = (f32x4){0.f, 0.f, 0.f, 0.f};
#pragma unroll
            for (int ks = 0; ks < 4; ++ks) { const int R = (ks >> 1) * 512 + 16 * nt + fr, q = 4 * (ks & 1) + fq;
                const bf16x8 bb = *(const LAS bf16x8*)(sPQ + R * 128 + ((q ^ ((R >> 1) & 7)) << 4));
                a = __builtin_amdgcn_mfma_f32_16x16x32_bf16(bb, WB[ks], a, 0, 0, 0); }
            u32x2 o; o.x = pk2(a[0], a[1]); o.y = pk2(a[2], a[3]);
            *(u32x2*)(UF + (size_t)(2 * nt + (fq >> 1)) * D) = o; }
    }
    __syncthreads();
}

constexpr int M2_CT = 0, M2_CTB = 48 * 544, M2_VT = 2 * M2_CTB, M2_VTB = 32 * 288, M2_VW = M2_VT + 2 * M2_VTB, M2_VWB = 48 * 288, M2_TAB = M2_VW + 2 * M2_VWB, M2_TABB = 5 * 512, M2_SC = M2_TAB + 3 * M2_TABB, M2_HS = M2_SC + 1024;
struct M2Step { int cp, is_lat, p0, tl0, tokrow0; };
__device__ __forceinline__ M2Step m2_step(int dir, int b, int j) {
    M2Step s; const int jj = j < NCHK ? j : NCHK - 1;
    s.cp = dir ? (jj == 0 ? 1 : (jj == 1 ? 0 : 35 - jj)) : jj; s.is_lat = s.cp >= 2; s.p0 = CH * s.cp; s.tl0 = s.is_lat ? CH * (s.cp - 2) : 0;
    s.tokrow0 = s.is_lat ? b * SEQ + s.tl0 : TLAT + b * CTXL + CH * s.cp; return s;
}
__device__ __forceinline__ void m2_stream(const Frame& F, const Params& p, int sid) {
    const int x = sid & 7, jj_ = sid >> 3, gl = jj_ >> 3, slice = jj_ & 7, g = x + 8 * gl, dir = g >> 4, bh = g & 15, b = bh >> 2, h = bh & 3;
    int tid = F.tid; asm volatile("" : "+v"(tid)); const int lane = tid & 63, w = F.wave, fr = lane & 15, fq = lane >> 4, wa = w & 3, tr = tid & 255;
    const bool roleA = w < 4;
    LAS unsigned char* L = F.lds;
    LAS float* smst = (LAS float*)(L + M2_SC); LAS float* smnw = smst + 34; LAS float* sdec = smst + 68; LAS float* scs = smst + 102;
    const float* TS = (const float*)(p.ws + WS_TOKSC) + (size_t)(dir * 16 + bh) * PLEN * 4;
    const float* CS = (const float*)(p.ws + WS_CHSC) + (size_t)(dir * 16 + bh) * NCHK * 2;
    const bf16* VT = (const bf16*)(p.ws + WS_VT) + (size_t)(h * 256 + slice * 32 + (tr >> 4)) * MTOK + 8 * (tr & 15);
    const bf16x8* KT = (const bf16x8*)(p.ws + WS_KT) + (size_t)bh * NCHK * 4096 + wa * 1024 + lane;
    const bf16x8* Q = (const bf16x8*)(p.ws + WS_Q) + (size_t)bh * 32 * 4096 + wa * 1024 + lane;
    const bf16x8* P = (const bf16x8*)((const unsigned char*)p.out + DO_P) + (size_t)(dir * 16 + bh) * 32 * 2048 + wa * 512 + lane;
    bf16* H = (bf16*)(p.ws + (dir ? WS_HB : WS_HF)) + (size_t)(b * SEQ) * D + h * 256 + slice * 32;
    for (int i = tid; i < M2_TAB / 4; i += NTHR) ((LAS unsigned*)L)[i] = 0u;
    if (tid < 2 * NCHK) scs[tid] = CS[tid];
    __syncthreads();
    if (tid == 0) { float m = 0.f;
        for (int j = 0; j < NCHK; ++j) { const M2Step st = m2_step(dir, b, j); const float bL = scs[st.cp * 2], gmax = scs[st.cp * 2 + 1];
            const float mn = fmaxf(bL + m, gmax); smst[j] = m; smnw[j] = mn; sdec[j] = __expf(bL + m - mn); m = mn; } }
    __syncthreads();
#define M2_TABLES(jj, stp, sc) do { if (tr < 128 && (jj) < NCHK) { LAS float* tb_ = (LAS float*)(L + M2_TAB + ((jj) % 3) * M2_TABB); const float bL = scs[(stp).cp * 2], mst_ = smst[jj], mnw_ = smnw[jj]; \
        tb_[512 + tr] = __expf(fminf(bL - (sc)[0] + (sc)[1] - mnw_, 0.f)); \
        const float mt_ = fmaxf((sc)[0] + mst_, (sc)[2]); const float c_ = __expf((sc)[2] - mt_); \
        *(LAS f32x4*)(tb_ + 4 * tr) = (f32x4){__expf((sc)[0] + mst_ - mt_), c_, c_ * (sc)[3], __expf(-mt_)}; } } while (0)
#define M2_VSTAGE(jj, va, vb) do { if ((jj) < NCHK) { const LAS float* tb_ = (const LAS float*)(L + M2_TAB + ((jj) % 3) * M2_TABB); const int e = tr >> 4, sg = tr & 15; \
        const f32x4 wa_ = *(const LAS f32x4*)(tb_ + 512 + 8 * sg), wb_ = *(const LAS f32x4*)(tb_ + 516 + 8 * sg); u32x4 o_; \
        *(LAS u32x4*)(L + M2_VT + ((jj) & 1) * M2_VTB + e * 288 + sg * 16) = (va); *(LAS u32x4*)(L + M2_VT + ((jj) & 1) * M2_VTB + (e + 16) * 288 + sg * 16) = (vb); \
        o_[0] = pk2(bflo((va)[0]) * wa_[0], bfhi((va)[0]) * wa_[1]); o_[1] = pk2(bflo((va)[1]) * wa_[2], bfhi((va)[1]) * wa_[3]); o_[2] = pk2(bflo((va)[2]) * wb_[0], bfhi((va)[2]) * wb_[1]); o_[3] = pk2(bflo((va)[3]) * wb_[2], bfhi((va)[3]) * wb_[3]); \
        *(LAS u32x4*)(L + M2_VW + ((jj) & 1) * M2_VWB + e * 288 + sg * 16) = o_; \
        o_[0] = pk2(bflo((vb)[0]) * wa_[0], bfhi((vb)[0]) * wa_[1]); o_[1] = pk2(bflo((vb)[1]) * wa_[2], bfhi((vb)[1]) * wa_[3]); o_[2] = pk2(bflo((vb)[2]) * wb_[0], bfhi((vb)[2]) * wb_[1]); o_[3] = pk2(bflo((vb)[3]) * wb_[2], bfhi((vb)[3]) * wb_[3]); \
        *(LAS u32x4*)(L + M2_VW + ((jj) & 1) * M2_VWB + (e + 16) * 288 + sg * 16) = o_; \
        if (tr < 16) { u32x4 o2; o2[0] = pk2(wa_[0], wa_[1]); o2[1] = pk2(wa_[2], wa_[3]); o2[2] = pk2(wb_[0], wb_[1]); o2[3] = pk2(wb_[2], wb_[3]); \
            *(LAS u32x4*)(L + M2_VW + ((jj) & 1) * M2_VWB + 32 * 288 + tr * 16) = o2; } } } while (0)
#define M2_LDQ(QQ, st) do { const bf16x8* q_ = Q + (size_t)((st).is_lat ? (st).cp - 2 : 0) * 4096; _Pragma("unroll") for (int k = 0; k < 8; ++k) { (QQ)[0][k] = q_[k * 64]; (QQ)[1][k] = q_[(8 + k) * 64]; } } while (0)
#define M2_LDP(st) do { const bf16x8* p_ = P + (size_t)((st).is_lat ? (st).cp - 2 : 0) * 2048; _Pragma("unroll") for (int k = 0; k < 4; ++k) { pa[0][k] = p_[k * 64]; pa[1][k] = p_[(4 + k) * 64]; } } while (0)
#define M2_LDK(KK, st) do { const bf16x8* k_ = KT + (size_t)(st).cp * 4096; _Pragma("unroll") for (int mt = 0; mt < 4; ++mt) _Pragma("unroll") for (int k = 0; k < 4; ++k) (KK)[mt][k] = k_[(mt * 4 + k) * 64]; } while (0)
    const M2Step s0 = m2_step(dir, b, 0), s1 = m2_step(dir, b, 1);
    if (!roleA) { const f32x4 t0 = *(const f32x4*)(TS + (size_t)(s0.p0 + (tr & 127)) * 4), t1 = *(const f32x4*)(TS + (size_t)(s1.p0 + (tr & 127)) * 4);
        M2_TABLES(0, s0, t0); M2_TABLES(1, s1, t1); }
    __syncthreads();
    if (!roleA) { const u32x4 v0a = *(const u32x4*)(VT + s0.tokrow0), v0b = *(const u32x4*)(VT + (size_t)16 * MTOK + s0.tokrow0); M2_VSTAGE(0, v0a, v0b); }
    if (roleA) {
        bf16x8 qa[2][2][8], pa[2][4];
        M2_LDQ(qa[0], s0); M2_LDP(s0);
        __syncthreads();
        for (int jj = 0; jj < NCHK; jj += 2) {
#pragma unroll
          for (int u = 0; u < 2; ++u) { const int j = jj + u;
            const M2Step sj = m2_step(dir, b, j), sn = m2_step(dir, b, j + 1);
            M2_LDQ(qa[u ^ 1], sn);
            if (j > 0) { const M2Step sp = m2_step(dir, b, j - 1);
                if (sp.is_lat) {
#pragma unroll
                    for (int i2 = 0; i2 < 2; ++i2) { const int pc = tr + 256 * i2; const u32x4 hv = *(const LAS u32x4*)(L + M2_HS + ((j - 1) & 1) * 8192 + pc * 16);
                        *(u32x4*)(H + (size_t)(sp.tl0 + (pc >> 2)) * D + (pc & 3) * 8) = hv; } } }
            if (sj.is_lat) {
                const LAS unsigned char* sCT = L + M2_CT + (j & 1) * M2_CTB; const LAS unsigned char* sVT = L + M2_VT + (j & 1) * M2_VTB;
                const LAS float* tb = (const LAS float*)(L + M2_TAB + (j % 3) * M2_TABB);
                f32x4 aI[2][3], aA[2][2];
#pragma unroll
                for (int mt = 0; mt < 2; ++mt) {
#pragma unroll
                    for (int nt = 0; nt < 3; ++nt) aI[mt][nt] = (f32x4){0.f, 0.f, 0.f, 0.f};
                    aA[mt][0] = (f32x4){0.f, 0.f, 0.f, 0.f}; aA[mt][1] = (f32x4){0.f, 0.f, 0.f, 0.f}; }
                bf16x8 bc[3], bn[3];
#pragma unroll
                for (int nt = 0; nt < 3; ++nt) bc[nt] = *(const LAS bf16x8*)(sCT + (16 * nt + fr) * 544 + (8 * fq) * 2);
#pragma unroll
                for (int k = 0; k < 8; ++k) {
                    if (k < 7) {
#pragma unroll
                        for (int nt = 0; nt < 3; ++nt) bn[nt] = *(const LAS bf16x8*)(sCT + (16 * nt + fr) * 544 + (32 * (k + 1) + 8 * fq) * 2); }
#pragma unroll
                    for (int nt = 0; nt < 3; ++nt) {
                        aI[0][nt] = __builtin_amdgcn_mfma_f32_16x16x32_bf16(qa[u][0][k], bc[nt], aI[0][nt], 0, 0, 0);
                        aI[1][nt] = __builtin_amdgcn_mfma_f32_16x16x32_bf16(qa[u][1][k], bc[nt], aI[1][nt], 0, 0, 0); }
#pragma unroll
                    for (int nt = 0; nt < 3; ++nt) bc[nt] = bn[nt]; }
                { bf16x8 vc[2], vn2[2];
#pragma unroll
                  for (int nt = 0; nt < 2; ++nt) vc[nt] = *(const LAS bf16x8*)(sVT + (16 * nt + fr) * 288 + (8 * fq) * 2);
#pragma unroll
                  for (int k = 0; k < 4; ++k) {
                    if (k < 3) {
#pragma unroll
                        for (int nt = 0; nt < 2; ++nt) vn2[nt] = *(const LAS bf16x8*)(sVT + (16 * nt + fr) * 288 + (32 * (k + 1) + 8 * fq) * 2); }
#pragma unroll
                    for (int nt = 0; nt < 2; ++nt) {
                        aA[0][nt] = __builtin_amdgcn_mfma_f32_16x16x32_bf16(pa[0][k], vc[nt], aA[0][nt], 0, 0, 0);
                        aA[1][nt] = __builtin_amdgcn_mfma_f32_16x16x32_bf16(pa[1][k], vc[nt], aA[1][nt], 0, 0, 0); }
                    vc[0] = vn2[0]; vc[1] = vn2[1]; } }
                M2_LDP(sn);
                LAS unsigned short* sH = (LAS unsigned short*)(L + M2_HS + (j & 1) * 8192);
#pragma unroll
                for (int mt = 0; mt < 2; ++mt)
#pragma unroll
                    for (int rg = 0; rg < 4; ++rg) { const int t = 32 * wa + 16 * mt + 4 * fq + rg;
                        const float qn_ = __shfl(aI[mt][2][rg], lane & 48);
                        const f32x4 tv = *(const LAS f32x4*)(tb + 4 * t);
                        const float inv = __builtin_amdgcn_rcpf(fmaxf(fabsf(tv[0] * qn_ + tv[2]), tv[3]));
                        const unsigned hp = pk2((tv[0] * aI[mt][0][rg] + tv[1] * aA[mt][0][rg]) * inv, (tv[0] * aI[mt][1][rg] + tv[1] * aA[mt][1][rg]) * inv);
                        sH[t * 32 + fr] = (unsigned short)hp; sH[t * 32 + 16 + fr] = (unsigned short)(hp >> 16); }
            } else { M2_LDP(sn); }
            __syncthreads();
          }
        }
        { const M2Step sp = m2_step(dir, b, NCHK - 1);
          if (sp.is_lat) {
#pragma unroll
            for (int i2 = 0; i2 < 2; ++i2) { const int pc = tr + 256 * i2; const u32x4 hv = *(const LAS u32x4*)(L + M2_HS + ((NCHK - 1) & 1) * 8192 + pc * 16);
                *(u32x4*)(H + (size_t)(sp.tl0 + (pc >> 2)) * D + (pc & 3) * 8) = hv; } } }
    } else {
        bf16x8 ka[2][4][4];
        f32x4 accC[4][3];
#pragma unroll
        for (int mt = 0; mt < 4; ++mt)
#pragma unroll
            for (int nt = 0; nt < 3; ++nt) accC[mt][nt] = (f32x4){0.f, 0.f, 0.f, 0.f};
        M2_LDK(ka[0], s0);
        u32x4 vna = *(const u32x4*)(VT + s1.tokrow0), vnb = *(const u32x4*)(VT + (size_t)16 * MTOK + s1.tokrow0);
        f32x4 tn2 = *(const f32x4*)(TS + (size_t)(m2_step(dir, b, 2).p0 + (tr & 127)) * 4);
        __syncthreads();
        for (int jj = 0; jj < NCHK; jj += 2) {
#pragma unroll
          for (int u = 0; u < 2; ++u) { const int j = jj + u;
            const M2Step sn = m2_step(dir, b, j + 1), sn2 = m2_step(dir, b, j + 2);
            M2_LDK(ka[u ^ 1], sn);
            const LAS unsigned char* sVW = L + M2_VW + (j & 1) * M2_VWB; const float dec = sdec[j];
            const u32x4 vxa = *(const u32x4*)(VT + sn2.tokrow0), vxb = *(const u32x4*)(VT + (size_t)16 * MTOK + sn2.tokrow0);
            const f32x4 tn3 = *(const f32x4*)(TS + (size_t)(m2_step(dir, b, j + 3).p0 + (tr & 127)) * 4);
#pragma unroll
            for (int mt = 0; mt < 4; ++mt)
#pragma unroll
                for (int nt = 0; nt < 3; ++nt) accC[mt][nt] = accC[mt][nt] * dec;
            { bf16x8 wc[3], wn[3];
#pragma unroll
              for (int nt = 0; nt < 3; ++nt) wc[nt] = *(const LAS bf16x8*)(sVW + (16 * nt + fr) * 288 + (8 * fq) * 2);
#pragma unroll
              for (int k = 0; k < 4; ++k) {
                if (k < 3) {
#pragma unroll
                    for (int nt = 0; nt < 3; ++nt) wn[nt] = *(const LAS bf16x8*)(sVW + (16 * nt + fr) * 288 + (32 * (k + 1) + 8 * fq) * 2); }
#pragma unroll
                for (int nt = 0; nt < 3; ++nt)
#pragma unroll
                    for (int mt = 0; mt < 4; ++mt) accC[mt][nt] = __builtin_amdgcn_mfma_f32_16x16x32_bf16(ka[u][mt][k], wc[nt], accC[mt][nt], 0, 0, 0);
#pragma unroll
                for (int nt = 0; nt < 3; ++nt) wc[nt] = wn[nt]; } }
            { LAS unsigned char* dCT = L + M2_CT + ((j + 1) & 1) * M2_CTB;
#pragma unroll
              for (int mt = 0; mt < 4; ++mt)
#pragma unroll
                for (int nt = 0; nt < 3; ++nt) { u32x2 o; o.x = pk2(accC[mt][nt][0], accC[mt][nt][1]); o.y = pk2(accC[mt][nt][2], accC[mt][nt][3]);
                    *(LAS u32x2*)(dCT + (16 * nt + fr) * 544 + (64 * wa + 16 * mt + 4 * fq) * 2) = o; } }
            M2_VSTAGE(j + 1, vna, vnb);
            M2_TABLES(j + 2, sn2, tn2);
            vna = vxa; vnb = vxb; tn2 = tn3;
            __syncthreads();
          }
        }
    }
    __syncthreads();
#undef M2_LDQ
#undef M2_LDP
#undef M2_LDK
#undef M2_TABLES
#undef M2_VSTAGE
}

#define XB_TMO      128
#define XB_XCNT(j)  (256  + 64 * (j))
#define XB_XSUB(j)  (1280 + 64 * (j))
#define XB_XGEN(j)  (2304 + 64 * (j))
#define XB_TOP      3328
#define XB_TOPGEN   3392
#define XB_SPIN_CAP (1u << 22)
__device__ __forceinline__ unsigned xb_ld(unsigned* p)              { return __hip_atomic_load(p, __ATOMIC_RELAXED, __HIP_MEMORY_SCOPE_AGENT); }
__device__ __forceinline__ unsigned xb_add(unsigned* p, unsigned v) { return __hip_atomic_fetch_add(p, v, __ATOMIC_RELAXED, __HIP_MEMORY_SCOPE_AGENT); }
__device__ __forceinline__ unsigned xb_xcc_id() { return (unsigned)__builtin_amdgcn_s_getreg((3 << 11) | 20) & 0xFu; }
#define XB_SPIN(cond, bar) do { unsigned _sp = 0; while (cond) { __builtin_amdgcn_s_sleep(1); \
    if ((++_sp & 255u) == 0u) { if (xb_ld(&(bar)[XB_TMO])) break; if (_sp > XB_SPIN_CAP) { atomicAdd(&(bar)[XB_TMO], 1u); break; } } } } while (0)
struct XcdBarrier { unsigned* bar; unsigned x; volatile LAS unsigned* st; };
__device__ __forceinline__ XcdBarrier xcd_barrier_post(unsigned* bar, volatile LAS unsigned* st) {
    XcdBarrier b; b.bar = bar; b.x = xb_xcc_id(); b.st = st;
    if (threadIdx.x == 0) (void)xb_add(&bar[XB_XCNT(b.x)], 1u);
    return b;
}
__device__ __forceinline__ void xcd_barrier_complete(unsigned* bar, unsigned x, unsigned& nloc, unsigned& nx) {
    const unsigned G = gridDim.x * gridDim.y * gridDim.z;
    unsigned sum, cnt, mine, sp = 0u;
    for (;;) {
        sum = 0u; cnt = 0u; mine = 0u;
#pragma unroll
        for (unsigned j = 0; j < 16; ++j) { const unsigned c = xb_ld(&bar[XB_XCNT(j)]); sum += c; cnt += (c > 0u) ? 1u : 0u; mine = (j == x) ? c : mine; }
        if (sum == G) break;
        __builtin_amdgcn_s_sleep(1);
        if ((++sp & 255u) == 0u) { if (xb_ld(&bar[XB_TMO])) break; if (sp > XB_SPIN_CAP) { atomicAdd(&bar[XB_TMO], 1u); break; } }
    }
    nloc = mine > 0u ? mine : 1u; nx = cnt > 0u ? cnt : 1u;
}
__device__ __forceinline__ void xcd_barrier(const XcdBarrier& b) {
    asm volatile("s_waitcnt vmcnt(0)" ::: "memory");
    __syncthreads();
    if (threadIdx.x == 0) {
        unsigned* bar = b.bar;
        __builtin_amdgcn_s_waitcnt(0);
        unsigned nloc = b.st[0], nx = b.st[1];
        if (nloc == 0u) { xcd_barrier_complete(bar, b.x, nloc, nx); b.st[0] = nloc; b.st[1] = nx; }
        const unsigned old = xb_add(&bar[XB_XSUB(b.x)], 1u);
        const unsigned gen = old / nloc;
        if (old + 1u == (gen + 1u) * nloc) {
            __builtin_amdgcn_fence(__ATOMIC_RELEASE, "agent");
            asm volatile("s_waitcnt vmcnt(0)" ::: "memory");
            const unsigned og = xb_add(&bar[XB_TOP], 1u);
            const unsigned tg = og / nx;
            if (og + 1u == (tg + 1u) * nx) xb_add(&bar[XB_TOPGEN], 1u);
            else XB_SPIN(xb_ld(&bar[XB_TOPGEN]) == tg, bar);
            __builtin_amdgcn_fence(__ATOMIC_ACQUIRE, "agent");
            xb_add(&bar[XB_XGEN(b.x)], 1u);
            asm volatile("s_waitcnt vmcnt(0)" ::: "memory");
        } else {
            XB_SPIN(xb_ld(&bar[XB_XGEN(b.x)]) == gen, bar);
            __builtin_amdgcn_fence(__ATOMIC_ACQUIRE, "agent");
            asm volatile("s_waitcnt vmcnt(0)" ::: "memory");
        }
    }
    __syncthreads();
}

__device__ __forceinline__ pg8::Seg mkseg(const void* A0, const void* B0, int nM, int nN, int kind, int ksplit = 1) { pg8::Seg s; s.A0 = (const char*)A0; s.B0 = (const char*)B0; s.nM = nM; s.nN = nN; s.kind = kind; s.ksplit = ksplit; return s; }
__device__ __forceinline__ pg8::Sched mksched(int K) { pg8::Sched S; S.s[0] = S.s[1] = S.s[2] = S.s[3] = mkseg(nullptr, nullptr, 0, 0, 0); S.G = gridDim.x; S.c = blockIdx.x; S.tstep = (size_t)256 * K * 2; S.ntk = K / 64; return S; }

__global__ void __launch_bounds__(NTHR) mega_fwd(Params p) {
    extern __shared__ __attribute__((aligned(16))) unsigned char lds_raw[];
    Frame F;
#define REFRAME() do { int t_ = threadIdx.x; asm volatile("" : "+v"(t_)); F.lds = (LAS unsigned char*)lds_raw; F.tid = t_; F.lane = t_ & 63; F.wave = __builtin_amdgcn_readfirstlane(t_ >> 6); \
        F.gw = blockIdx.x * NWAVE + F.wave; F.ngw = gridDim.x * NWAVE; } while (0)
    REFRAME();
    unsigned char* ws = p.ws; unsigned char* dout = (unsigned char*)p.out;
    volatile LAS unsigned* bst = (volatile LAS unsigned*)(F.lds + LDS_BYTES - 16);
    if (F.tid < 4) bst[F.tid] = 0u;
    __syncthreads();
    const XcdBarrier gbar = xcd_barrier_post((unsigned*)(ws + WS_BAR), bst);
#define GSYNC() do { xcd_barrier(gbar); REFRAME(); } while (0)

    ada_phase(F, p);
    wfour_phase(F, p);
    {
        constexpr int I13 = 16 * 176, I2 = 44 * 32, IIN = 16 * (WIN_ROWS / 32), ISQ = 16 * 32;
        Frame F2 = F; const bool extra = gridDim.x == 256 && blockIdx.x >= 144; F2.gw = (blockIdx.x - 144) * NWAVE + F.wave; F2.ngw = 112 * NWAVE;
#define CONV_SPLIT(CALL_A, CALL_B) do { CALL_A; if (gridDim.x != 256) { Frame F2 = F; CALL_B; } else if (extra) { CALL_B; } } while (0)
        { constexpr int A = I13 * 55 / 100; CONV_SPLIT(conv_w13(F, p.w13_a, (bf16*)(ws + WS_W13), 0, A), conv_w13(F2, p.w13_a, (bf16*)(ws + WS_W13), A, I13 - A)); }
        { constexpr int A = I2 * 55 / 100; CONV_SPLIT(conv_plain(F, p.w2_a, FF, D, (bf16*)(ws + WS_W2), 0, A), conv_plain(F2, p.w2_a, FF, D, (bf16*)(ws + WS_W2), A, I2 - A)); }
        { constexpr int A = IIN * 55 / 100; CONV_SPLIT(conv_win(F, p.w_in, (bf16*)(ws + WS_WIN), 0, A), conv_win(F2, p.w_in, (bf16*)(ws + WS_WIN), A, IIN - A)); }
        { constexpr int A = ISQ * 55 / 100; CONV_SPLIT(conv_plain(F, p.w_mproj, D, D, (bf16*)(ws + WS_WMPROJ), 0, A), conv_plain(F2, p.w_mproj, D, D, (bf16*)(ws + WS_WMPROJ), A, ISQ - A));
          CONV_SPLIT(conv_plain(F, p.w_out, D, D, (bf16*)(ws + WS_WOUT), 0, A), conv_plain(F2, p.w_out, D, D, (bf16*)(ws + WS_WOUT), A, ISQ - A)); }
#undef CONV_SPLIT
        { LAS float* scr = (LAS float*)(F.lds + F.wave * 16384);
          for (int it = F.gw; it < 16; it += F.ngw) transpose_item(p.w_in, D, INW, (bf16*)(ws + WS_WG), 0, COL_GATES, 64 * it, scr, F.lane);
          u32x4* z = (u32x4*)(ws + WS_WG + 32 * D * 2); for (int i = blockIdx.x * NTHR + F.tid; i < 224 * D * 2 / 16; i += gridDim.x * NTHR) z[i] = (u32x4){0u, 0u, 0u, 0u}; }
    }
    GSYNC();
    phase_u1(F, p);
    GSYNC();
    { pg8::Sched S = mksched(D); S.s[0] = mkseg(ws + WS_U, ws + WS_W13, MTOK / 256, 22, 0); EpiSwiglu E{(bf16*)(ws + WS_ACT)}; pg8::gemm_phase(F.lds, D, S, E); }
    GSYNC();
    { pg8::Sched S = mksched(FF); S.s[0] = mkseg(ws + WS_ACT, ws + WS_W2, TLAT / 256, 4, 0); S.s[1] = mkseg(ws + WS_ACT + (size_t)TLAT * FF * 2, ws + WS_W2, TCTX / 256, 4, 1, 8);
      EpiDownA E{(bf16*)(ws + WS_Y1), (float*)(ws + WS_Y1C)}; pg8::gemm_phase(F.lds, FF, S, E); }
    GSYNC();
    phase_post_ffn_a(F, p);
    GSYNC();
    { pg8::Sched S = mksched(D); const unsigned char* W = ws + WS_WIN;
      S.s[0] = mkseg(ws + WS_U2, W + (size_t)ROW_Q * D * 2, MTOK / 256, 8, 0);
      S.s[1] = mkseg(W + (size_t)ROW_V * D * 2, ws + WS_U2, 4, MTOK / 256, 2);
      S.s[2] = mkseg(W + (size_t)ROW_F * D * 2, ws + WS_U2, 2, TLAT / 256, 3);
      S.s[3] = mkseg(ws + WS_U2, ws + WS_WG, MTOK / 256, 1, 4);
      EpiProjA E{(bf16*)(ws + WS_QPRE), (bf16*)(ws + WS_KPRE), (bf16*)(ws + WS_VT), (bf16*)(ws + WS_XFT), p.b_in, (float*)(ws + WS_GATES)}; pg8::gemm_phase(F.lds, D, S, E); }
    GSYNC();
    for (int it = blockIdx.x; it < 16 * NCHK; it += gridDim.x) { if (it < 512) m1_item(F, p, it & 15, 2 + (it >> 4)); else m1_item(F, p, (it - 512) & 15, (it - 512) >> 4); }
    GSYNC();
    for (int sid = blockIdx.x; sid < 256; sid += gridDim.x) m2_stream(F, p, sid);
    GSYNC();
    for (int it = blockIdx.x; it < 256; it += gridDim.x) fourier_item(F, p, it);
    { constexpr int I13 = 16 * 176, I2 = 44 * 32; conv_w13(F, p.w13_b, (bf16*)(ws + WS_W13B), 0, I13); conv_plain(F, p.w2_b, FF, D, (bf16*)(ws + WS_W2B), 0, I2); }
    GSYNC();
    { pg8::Sched S = mksched(D); const pg8::Seg so = mkseg(ws + WS_U2, ws + WS_WIN + (size_t)ROW_O * D * 2, TLAT / 256, 4, 0), sf = mkseg(ws + WS_UF, ws + WS_WFOUR, TLAT / 256, 4, 1);
      const bool swp = gridDim.x == 256 && ((blockIdx.x >> 3) & 1);
      S.s[0] = swp ? sf : so; S.s[1] = swp ? so : sf;
      EpiX E{(bf16*)(ws + WS_HM), (bf16*)(dout + DO_TF), (const bf16*)(ws + WS_HF), (const bf16*)(ws + WS_HB), p.b_in, p.head_g, (LAS float*)(F.lds + pg8::STAGE_BYTES)}; pg8::gemm_phase(F.lds, D, S, E); }
    GSYNC();
    if (gridDim.x == 256) {
      pg8::SchedY S; S.base = mksched(D); S.base.s[0] = mkseg(ws + WS_HM, ws + WS_WMPROJ, TLAT / 256, 4, 1); S.Ag = (const char*)(ws + WS_U2); S.Bg = (const char*)(ws + WS_WIN + (size_t)ROW_GF * D * 2);
      EpiY E{(bf16*)(dout + DO_TF), (bf16*)(ws + WS_TM), p.b_in}; pg8::gemm_phase(F.lds, D, S, E);
    } else {
      { pg8::Sched S = mksched(D); S.s[0] = mkseg(ws + WS_HM, ws + WS_WMPROJ, TLAT / 256, 4, 1); EpiY E{(bf16*)(dout + DO_TF), (bf16*)(ws + WS_TM), p.b_in}; pg8::gemm_phase(F.lds, D, S, E); }
      GSYNC();
      { pg8::Sched S = mksched(D); S.s[0] = mkseg(ws + WS_U2, ws + WS_WIN + (size_t)ROW_GF * D * 2, TLAT / 256, 8, 0); EpiY E{(bf16*)(dout + DO_TF), (bf16*)(ws + WS_TM), p.b_in}; pg8::gemm_phase(F.lds, D, S, E); }
    }
    GSYNC();
    { pg8::Sched S = mksched(D); S.s[0] = mkseg(ws + WS_TM, ws + WS_WOUT, TLAT / 256, 4, 0);
      float* xb = (float*)(ws + WS_XCH); unsigned* xc = (unsigned*)(ws + WS_XCNT);
      EpiMix E{p.x, p.norm_g + 3 * D, p.norm_g + 4 * D, (const float*)(ws + WS_MOD), (const bf16*)(dout + DO_D1), (bf16*)(ws + WS_D12), (bf16*)(dout + DO_U3),
               PanelRms{xb, xc}, PanelRms{xb + 65536, xc + 64 * 64}, (LAS float*)(F.lds + pg8::STAGE_BYTES)};
      if (gridDim.x == 256) pg8::gemm_phase(F.lds, D, S, E); }
    GSYNC();
    { pg8::Sched S = mksched(D); S.s[0] = mkseg(dout + DO_U3, ws + WS_W13B, TLAT / 256, 22, 0); EpiSwiglu E{(bf16*)(ws + WS_ACT2)}; pg8::gemm_phase(F.lds, D, S, E); }
    GSYNC();
    { pg8::Sched S = mksched(FF); S.s[0] = mkseg(ws + WS_ACT2, ws + WS_W2B, TLAT / 256, 4, 0);
      EpiFinal E{p.x, p.norm_g + 5 * D, (const float*)(ws + WS_MOD), (const bf16*)(ws + WS_D12), p.out, PanelRms{(float*)(ws + WS_XCH) + 2 * 65536, (unsigned*)(ws + WS_XCNT) + 2 * 64 * 64}, (LAS float*)(F.lds + pg8::STAGE_BYTES)};
      if (gridDim.x == 256) pg8::gemm_phase(F.lds, FF, S, E); }
}

extern "C" void kernel_launch(void* const* d_in, const int* in_sizes, int n_in, void* d_out, int out_size, void* d_ws, size_t ws_size, hipStream_t stream) {
    static int grid = 0;
    if (grid == 0) {
        if (n_in != 19 || out_size != TLAT * D || ws_size < WS_NEED) { fprintf(stderr, "kernel_launch: unexpected problem (n_in %d, out %d, ws %zu)\n", n_in, out_size, ws_size); grid = -1; return; }
        int dev = 0, cus = 0, per_cu = 0;
        if (hipGetDevice(&dev) != hipSuccess || hipDeviceGetAttribute(&cus, hipDeviceAttributeMultiprocessorCount, dev) != hipSuccess) { grid = -1; return; }
        if (hipFuncSetAttribute((const void*)mega_fwd, hipFuncAttributeMaxDynamicSharedMemorySize, LDS_BYTES) != hipSuccess) { fprintf(stderr, "kernel_launch: hipFuncSetAttribute failed\n"); grid = -1; return; }
        if (hipOccupancyMaxActiveBlocksPerMultiprocessor(&per_cu, (const void*)mega_fwd, NTHR, LDS_BYTES) != hipSuccess || per_cu < 1) { fprintf(stderr, "kernel_launch: occupancy query failed (%d)\n", per_cu); (void)hipGetLastError(); grid = -1; return; }
        grid = cus * 1;
        if (grid != 256) fprintf(stderr, "kernel_launch: built for a 256-CU device (fused norm epilogues need one 256x256 unit per workgroup); got %d\n", grid);
        fprintf(stderr, "kernel_launch: %d CUs, %d blocks/CU by the occupancy query, grid %d\n", cus, per_cu, grid);
    }
    if (grid < 0) return;
    Params p{};
    const float** f = (const float**)&p;
    for (int i = 0; i < 19; ++i) f[i] = (const float*)d_in[i];
    p.out = (float*)d_out; p.ws = (unsigned char*)d_ws;
    (void)hipMemsetAsync((char*)d_ws + WS_BAR, 0, 64 * 1024, stream);
    void* args[] = {&p};
    hipError_t e = hipLaunchCooperativeKernel((const void*)mega_fwd, dim3(grid), dim3(NTHR), args, LDS_BYTES, stream);
    if (e != hipSuccess) fprintf(stderr, "kernel_launch: cooperative launch failed: %s (grid %d)\n", hipGetErrorString(e), grid);
}
```

```cpp
#include <hip/hip_runtime.h>
#include <hip/hip_cooperative_groups.h>
#include <cstdio>
#include <cstdint>
namespace cg = cooperative_groups;

#define LAS __attribute__((address_space(3)))
typedef unsigned short bf16;
typedef short bf16x8 __attribute__((ext_vector_type(8)));
typedef float f32x4 __attribute__((ext_vector_type(4)));
typedef float f32x2 __attribute__((ext_vector_type(2)));
typedef unsigned u32x4 __attribute__((ext_vector_type(4)));
typedef unsigned u32x2 __attribute__((ext_vector_type(2)));

constexpr int D = 1024, NB = 4, SEQ = 4096, CTXL = 256, FF = 2816, NH = 4, DH = 256, CH = 128;
constexpr int TLAT = NB * SEQ;
constexpr int TCTX = NB * CTXL;
constexpr int MTOK = TLAT + TCTX;
constexpr int INW = 6672;
constexpr int PLEN = CTXL + SEQ;
constexpr int NCHK = PLEN / CH;
constexpr float EPS = 1e-6f;
constexpr int NTHR = 512, NWAVE = 8;
constexpr int LDS_BYTES = 147456;

constexpr size_t MiB = 1u << 20;
constexpr size_t WS_MOD = 0;
constexpr size_t WS_BAR = 256 * 1024;
constexpr size_t WS_GATES = 512 * 1024;
constexpr size_t WS_TOKSC = 2 * MiB;
constexpr size_t WS_CHSC = 5 * MiB;
constexpr size_t WS_WG = 7 * MiB;
constexpr size_t WS_XCH = 6 * MiB;
constexpr size_t WS_XCNT = WS_BAR + 16 * 1024;
constexpr size_t WS_W13 = 8 * MiB, WS_W2 = 19 * MiB, WS_WIN = 25 * MiB, WS_WFOUR = 38 * MiB, WS_WMPROJ = 40 * MiB, WS_WOUT = 42 * MiB;
constexpr size_t WS_XFT = 8 * MiB;
constexpr size_t WS_U = 44 * MiB;
constexpr size_t WS_U2 = 210 * MiB;
constexpr size_t WS_ACT = 78 * MiB;
constexpr size_t WS_Y1 = 172 * MiB;
constexpr size_t WS_Y1C = 44 * MiB;
constexpr size_t WS_QPRE = 78 * MiB;
constexpr size_t WS_KPRE = 110 * MiB;
constexpr size_t WS_VT = 144 * MiB;
constexpr size_t WS_Q = 178 * MiB;
constexpr size_t WS_UF = 142 * MiB;
constexpr size_t WS_KT = 44 * MiB;
constexpr size_t WS_HF = 78 * MiB, WS_HB = 110 * MiB;
constexpr size_t WS_HM = 174 * MiB;
constexpr size_t DO_TF = 32 * MiB;
constexpr size_t WS_W13B = 44 * MiB, WS_W2B = 55 * MiB;
constexpr size_t WS_TM = 78 * MiB;
constexpr size_t WS_OUTL = 110 * MiB;
constexpr size_t WS_D12 = 110 * MiB;
constexpr size_t WS_ACT2 = 142 * MiB;
constexpr size_t WS_Y3 = 164 * MiB;
constexpr size_t WS_NEED = 256 * MiB;
constexpr size_t DO_D1 = 0, DO_P = 32 * MiB, DO_U3 = 32 * MiB;

constexpr int COL_F = 0, COL_Q = 512, COL_K = 1536, COL_V = 2560, COL_O = 3584, COL_GATES = 4608, COL_GF = 4624, COL_GM = 5648;
constexpr int ROW_Q = 0, ROW_K = 1024, ROW_V = 2048, ROW_F = 3072, ROW_O = 3584, ROW_GF = 4608, ROW_GM = 5632, WIN_ROWS = 6656;

struct Params {
    const float *x, *c, *ctx, *c_ctx, *w_ada, *b_ada, *norm_g, *w13_a, *w2_a, *w_in, *b_in, *conv_w, *conv_b, *head_g, *w_four, *w_mproj, *w_out, *w13_b, *w2_b;
    float* out; unsigned char* ws;
};

typedef __bf16 bf16x2_t __attribute__((ext_vector_type(2)));
__device__ __forceinline__ unsigned f2bf(float f) { return (unsigned)__builtin_bit_cast(unsigned short, (__bf16)f); }
__device__ __forceinline__ unsigned pk2(float lo, float hi) { bf16x2_t v; v[0] = (__bf16)lo; v[1] = (__bf16)hi; return __builtin_bit_cast(unsigned, v); }
__device__ __forceinline__ float bf2f(unsigned b) { return __builtin_bit_cast(float, b << 16); }
__device__ __forceinline__ float bflo(unsigned w) { return __builtin_bit_cast(float, w << 16); }
__device__ __forceinline__ float bfhi(unsigned w) { return __builtin_bit_cast(float, w & 0xffff0000u); }
__device__ __forceinline__ unsigned cvt_pk_bf16(float lo, float hi) { return pk2(lo, hi); }
#define DPP_F(v, ctrl) __builtin_bit_cast(float, __builtin_amdgcn_update_dpp(0, __builtin_bit_cast(int, (v)), (ctrl), 0xf, 0xf, false))
__device__ __forceinline__ float row16_sum(float v) {
    v += DPP_F(v, 0xB1);
    v += DPP_F(v, 0x4E);
    v += DPP_F(v, 0x141);
    v += DPP_F(v, 0x140);
    return v;
}
__device__ __forceinline__ float rlane(float v, int l) { return __builtin_bit_cast(float, __builtin_amdgcn_readlane(__builtin_bit_cast(int, v), l)); }
__device__ __forceinline__ float wave_sum(float v) { v = row16_sum(v); return (rlane(v, 0) + rlane(v, 16)) + (rlane(v, 32) + rlane(v, 48)); }
__device__ __forceinline__ float sigmoidf_(float x) { return __builtin_amdgcn_rcpf(1.0f + __expf(-x)); }
__device__ __forceinline__ float siluf_(float x) { return x * __builtin_amdgcn_rcpf(1.0f + __expf(-x)); }
#define LDS_WAIT() asm volatile("s_waitcnt lgkmcnt(0)" ::: "memory")
#define VM_WAIT() asm volatile("s_waitcnt vmcnt(0)" ::: "memory")

namespace pg8 {
constexpr int BM = 256, BK = 64, HALF = 128, HTB = HALF * BK * 2, STAGE_BYTES = 8 * HTB, NXCD = 8, WGM = 8;
__host__ __device__ __forceinline__ int lds_byte(int r, int c) { const int st = (r >> 4) * 2 + (c >> 5), rr = r & 15, cc = c & 31, ob = rr * 64 + cc * 2; return st * 1024 + (ob ^ (((ob >> 9) & 1) << 5)); }
__host__ __device__ __forceinline__ void stage_rc(int b, int& R, int& C) { const int st = b / 1024, sb = b % 1024, swz = sb ^ (((sb >> 9) & 1) << 5); R = (st >> 1) * 16 + swz / 64; C = (st & 1) * 32 + (swz % 64) / 2; }
__host__ __device__ __forceinline__ int perm32(int rho) { const int n = rho >> 4, i = rho & 15; return 8 * (i >> 2) + 4 * n + (i & 3); }

struct Unit { const char* A; const char* B; int kind, pm, pn, nt, kq; };
struct Seg { const char* A0; const char* B0; int nM, nN, kind, ksplit; };
struct Sched {
    Seg s[4]; int G, c; size_t tstep;
    int ntk;
    __device__ __forceinline__ bool pick(const Seg& sg, long& L, Unit& u) const {
        const int nwg = sg.nM * sg.nN * sg.ksplit;
        if (L >= nwg) { L -= nwg; return false; }
        if (sg.ksplit > 1) { const int tiles = sg.nM * sg.nN, kq = (int)L / tiles, tl = (int)L % tiles; u.pm = tl % sg.nM; u.pn = tl / sg.nM; u.kind = sg.kind;
            const int kt0 = kq * 6 - (kq > 6 ? 2 : 0); u.nt = kq < 6 ? 6 : 4; u.kq = kq;
            u.A = sg.A0 + (size_t)u.pm * tstep + kt0 * 128; u.B = sg.B0 + (size_t)u.pn * tstep + kt0 * 128; return true; }
        u.nt = ntk; u.kq = 0;
        int wgid = (int)L; { const int q = nwg / NXCD, r = nwg % NXCD, xcd = wgid % NXCD, off = wgid / NXCD; wgid = (xcd < r ? xcd * (q + 1) : r * (q + 1) + (xcd - r) * q) + off; }
        const int nig = WGM * sg.nN, gid = wgid / nig, fm = gid * WGM, gsz = (sg.nM - fm) < WGM ? (sg.nM - fm) : WGM;
        u.pm = fm + ((wgid % nig) % gsz); u.pn = (wgid % nig) / gsz; u.kind = sg.kind;
        u.A = sg.A0 + (size_t)u.pm * tstep; u.B = sg.B0 + (size_t)u.pn * tstep; return true;
    }
    __device__ __forceinline__ bool next(int i, Unit& u) const {
        long L = (long)i * G + c;
        if (pick(s[0], L, u)) return true;
        if (pick(s[1], L, u)) return true;
        if (pick(s[2], L, u)) return true;
        if (pick(s[3], L, u)) return true;
        return false;
    }
};

struct SchedY {
    Sched base; const char* Ag; const char* Bg;
    __device__ __forceinline__ bool next(int i, Unit& u) const {
        if (i > 3) return false;
        long L = base.c; Unit t;
        if (i == 0) { base.pick(base.s[1], L, t); u = t; return true; }
        base.pick(base.s[0], L, t);
        if (i == 1) { u = t; return true; }
        u.kind = 0; u.pm = t.pm; u.pn = 2 * t.pn + (i - 2); u.nt = base.ntk; u.kq = 0;
        u.A = Ag + (size_t)u.pm * base.tstep; u.B = Bg + (size_t)u.pn * base.tstep; return true;
    }
};
template <class Epi, class SchedT>
__device__ __forceinline__ void gemm_phase(LAS unsigned char* lds, const int K, const SchedT& S, const Epi& E) {
    int tid_ = threadIdx.x; asm volatile("" : "+v"(tid_));
    const int tid = tid_, wid = __builtin_amdgcn_readfirstlane(tid >> 6), lane = tid & 63, wr = wid >> 2, wc = wid & 3, fr = lane & 15, fq = lane >> 4;
    unsigned voffA[2], voffB[2];
#pragma unroll
    for (int i = 0; i < 2; ++i) { int R, C; stage_rc(tid * 16 + i * 8192, R, C); const int Rb = (R & ~31) + perm32(R & 31);
        voffA[i] = (unsigned)(R * K + C) * 2u; voffB[i] = (unsigned)(Rb * K + C) * 2u; }
    const size_t kstep = (size_t)(BK * 2);
    const size_t hstep = (size_t)HALF * K * 2;
    const unsigned ldsw = (unsigned)wid * 1024u;
    const int aoff = lds_byte(wr * 64 + fr, fq * 8), boff = lds_byte(wc * 32 + fr, fq * 8);
#define PG8_SA(b, h) (((b) * 2 + (h)) * HTB)
#define PG8_SB(b, h) ((4 + (b) * 2 + (h)) * HTB)
#define PG8_STAGE(bufoff, gbase, voff) do { _Pragma("unroll") for (int _i = 0; _i < 2; ++_i) \
        __builtin_amdgcn_global_load_lds((const unsigned*)((const char*)(gbase) + (voff)[_i]), (LAS unsigned*)(lds + (bufoff) + ldsw + _i * 8192), 16, 0, 0); } while (0)
#define PG8_LDA(dst, b, h) do { _Pragma("unroll") for (int m = 0; m < 4; ++m) _Pragma("unroll") for (int k = 0; k < 2; ++k) dst[m][k] = *(const LAS bf16x8*)(lds + PG8_SA(b, h) + aoff + m * 2048 + k * 1024); } while (0)
#define PG8_LDB(dst, b, h) do { _Pragma("unroll") for (int n = 0; n < 2; ++n) _Pragma("unroll") for (int k = 0; k < 2; ++k) dst[n][k] = *(const LAS bf16x8*)(lds + PG8_SB(b, h) + boff + n * 2048 + k * 1024); } while (0)
#define PG8_MMA(ai, bj, At, Bt) do { __builtin_amdgcn_s_setprio(1); _Pragma("unroll") for (int m = 0; m < 4; ++m) _Pragma("unroll") for (int n = 0; n < 2; ++n) _Pragma("unroll") for (int k = 0; k < 2; ++k) \
        acc[ai][bj][m][n] = __builtin_amdgcn_mfma_f32_16x16x32_bf16(Bt[n][k], At[m][k], acc[ai][bj][m][n], 0, 0, 0); __builtin_amdgcn_s_setprio(0); } while (0)
#define PG8_WAIT_V(n) asm volatile("s_waitcnt vmcnt(" #n ")" ::: "memory")
#define PG8_WAIT_L(n) asm volatile("s_waitcnt lgkmcnt(" #n ")" ::: "memory")
#define PG8_BAR __builtin_amdgcn_s_barrier()
#define PG8_SCHED __builtin_amdgcn_sched_barrier(0)
    Unit cur, nxt; int ui = 0;
    if (!S.next(0, cur)) return;
    f32x4 acc[2][2][4][2];
#pragma unroll
    for (int a = 0; a < 2; ++a)
#pragma unroll
        for (int b = 0; b < 2; ++b)
#pragma unroll
            for (int m = 0; m < 4; ++m)
#pragma unroll
                for (int n = 0; n < 2; ++n) acc[a][b][m][n] = (f32x4){0.f, 0.f, 0.f, 0.f};
    bf16x8 At[4][2], B0[2][2], B1[2][2];
    const char* cA = cur.A; const char* cB = cur.B;
    PG8_STAGE(PG8_SB(0, 0), cB, voffB); PG8_STAGE(PG8_SB(0, 1), cB + hstep, voffB); PG8_STAGE(PG8_SA(0, 0), cA, voffA); PG8_STAGE(PG8_SA(0, 1), cA + hstep, voffA);
    if (wr == 1) PG8_BAR;
    PG8_WAIT_V(2); PG8_BAR;
    PG8_STAGE(PG8_SB(1, 0), cB + kstep, voffB); PG8_STAGE(PG8_SA(1, 0), cA + kstep, voffA); PG8_STAGE(PG8_SB(1, 1), cB + hstep + kstep, voffB);
    PG8_WAIT_V(6); PG8_BAR;
    for (;;) {
        const bool has_next = S.next(ui + 1, nxt);
        const char* nA = has_next ? nxt.A : cA; const char* nB = has_next ? nxt.B : cB;
        const int nt = cur.nt;
        for (int t = 0; t < nt; t += 2) {
            const bool last = (t == nt - 2);
            const char* a1 = cA + (size_t)(t + 1) * kstep;
            const char* a2 = last ? nA : cA + (size_t)(t + 2) * kstep; const char* b2 = last ? nB : cB + (size_t)(t + 2) * kstep;
            const char* a3 = a2 + kstep; const char* b3 = b2 + kstep;
            PG8_LDB(B0, 0, 0); PG8_LDB(B1, 0, 1); PG8_SCHED; PG8_LDA(At, 0, 0); PG8_STAGE(PG8_SA(1, 1), a1 + hstep, voffA);
            PG8_WAIT_V(8); PG8_WAIT_L(0); PG8_BAR; PG8_MMA(0, 0, At, B0); PG8_MMA(0, 1, At, B1); PG8_BAR; PG8_SCHED;
            PG8_LDA(At, 0, 1); PG8_STAGE(PG8_SB(0, 0), b2, voffB); PG8_STAGE(PG8_SB(0, 1), b2 + hstep, voffB); PG8_STAGE(PG8_SA(0, 0), a2, voffA);
            PG8_WAIT_V(8); PG8_WAIT_L(0); PG8_BAR; PG8_MMA(1, 0, At, B0); PG8_MMA(1, 1, At, B1); PG8_BAR; PG8_SCHED;
            PG8_LDB(B0, 1, 0); PG8_LDB(B1, 1, 1); PG8_SCHED; PG8_LDA(At, 1, 0); PG8_STAGE(PG8_SA(0, 1), a2 + hstep, voffA);
            PG8_WAIT_V(8); PG8_WAIT_L(0); PG8_BAR; PG8_MMA(0, 0, At, B0); PG8_MMA(0, 1, At, B1); PG8_BAR; PG8_SCHED;
            PG8_LDA(At, 1, 1); PG8_STAGE(PG8_SB(1, 0), b3, voffB); PG8_STAGE(PG8_SB(1, 1), b3 + hstep, voffB); PG8_STAGE(PG8_SA(1, 0), a3, voffA);
            PG8_WAIT_V(8); PG8_WAIT_L(0); PG8_BAR; PG8_MMA(1, 0, At, B0); PG8_MMA(1, 1, At, B1); PG8_BAR; PG8_SCHED;
        }
        if (wr == 0) PG8_BAR;
        { int fr2 = fr, fq2 = fq; asm volatile("" : "+v"(fr2), "+v"(fq2));
          E(acc, cur, wr, wc, fr2, fq2); }
        if (!has_next) break;
#pragma unroll
        for (int a = 0; a < 2; ++a)
#pragma unroll
            for (int b = 0; b < 2; ++b)
#pragma unroll
                for (int m = 0; m < 4; ++m)
#pragma unroll
                    for (int n = 0; n < 2; ++n) acc[a][b][m][n] = (f32x4){0.f, 0.f, 0.f, 0.f};
        cur = nxt; cA = nA; cB = nB; ++ui;
        if (wr == 1) PG8_BAR;
    }
    PG8_WAIT_V(0);
    PG8_BAR;
#undef PG8_SA
#undef PG8_SB
#undef PG8_STAGE
#undef PG8_LDA
#undef PG8_LDB
#undef PG8_MMA
#undef PG8_WAIT_V
#undef PG8_WAIT_L
#undef PG8_BAR
#undef PG8_SCHED
}
}

#define ACC_T const f32x4 (&acc)[2][2][4][2]
template <class T> __device__ __forceinline__ T ldg(const void* base, unsigned boff) { return *(const T*)((const char*)base + boff); }
#ifndef WT_STORES
#define WT_STORES 0
#endif
template <class T> __device__ __forceinline__ void stg(void* base, unsigned boff, const T& v) {
    static_assert(sizeof(T) == 16, "16-byte stores only");
#if WT_STORES
    const __amdgpu_buffer_rsrc_t rs = __builtin_amdgcn_make_buffer_rsrc(base, (short)0, 0x7fffffff, 0x00020000);
    __builtin_amdgcn_raw_buffer_store_b128(__builtin_bit_cast(u32x4, v), rs, boff, 0, 16);
#else
    *(T*)((char*)base + boff) = v;
#endif
}
__device__ __forceinline__ u32x4 pack8(const f32x4& v0, const f32x4& v1) { u32x4 w; w.x = cvt_pk_bf16(v0[0], v0[1]); w.y = cvt_pk_bf16(v0[2], v0[3]); w.z = cvt_pk_bf16(v1[0], v1[1]); w.w = cvt_pk_bf16(v1[2], v1[3]); return w; }
#define ROWGROUPS(ai, m) _Pragma("unroll") for (int ai = 0; ai < 2; ++ai) _Pragma("unroll") for (int m = 0; m < 4; ++m)

struct EpiSwiglu {
    bf16* O;
    __device__ __forceinline__ void operator()(ACC_T, const pg8::Unit& u, int wr, int wc, int fr, int fq) const {
        const unsigned off0 = (unsigned)((u.pm * 256 + wr * 64 + fr) * FF + u.pn * 128 + wc * 32 + 8 * fq) * 2u;
        ROWGROUPS(ai, m) {
            const f32x4 a0 = acc[ai][0][m][0], a1 = acc[ai][0][m][1], b0 = acc[ai][1][m][0], b1 = acc[ai][1][m][1];
            f32x4 h0, h1;
#pragma unroll
            for (int j = 0; j < 4; ++j) { h0[j] = a0[j] * b0[j] * __builtin_amdgcn_rcpf(1.0f + __builtin_amdgcn_exp2f(-a0[j])); h1[j] = a1[j] * b1[j] * __builtin_amdgcn_rcpf(1.0f + __builtin_amdgcn_exp2f(-a1[j])); }
            stg(O, off0 + (unsigned)((ai * 128 + m * 16) * FF * 2), pack8(h0, h1));
        }
    }
};

struct EpiProjA {
    bf16 *Oq, *Ok, *Ovt, *Oxt; const float* b_in; float* G;
    __device__ __forceinline__ void operator()(ACC_T, const pg8::Unit& u, int wr, int wc, int fr, int fq) const {
        const int row0 = u.pm * 256 + wr * 64 + fr, col0 = u.pn * 256 + wc * 32 + 8 * fq;
        if (u.kind == 4) {
            if (wc == 0 && fq < 2) { const f32x4 b0 = ldg<f32x4>(b_in, (unsigned)(COL_GATES + 8 * fq) * 4u), b1 = ldg<f32x4>(b_in, (unsigned)(COL_GATES + 8 * fq + 4) * 4u);
                const unsigned g0 = (unsigned)(row0 * 16 + 8 * fq) * 4u;
                ROWGROUPS(ai, m) { stg(G, g0 + (unsigned)((ai * 128 + m * 16) * 64), acc[ai][0][m][0] + b0); stg(G, g0 + (unsigned)((ai * 128 + m * 16) * 64) + 16, acc[ai][0][m][1] + b1); } }
            return; }
        if (u.kind == 0) {
            const bool isk = u.pn >= 4; if (!isk && u.pm >= TLAT / 256) return;
            bf16* O = isk ? Ok : Oq; const int colq = col0 - (isk ? 1024 : 0); const unsigned boff = (unsigned)((isk ? COL_K : COL_Q) + colq) * 4u;
            const unsigned off0 = (unsigned)(row0 * D + colq) * 2u;
#pragma unroll
            for (int bj = 0; bj < 2; ++bj) {
                const f32x4 bv0 = ldg<f32x4>(b_in, boff + bj * 512), bv1 = ldg<f32x4>(b_in, boff + bj * 512 + 16);
                ROWGROUPS(ai, m) stg(O, off0 + (unsigned)((ai * 128 + m * 16) * D * 2) + bj * 256, pack8(acc[ai][bj][m][0] + bv0, acc[ai][bj][m][1] + bv1));
            }
        } else {
            bf16* O = u.kind == 2 ? Ovt : Oxt; const int ldc = u.kind == 2 ? MTOK : TLAT; const unsigned boff = (unsigned)((u.kind == 2 ? COL_V : COL_F) + row0) * 4u;
            const unsigned off0 = (unsigned)(row0 * ldc + col0) * 2u;
            ROWGROUPS(ai, m) { const float bb = ldg<float>(b_in, boff + (unsigned)((ai * 128 + m * 16) * 4)); const unsigned o = off0 + (unsigned)((ai * 128 + m * 16) * ldc * 2);
#pragma unroll
                for (int bj = 0; bj < 2; ++bj) stg(O, o + bj * 256, pack8(acc[ai][bj][m][0] + bb, acc[ai][bj][m][1] + bb)); }
        }
    }
};
__device__ __forceinline__ void store_bf16_tile(bf16* O, ACC_T, const pg8::Unit& u, int wr, int wc, int fr, int fq) {
    const unsigned off0 = (unsigned)((u.pm * 256 + wr * 64 + fr) * D + u.pn * 256 + wc * 32 + 8 * fq) * 2u;
    ROWGROUPS(ai, m) { const unsigned o = off0 + (unsigned)((ai * 128 + m * 16) * D * 2);
#pragma unroll
        for (int bj = 0; bj < 2; ++bj) stg(O, o + bj * 256, pack8(acc[ai][bj][m][0], acc[ai][bj][m][1])); }
}
struct EpiBf16 { bf16* O; __device__ __forceinline__ void operator()(ACC_T, const pg8::Unit& u, int wr, int wc, int fr, int fq) const { store_bf16_tile(O, acc, u, wr, wc, fr, fq); } };
struct EpiDownA { bf16* Y1; float* Y1C;
    __device__ __forceinline__ void operator()(ACC_T, const pg8::Unit& u, int wr, int wc, int fr, int fq) const {
        if (u.kind == 0) { store_bf16_tile(Y1, acc, u, wr, wc, fr, fq); return; }
        const unsigned off0 = (unsigned)(((u.kq * TCTX + u.pm * 256 + wr * 64 + fr) * D) + u.pn * 256 + wc * 32 + 8 * fq) * 4u;
        ROWGROUPS(ai, m) { const unsigned o = off0 + (unsigned)((ai * 128 + m * 16) * D * 4);
#pragma unroll
            for (int bj = 0; bj < 2; ++bj) { stg(Y1C, o + bj * 512, acc[ai][bj][m][0]); stg(Y1C, o + bj * 512 + 16, acc[ai][bj][m][1]); } }
    }
};
struct EpiX {
    bf16 *HM, *TF; const bf16 *HF, *HB; const float *b_in, *head_g; LAS float* red;
    __device__ __forceinline__ void operator()(ACC_T, const pg8::Unit& u, int wr, int wc, int fr, int fq) const {
        if (u.kind == 1) { store_bf16_tile(TF, acc, u, wr, wc, fr, fq); return; }
        const int col0 = u.pn * 256 + wc * 32 + 8 * fq, rt0 = wr * 64 + fr;
        const unsigned off0 = (unsigned)((u.pm * 256 + rt0) * D + col0) * 2u;
#pragma unroll
        for (int am = 0; am < 4; ++am) { const int ai = am >> 1, mb = (am & 1) * 2;
            u32x4 hp[4][2];
#pragma unroll
            for (int m = mb; m < mb + 2; ++m) { const unsigned o = off0 + (unsigned)((ai * 128 + m * 16) * D * 2); float s = 0.f;
#pragma unroll
                for (int bj = 0; bj < 2; ++bj) { const u32x4 a = ldg<u32x4>(HF, o + bj * 256), b = ldg<u32x4>(HB, o + bj * 256); u32x4 hq;
#pragma unroll
                    for (int q = 0; q < 4; ++q) { const float h0 = bflo(a[q]) + bflo(b[q]), h1 = bfhi(a[q]) + bfhi(b[q]); hq[q] = pk2(h0, h1); const float g0 = bflo(hq[q]), g1 = bfhi(hq[q]); s += g0 * g0 + g1 * g1; }
                    hp[m][bj] = hq; }
                s += __shfl_xor(s, 16); s += __shfl_xor(s, 32);
                if (fq == 0) red[(ai * 128 + m * 16 + rt0) * 4 + wc] = s; }
            LDS_WAIT(); __builtin_amdgcn_s_barrier(); asm volatile("" ::: "memory");
#pragma unroll
            for (int bj = 0; bj < 2; ++bj) {
                const unsigned cb = (unsigned)(col0 + bj * 128) * 4u;
                const f32x4 bo0 = ldg<f32x4>(b_in, COL_O * 4 + cb), bo1 = ldg<f32x4>(b_in, COL_O * 4 + cb + 16), hg0 = ldg<f32x4>(head_g, cb), hg1 = ldg<f32x4>(head_g, cb + 16);
#pragma unroll
                for (int m = mb; m < mb + 2; ++m) { const f32x4 ps = *(const LAS f32x4*)(red + (ai * 128 + m * 16 + rt0) * 4);
                    const float rstd = rsqrtf(((ps[0] + ps[1]) + (ps[2] + ps[3])) * (1.0f / 256.0f) + EPS);
                    const unsigned o = off0 + (unsigned)((ai * 128 + m * 16) * D * 2) + bj * 256;
                    const u32x4 hq = hp[m][bj];
                    const f32x4 v0 = acc[ai][bj][m][0] + bo0, v1 = acc[ai][bj][m][1] + bo1;
                    f32x4 r0, r1;
                    r0[0] = sigmoidf_(v0[0]) * bflo(hq[0]) * rstd * hg0[0]; r0[1] = sigmoidf_(v0[1]) * bfhi(hq[0]) * rstd * hg0[1];
                    r0[2] = sigmoidf_(v0[2]) * bflo(hq[1]) * rstd * hg0[2]; r0[3] = sigmoidf_(v0[3]) * bfhi(hq[1]) * rstd * hg0[3];
                    r1[0] = sigmoidf_(v1[0]) * bflo(hq[2]) * rstd * hg1[0]; r1[1] = sigmoidf_(v1[1]) * bfhi(hq[2]) * rstd * hg1[1];
                    r1[2] = sigmoidf_(v1[2]) * bflo(hq[3]) * rstd * hg1[2]; r1[3] = sigmoidf_(v1[3]) * bfhi(hq[3]) * rstd * hg1[3];
                    stg(HM, o, pack8(r0, r1)); } }
            asm volatile("" ::: "memory");
        }
    }
};
struct EpiY {
    bf16 *TF, *TM; const float* b_in;
    __device__ __forceinline__ void operator()(ACC_T, const pg8::Unit& u, int wr, int wc, int fr, int fq) const {
        if (u.kind == 1) { store_bf16_tile(TM, acc, u, wr, wc, fr, fq); return; }
        if (u.kind == 2) { store_bf16_tile(TF, acc, u, wr, wc, fr, fq); return; }
        const int ch0 = u.pn * 128 + wc * 32 + 8 * fq;
        const unsigned off0 = (unsigned)((u.pm * 256 + wr * 64 + fr) * D + ch0) * 2u;
        const f32x4 bf0 = ldg<f32x4>(b_in, (unsigned)(COL_GF + ch0) * 4u), bf1 = ldg<f32x4>(b_in, (unsigned)(COL_GF + ch0) * 4u + 16);
        const f32x4 bm0 = ldg<f32x4>(b_in, (unsigned)(COL_GM + ch0) * 4u), bm1 = ldg<f32x4>(b_in, (unsigned)(COL_GM + ch0) * 4u + 16);
#pragma unroll
        for (int am = 0; am < 4; ++am) { const int ai = am >> 1, mb = (am & 1) * 2;
            u32x4 tq[4], tmq[4];
#pragma unroll
            for (int m = mb; m < mb + 2; ++m) { const unsigned o = off0 + (unsigned)((ai * 128 + m * 16) * D * 2); tq[m] = ldg<u32x4>(TF, o); tmq[m] = ldg<u32x4>(TM, o); }
#pragma unroll
            for (int m = mb; m < mb + 2; ++m) { const unsigned o = off0 + (unsigned)((ai * 128 + m * 16) * D * 2);
                const u32x4 t = tq[m], tm = tmq[m];
                const f32x4 f0 = acc[ai][0][m][0] + bf0, f1 = acc[ai][0][m][1] + bf1, g0 = acc[ai][1][m][0] + bm0, g1 = acc[ai][1][m][1] + bm1;
                f32x4 r0, r1;
                r0[0] = sigmoidf_(f0[0]) * bflo(t[0]) + sigmoidf_(g0[0]) * bflo(tm[0]); r0[1] = sigmoidf_(f0[1]) * bfhi(t[0]) + sigmoidf_(g0[1]) * bfhi(tm[0]);
                r0[2] = sigmoidf_(f0[2]) * bflo(t[1]) + sigmoidf_(g0[2]) * bflo(tm[1]); r0[3] = sigmoidf_(f0[3]) * bfhi(t[1]) + sigmoidf_(g0[3]) * bfhi(tm[1]);
                r1[0] = sigmoidf_(f1[0]) * bflo(t[2]) + sigmoidf_(g1[0]) * bflo(tm[2]); r1[1] = sigmoidf_(f1[1]) * bfhi(t[2]) + sigmoidf_(g1[1]) * bfhi(tm[2]);
                r1[2] = sigmoidf_(f1[2]) * bflo(t[3]) + sigmoidf_(g1[2]) * bflo(tm[3]); r1[3] = sigmoidf_(f1[3]) * bfhi(t[3]) + sigmoidf_(g1[3]) * bfhi(tm[3]);
                stg(TM, o, pack8(r0, r1)); }
            asm volatile("" ::: "memory"); }
    }
};

struct PanelRms {
    float* xbuf; unsigned* cnt;
    __device__ __forceinline__ void run(const f32x4 (&v)[2][2][4][2], const pg8::Unit& u, int wr, int wc, int fr, int fq, LAS float* Pt, LAS float* S, int wid, int lane) const {
        ROWGROUPS(ai, m) { float s = 0.f;
#pragma unroll
            for (int bj = 0; bj < 2; ++bj)
#pragma unroll
                for (int n = 0; n < 2; ++n) { const f32x4 x = v[ai][bj][m][n]; s += (x[0] * x[0] + x[1] * x[1]) + (x[2] * x[2] + x[3] * x[3]); }
            s += __shfl_xor(s, 16); s += __shfl_xor(s, 32);
            if (fq == 0) Pt[(ai * 128 + wr * 64 + m * 16 + fr) * 4 + wc] = s; }
        LDS_WAIT(); __builtin_amdgcn_s_barrier(); asm volatile("" ::: "memory");
        const int row = wid * 32 + (lane & 31);
        if (lane < 32) { const f32x4 a = *(const LAS f32x4*)(Pt + row * 4);
            __hip_atomic_store(xbuf + (size_t)(u.pm * 256 + row) * 4 + u.pn, (a[0] + a[1]) + (a[2] + a[3]), __ATOMIC_RELAXED, __HIP_MEMORY_SCOPE_AGENT); }
        asm volatile("s_waitcnt vmcnt(0)" ::: "memory");
        if (lane == 0) __hip_atomic_fetch_add(cnt + 64 * u.pm, 1u, __ATOMIC_RELAXED, __HIP_MEMORY_SCOPE_AGENT);
        if (wid == 0) { unsigned sp = 0;
            while ((unsigned)__builtin_amdgcn_readfirstlane(__hip_atomic_load(cnt + 64 * u.pm, __ATOMIC_RELAXED, __HIP_MEMORY_SCOPE_AGENT)) < 32u) { __builtin_amdgcn_s_sleep(2); if (++sp > (1u << 22)) break; }
            __builtin_amdgcn_fence(__ATOMIC_ACQUIRE, "agent"); }
        asm volatile("s_waitcnt vmcnt(0) lgkmcnt(0)" ::: "memory"); __builtin_amdgcn_s_barrier(); asm volatile("" ::: "memory");
        if (lane < 32) { const float* sl = xbuf + (size_t)(u.pm * 256 + row) * 4; float t = 0.f;
#pragma unroll
            for (int k = 0; k < 4; ++k) t += __hip_atomic_load(sl + k, __ATOMIC_RELAXED, __HIP_MEMORY_SCOPE_AGENT);
            S[row] = rsqrtf(t * (1.0f / 1024.0f) + EPS); }
        LDS_WAIT(); __builtin_amdgcn_s_barrier(); asm volatile("" ::: "memory");
    }
};
struct EpiFinal {
    const float *x, *g5, *mod; const bf16* D12; float* out; PanelRms st; LAS float* tab;
    __device__ __forceinline__ void operator()(ACC_T, const pg8::Unit& u, int wr, int wc, int fr, int fq) const {
        const int wid = wr * 4 + wc, lane = fq * 16 + fr; LAS float* S = tab + 1024;
        st.run(acc, u, wr, wc, fr, fq, tab, S, wid, lane);
        const int col0 = u.pn * 256 + wc * 32 + 8 * fq, rt0 = wr * 64 + fr, v = (u.pm * 256) >> 12;
        const unsigned e0 = (unsigned)((u.pm * 256 + rt0) * D + col0);
        const float* gate = mod + (size_t)v * 9216 + 8 * 1024;
#pragma unroll
        for (int bj = 0; bj < 2; ++bj) {
            const unsigned cb = (unsigned)(col0 + bj * 128) * 4u;
            f32x4 g0 = ldg<f32x4>(g5, cb), g1 = ldg<f32x4>(g5, cb + 16); const f32x4 t0 = ldg<f32x4>(gate, cb), t1 = ldg<f32x4>(gate, cb + 16);
            g0 = g0 * t0 * 0.5f; g1 = g1 * t1 * 0.5f;
            ROWGROUPS(ai, m) { const float rs = S[ai * 128 + m * 16 + rt0]; const unsigned e = e0 + (unsigned)((ai * 128 + m * 16) * D) + bj * 128;
                const f32x4 x0 = ldg<f32x4>(x, e * 4u), x1 = ldg<f32x4>(x, e * 4u + 16); const u32x4 dd = ldg<u32x4>(D12, e * 2u);
                f32x4 o0, o1;
                o0[0] = x0[0] + bflo(dd[0]); o0[1] = x0[1] + bfhi(dd[0]); o0[2] = x0[2] + bflo(dd[1]); o0[3] = x0[3] + bfhi(dd[1]);
                o1[0] = x1[0] + bflo(dd[2]); o1[1] = x1[1] + bfhi(dd[2]); o1[2] = x1[2] + bflo(dd[3]); o1[3] = x1[3] + bfhi(dd[3]);
                o0 = o0 + acc[ai][bj][m][0] * rs * g0; o1 = o1 + acc[ai][bj][m][1] * rs * g1;
                stg(out, e * 4u, o0); stg(out, e * 4u + 16, o1);
                asm volatile("" ::: "memory"); } }
    }
};
struct EpiMix {
    const float *x, *g3, *g4, *mod; const bf16* D1; bf16 *D12, *U3; PanelRms st1, st2; LAS float* tab;
    __device__ __forceinline__ void operator()(f32x4 (&acc)[2][2][4][2], const pg8::Unit& u, int wr, int wc, int fr, int fq) const {
        const int wid = wr * 4 + wc, lane = fq * 16 + fr; LAS float* S = tab + 1024;
        st1.run(acc, u, wr, wc, fr, fq, tab, S, wid, lane);
        const int col0 = u.pn * 256 + wc * 32 + 8 * fq, rt0 = wr * 64 + fr, v = (u.pm * 256) >> 12;
        const unsigned e0 = (unsigned)((u.pm * 256 + rt0) * D + col0);
        const float* mv = mod + (size_t)v * 9216;
#pragma unroll
        for (int bj = 0; bj < 2; ++bj) {
            const unsigned cb = (unsigned)(col0 + bj * 128) * 4u;
            f32x4 g0 = ldg<f32x4>(g3, cb), g1 = ldg<f32x4>(g3, cb + 16); const f32x4 t0 = ldg<f32x4>(mv + 5 * 1024, cb), t1 = ldg<f32x4>(mv + 5 * 1024, cb + 16);
            g0 = g0 * t0; g1 = g1 * t1;
            ROWGROUPS(ai, m) { const float rs = S[ai * 128 + m * 16 + rt0]; const unsigned e = e0 + (unsigned)((ai * 128 + m * 16) * D) + bj * 128;
                const u32x4 dd = ldg<u32x4>(D1, e * 2u);
                f32x4 d0, d1;
                d0[0] = bflo(dd[0]); d0[1] = bfhi(dd[0]); d0[2] = bflo(dd[1]); d0[3] = bfhi(dd[1]); d1[0] = bflo(dd[2]); d1[1] = bfhi(dd[2]); d1[2] = bflo(dd[3]); d1[3] = bfhi(dd[3]);
                d0 = d0 + acc[ai][bj][m][0] * rs * g0; d1 = d1 + acc[ai][bj][m][1] * rs * g1;
                const u32x4 pk = pack8(d0, d1); stg(D12, e * 2u, pk);
                const f32x4 x0 = ldg<f32x4>(x, e * 4u), x1 = ldg<f32x4>(x, e * 4u + 16);
                f32x4 h0, h1;
                h0[0] = x0[0] + bflo(pk[0]); h0[1] = x0[1] + bfhi(pk[0]); h0[2] = x0[2] + bflo(pk[1]); h0[3] = x0[3] + bfhi(pk[1]);
                h1[0] = x1[0] + bflo(pk[2]); h1[1] = x1[1] + bfhi(pk[2]); h1[2] = x1[2] + bflo(pk[3]); h1[3] = x1[3] + bfhi(pk[3]);
                acc[ai][bj][m][0] = h0; acc[ai][bj][m][1] = h1;
                asm volatile("" ::: "memory"); } }
        st2.run(acc, u, wr, wc, fr, fq, tab, S, wid, lane);
#pragma unroll
        for (int bj = 0; bj < 2; ++bj) {
            const unsigned cb = (unsigned)(col0 + bj * 128) * 4u;
            f32x4 g0 = ldg<f32x4>(g4, cb), g1 = ldg<f32x4>(g4, cb + 16); const f32x4 c0 = ldg<f32x4>(mv + 7 * 1024, cb), c1 = ldg<f32x4>(mv + 7 * 1024, cb + 16);
            const f32x4 s0 = ldg<f32x4>(mv + 6 * 1024, cb), s1 = ldg<f32x4>(mv + 6 * 1024, cb + 16);
            g0 = g0 * (c0 + 1.0f); g1 = g1 * (c1 + 1.0f);
            ROWGROUPS(ai, m) { const float rs = S[ai * 128 + m * 16 + rt0]; const unsigned e = e0 + (unsigned)((ai * 128 + m * 16) * D) + bj * 128;
                stg(U3, e * 2u, pack8(acc[ai][bj][m][0] * rs * g0 + s0, acc[ai][bj][m][1] * rs * g1 + s1)); } }
    }
};

struct Frame { LAS unsigned char* lds; int tid, lane, wave, gw, ngw; };

__device__ __forceinline__ void transpose_item(const float* W, int K, int Nsrc, bf16* WT, int dst_row0, int src_col0, int k0, LAS float* scr, int lane, float scale = 1.0f) {
    float tv[32];
    { const float* wp = W + (size_t)(k0 + (lane >> 5)) * Nsrc + src_col0 + (lane & 31);
#pragma unroll
      for (int i = 0; i < 32; ++i) tv[i] = __builtin_nontemporal_load(wp + (size_t)(2 * i) * Nsrc); }
#pragma unroll
    for (int i = 0; i < 32; ++i) scr[(2 * i + (lane >> 5)) * 33 + (lane & 31)] = tv[i] * scale;
    LDS_WAIT(); asm volatile("" ::: "memory");
    const int c = lane & 7;
#pragma unroll
    for (int j = 0; j < 4; ++j) { const int n = (lane >> 3) + 8 * j; const LAS float* s = scr + (8 * c) * 33 + n;
        u32x4 o; o.x = pk2(s[0 * 33], s[1 * 33]); o.y = pk2(s[2 * 33], s[3 * 33]); o.z = pk2(s[4 * 33], s[5 * 33]); o.w = pk2(s[6 * 33], s[7 * 33]);
        *(u32x4*)(WT + (size_t)(dst_row0 + n) * K + k0 + 8 * c) = o; }
    LDS_WAIT(); asm volatile("" ::: "memory");
}
__device__ __forceinline__ void conv_w13(const Frame& F, const float* w13, bf16* dst, int it0, int its) {
    LAS float* scr = (LAS float*)(F.lds + F.wave * 16384);
    for (int it = it0 + F.gw; it < it0 + its; it += F.ngw) { const int r = it, kb = r / 176, nb = r % 176, n0 = 32 * nb, j = n0 >> 8, s = (n0 >> 7) & 1, i0 = n0 & 127;
        transpose_item(w13, D, 2 * FF, dst, n0, s * FF + 128 * j + i0, 64 * kb, scr, F.lane, s ? 0.6931471805599453f : 1.4426950408889634f); }
}
__device__ __forceinline__ void conv_plain(const Frame& F, const float* W, int K, int N, bf16* dst, int it0, int its) {
    LAS float* scr = (LAS float*)(F.lds + F.wave * 16384);
    const int nblk = N / 32;
    for (int it = it0 + F.gw; it < it0 + its; it += F.ngw) { const int r = it, kb = r / nblk, nb = r % nblk;
        transpose_item(W, K, N, dst, 32 * nb, 32 * nb, 64 * kb, scr, F.lane); }
}
__device__ __forceinline__ int win_src_col(int n0) {
    if (n0 < ROW_K) return COL_Q + n0;
    if (n0 < ROW_V) return COL_K + (n0 - ROW_K);
    if (n0 < ROW_F) return COL_V + (n0 - ROW_V);
    if (n0 < ROW_O) return COL_F + (n0 - ROW_F);
    if (n0 < ROW_GF) return COL_O + (n0 - ROW_O);
    { const int r = n0 - ROW_GF, j = r >> 8, sg = (r >> 7) & 1, i0 = r & 127; return (sg ? COL_GM : COL_GF) + 128 * j + i0; }
}
__device__ __forceinline__ void conv_win(const Frame& F, const float* w_in, bf16* dst, int it0, int its) {
    LAS float* scr = (LAS float*)(F.lds + F.wave * 16384);
    constexpr int nblk = WIN_ROWS / 32;
    for (int it = it0 + F.gw; it < it0 + its; it += F.ngw) { const int r = it, kb = r / nblk, nb = r % nblk;
        transpose_item(w_in, D, INW, dst, 32 * nb, win_src_col(32 * nb), 64 * kb, scr, F.lane); }
}

__device__ __forceinline__ void ada_phase(const Frame& F, const Params& p) {
    LAS float* sc = (LAS float*)F.lds;
    LAS float* part = sc + 5 * 1024;
    float* mod = (float*)(p.ws + WS_MOD);
    for (int i = F.tid; i < 5 * 1024; i += NTHR) { const int v = i >> 10, k = i & 1023; const float cv = v < 4 ? p.c[v * 1024 + k] : p.c_ctx[k]; sc[i] = siluf_(cv); }
    __syncthreads();
    for (int tile = blockIdx.x; tile < 144; tile += gridDim.x) {
        const int col = 64 * tile + F.lane;
        float a0 = 0.f, a1 = 0.f, a2 = 0.f, a3 = 0.f, a4 = 0.f;
#pragma unroll 32
        for (int it = 0; it < 128; ++it) { const int k = 128 * F.wave + it; const float w = __builtin_nontemporal_load(p.w_ada + (size_t)k * 9216 + col);
            a0 += sc[k] * w; a1 += sc[1024 + k] * w; a2 += sc[2048 + k] * w; a3 += sc[3072 + k] * w; a4 += sc[4096 + k] * w; }
        { LAS float* pp = part + F.wave * 320 + F.lane; pp[0] = a0; pp[64] = a1; pp[128] = a2; pp[192] = a3; pp[256] = a4; }
        __syncthreads();
        if (F.tid < 320) { float s = 0.f;
#pragma unroll
            for (int w = 0; w < 8; ++w) s += part[w * 320 + F.tid];
            const int v = F.tid >> 6, cc = 64 * tile + (F.tid & 63); mod[v * 9216 + cc] = s + p.b_ada[cc]; }
        __syncthreads();
    }
}
__device__ __forceinline__ void wfour_phase(const Frame& F, const Params& p) {
    LAS float* ct = (LAS float*)(F.lds + 32768);
    if (F.tid < 128) ct[F.tid] = cosf((float)F.tid * (6.283185307179586f / 128.0f));
    __syncthreads();
    bf16* WF = (bf16*)(p.ws + WS_WFOUR);
    for (int task = blockIdx.x * NTHR + F.tid; task < 1024 * 128; task += gridDim.x * NTHR) {
        const int n = task & 1023, jg = task >> 10, i = jg >> 1, pq = jg & 1, f0 = 8 * i, g = f0 >> 7, ch0 = f0 & 127;
        float a[8];
#pragma unroll
        for (int t = 0; t < 8; ++t) a[t] = 0.f;
        const float* wp = p.w_four + (size_t)(g * 128) * 1024 + n;
        const int sh = pq ? 96 : 0;
#pragma unroll 8
        for (int k3 = 0; k3 < 128; ++k3) { const float w = wp[(size_t)k3 * 1024];
#pragma unroll
            for (int t = 0; t < 8; ++t) a[t] += ct[(k3 * (ch0 + t) + sh) & 127] * w; }
        const float scl = pq ? -0.08838834764831845f : 0.08838834764831845f;
        u32x4 o; o.x = pk2(a[0] * scl, a[1] * scl); o.y = pk2(a[2] * scl, a[3] * scl); o.z = pk2(a[4] * scl, a[5] * scl); o.w = pk2(a[6] * scl, a[7] * scl);
        *(u32x4*)(WF + (size_t)n * 1024 + 8 * jg) = o;
    }
    __syncthreads();
}

struct Row { f32x4 v[4]; };
__device__ __forceinline__ Row ld_row_f32(const float* r, int lane) { Row o; const f32x4* q = (const f32x4*)r + lane;
#pragma unroll
    for (int j = 0; j < 4; ++j) o.v[j] = q[64 * j]; return o; }
__device__ __forceinline__ Row ld_row_bf16(const bf16* r, int lane) { Row o; const u32x2* q = (const u32x2*)r + lane;
#pragma unroll
    for (int j = 0; j < 4; ++j) { const u32x2 w = q[64 * j]; o.v[j] = (f32x4){bflo(w.x), bfhi(w.x), bflo(w.y), bfhi(w.y)}; } return o; }
__device__ __forceinline__ void st_row_bf16(bf16* r, int lane, const Row& a) { u32x2* q = (u32x2*)r + lane;
#pragma unroll
    for (int j = 0; j < 4; ++j) { u32x2 w; w.x = pk2(a.v[j][0], a.v[j][1]); w.y = pk2(a.v[j][2], a.v[j][3]); q[64 * j] = w; } }
__device__ __forceinline__ void st_row_f32(float* r, int lane, const Row& a) { f32x4* q = (f32x4*)r + lane;
#pragma unroll
    for (int j = 0; j < 4; ++j) q[64 * j] = a.v[j]; }
__device__ __forceinline__ float row_rstd(const Row& a) { float s = 0.f;
#pragma unroll
    for (int j = 0; j < 4; ++j) s += (a.v[j][0] * a.v[j][0] + a.v[j][1] * a.v[j][1]) + (a.v[j][2] * a.v[j][2] + a.v[j][3] * a.v[j][3]);
    return rsqrtf(wave_sum(s) * (1.0f / 1024.0f) + EPS); }
__device__ __forceinline__ Row round_bf16(const Row& a) { Row o;
#pragma unroll
    for (int j = 0; j < 4; ++j)
#pragma unroll
        for (int e = 0; e < 4; ++e) o.v[j][e] = bf2f(f2bf(a.v[j][e]));
    return o; }
__device__ __forceinline__ Row modnorm2(const Row& h, const Row& gs, const Row& sh) {
    const float rs = row_rstd(h); Row o;
#pragma unroll
    for (int j = 0; j < 4; ++j) o.v[j] = h.v[j] * rs * gs.v[j] + sh.v[j];
    return o; }
__device__ __forceinline__ Row gated_norm2(const Row& y, const Row& gg) {
    const float rs = row_rstd(y); Row o;
#pragma unroll
    for (int j = 0; j < 4; ++j) o.v[j] = y.v[j] * rs * gg.v[j];
    return o; }
__device__ __forceinline__ Row rmul(const Row& a, const Row& b) { Row o;
#pragma unroll
    for (int j = 0; j < 4; ++j) o.v[j] = a.v[j] * b.v[j]; return o; }
__device__ __forceinline__ Row rmul1p(const Row& g, const Row& sc) { Row o;
#pragma unroll
    for (int j = 0; j < 4; ++j) o.v[j] = g.v[j] * (sc.v[j] + 1.0f); return o; }
__device__ __forceinline__ Row rscale(const Row& a, float c) { Row o;
#pragma unroll
    for (int j = 0; j < 4; ++j) o.v[j] = a.v[j] * c; return o; }
__device__ __forceinline__ Row radd(const Row& a, const Row& b) { Row o;
#pragma unroll
    for (int j = 0; j < 4; ++j) o.v[j] = a.v[j] + b.v[j]; return o; }
__device__ __forceinline__ const float* modp(const Params& p, int v, int i) { return (const float*)(p.ws + WS_MOD) + (size_t)v * 9216 + i * 1024; }
__device__ __forceinline__ const float* xrow(const Params& p, int r) { return r < TLAT ? p.x + (size_t)r * D : p.ctx + (size_t)(r - TLAT) * D; }
__device__ __forceinline__ int rowvar(int r) { return r < TLAT ? (r >> 12) : 4; }

__device__ __forceinline__ int row_of(const Frame& F, int it) {
    const int per = F.ngw >> 2, nl = (SEQ + per - 1) / per;
    if (it < nl) { const int rl = (F.gw >> 2) + it * per; if (rl < SEQ) return (F.gw & 3) * SEQ + rl; it = nl; }
    const int rc = F.gw + (it - nl) * F.ngw; return rc < TCTX ? TLAT + rc : -1;
}
__device__ __forceinline__ int lat_row(const Frame& F, int k) { const int rl = (F.gw >> 2) + k * (F.ngw >> 2); return rl < SEQ ? (F.gw & 3) * SEQ + rl : -1; }
__device__ __forceinline__ void phase_u1(const Frame& F, const Params& p) {
    bf16* U = (bf16*)(p.ws + WS_U);
    { const int v = F.gw & 3; const Row gs = rmul1p(ld_row_f32(p.norm_g, F.lane), ld_row_f32(modp(p, v, 1), F.lane)), sh = ld_row_f32(modp(p, v, 0), F.lane);
      for (int k0 = 0; lat_row(F, k0) >= 0; k0 += 4) { Row xr[4]; int rr[4];
#pragma unroll
          for (int q = 0; q < 4; ++q) { rr[q] = lat_row(F, k0 + q); if (rr[q] >= 0) xr[q] = ld_row_f32(p.x + (size_t)rr[q] * D, F.lane); }
#pragma unroll
          for (int q = 0; q < 4; ++q) if (rr[q] >= 0) st_row_bf16(U + (size_t)rr[q] * D, F.lane, modnorm2(xr[q], gs, sh)); } }
    { const Row gs = rmul1p(ld_row_f32(p.norm_g, F.lane), ld_row_f32(modp(p, 4, 1), F.lane)), sh = ld_row_f32(modp(p, 4, 0), F.lane);
      for (int rc = F.gw; rc < TCTX; rc += F.ngw) st_row_bf16(U + (size_t)(TLAT + rc) * D, F.lane, modnorm2(ld_row_f32(p.ctx + (size_t)rc * D, F.lane), gs, sh)); }
}
__device__ __forceinline__ void phase_post_ffn_a(const Frame& F, const Params& p) {
    bf16* U = (bf16*)(p.ws + WS_U2); bf16* D1 = (bf16*)((unsigned char*)p.out + DO_D1); const bf16* Y1 = (const bf16*)(p.ws + WS_Y1);
    { const int v = F.gw & 3; const Row gg = rscale(rmul(ld_row_f32(p.norm_g + 1 * D, F.lane), ld_row_f32(modp(p, v, 2), F.lane)), 0.5f);
      const Row gs = rmul1p(ld_row_f32(p.norm_g + 2 * D, F.lane), ld_row_f32(modp(p, v, 4), F.lane)), sh = ld_row_f32(modp(p, v, 3), F.lane);
      for (int k0 = 0; lat_row(F, k0) >= 0; k0 += 4) { Row xr[4], yr[4]; int rr[4];
#pragma unroll
          for (int q = 0; q < 4; ++q) { rr[q] = lat_row(F, k0 + q); if (rr[q] >= 0) { yr[q] = ld_row_bf16(Y1 + (size_t)rr[q] * D, F.lane); xr[q] = ld_row_f32(p.x + (size_t)rr[q] * D, F.lane); } }
#pragma unroll
          for (int q = 0; q < 4; ++q) if (rr[q] >= 0) { const Row dl = round_bf16(gated_norm2(yr[q], gg)); st_row_bf16(D1 + (size_t)rr[q] * D, F.lane, dl);
              st_row_bf16(U + (size_t)rr[q] * D, F.lane, modnorm2(radd(xr[q], dl), gs, sh)); } } }
    { const Row gg = rscale(rmul(ld_row_f32(p.norm_g + 1 * D, F.lane), ld_row_f32(modp(p, 4, 2), F.lane)), 0.5f);
      const Row gs = rmul1p(ld_row_f32(p.norm_g + 2 * D, F.lane), ld_row_f32(modp(p, 4, 4), F.lane)), sh = ld_row_f32(modp(p, 4, 3), F.lane);
      for (int rc = F.gw; rc < TCTX; rc += F.ngw) { const float* yc = (const float*)(p.ws + WS_Y1C) + (size_t)rc * D;
          Row y = radd(radd(ld_row_f32(yc, F.lane), ld_row_f32(yc + (size_t)TCTX * D, F.lane)), radd(ld_row_f32(yc + (size_t)2 * TCTX * D, F.lane), ld_row_f32(yc + (size_t)3 * TCTX * D, F.lane)));
          y = radd(y, radd(radd(ld_row_f32(yc + (size_t)4 * TCTX * D, F.lane), ld_row_f32(yc + (size_t)5 * TCTX * D, F.lane)), radd(ld_row_f32(yc + (size_t)6 * TCTX * D, F.lane), ld_row_f32(yc + (size_t)7 * TCTX * D, F.lane))));
          const Row dl = round_bf16(gated_norm2(y, gg));
          st_row_bf16(U + (size_t)(TLAT + rc) * D, F.lane, modnorm2(radd(ld_row_f32(p.ctx + (size_t)rc * D, F.lane), dl), gs, sh)); } }
}
__device__ __forceinline__ void phase_u2_again(const Frame& F, const Params& p) {
    bf16* U = (bf16*)(p.ws + WS_U); const bf16* D1 = (const bf16*)((unsigned char*)p.out + DO_D1);
    const int v = F.gw & 3; const Row gs = rmul1p(ld_row_f32(p.norm_g + 2 * D, F.lane), ld_row_f32(modp(p, v, 4), F.lane)), sh = ld_row_f32(modp(p, v, 3), F.lane);
    for (int k0 = 0; lat_row(F, k0) >= 0; k0 += 4) { Row xr[4], dr[4]; int rr[4];
#pragma unroll
        for (int q = 0; q < 4; ++q) { rr[q] = lat_row(F, k0 + q); if (rr[q] >= 0) { xr[q] = ld_row_f32(p.x + (size_t)rr[q] * D, F.lane); dr[q] = ld_row_bf16(D1 + (size_t)rr[q] * D, F.lane); } }
#pragma unroll
        for (int q = 0; q < 4; ++q) if (rr[q] >= 0) st_row_bf16(U + (size_t)rr[q] * D, F.lane, modnorm2(radd(xr[q], dr[q]), gs, sh)); }
}

constexpr int SQK_STRIDE = 544;
constexpr int M1_SQ = 0, M1_SK = 128 * SQK_STRIDE, M1_TAB = 2 * 128 * SQK_STRIDE;
__device__ __forceinline__ float logsigmoidf_(float x) { return fminf(x, 0.f) - log1pf(__expf(-fabsf(x))); }

__device__ __forceinline__ void m1_item(const Frame& F, const Params& p, int bh, int cp) {
    const int b = bh >> 2, h = bh & 3; const bool is_lat = cp >= 2;
    const int seqlen = is_lat ? SEQ : CTXL, t0 = is_lat ? CH * (cp - 2) : CH * cp, rowbase = is_lat ? b * SEQ : TLAT + b * CTXL, pbase = CH * cp;
    const bf16* QPRE = (const bf16*)(p.ws + WS_QPRE); const bf16* KPRE = (const bf16*)(p.ws + WS_KPRE);
    LAS unsigned char* sQ = F.lds + M1_SQ; LAS unsigned char* sK = F.lds + M1_SK; LAS float* tab = (LAS float*)(F.lds + M1_TAB);
    const int lane = F.lane, w = F.wave, fr = lane & 15, fq = lane >> 4;
    {
        const int ch = 8 * (F.tid & 31), rb = 8 * (F.tid >> 5);
#define M1_CONV(SRC, CCH, SCALE, DST) do { \
        float w0[8], w1[8], w2[8], bb[8]; \
        _Pragma("unroll") for (int e = 0; e < 8; ++e) { const int cc = (CCH) + h * 256 + ch + e; w0[e] = p.conv_w[cc]; w1[e] = p.conv_w[2048 + cc]; w2[e] = p.conv_w[4096 + cc]; bb[e] = p.conv_b[cc]; } \
        u32x4 xr[10]; const bf16* base = (SRC) + (size_t)(rowbase + t0 + rb) * D + h * 256 + ch; \
        _Pragma("unroll") for (int i = 0; i < 10; ++i) { const int sq = t0 + rb + i - 1; xr[i] = (sq >= 0 && sq < seqlen) ? *(const u32x4*)(base + (ptrdiff_t)(i - 1) * D) : (u32x4){0u, 0u, 0u, 0u}; } \
        _Pragma("unroll") for (int i = 0; i < 8; ++i) { float o[8]; \
            _Pragma("unroll") for (int q = 0; q < 4; ++q) { \
                const float y0 = w0[2 * q] * bflo(xr[i][q]) + w1[2 * q] * bflo(xr[i + 1][q]) + w2[2 * q] * bflo(xr[i + 2][q]) + bb[2 * q]; \
                const float y1 = w0[2 * q + 1] * bfhi(xr[i][q]) + w1[2 * q + 1] * bfhi(xr[i + 1][q]) + w2[2 * q + 1] * bfhi(xr[i + 2][q]) + bb[2 * q + 1]; \
                o[2 * q] = siluf_(y0) * (SCALE); o[2 * q + 1] = siluf_(y1) * (SCALE); } \
            u32x4 wv; wv.x = pk2(o[0], o[1]); wv.y = pk2(o[2], o[3]); wv.z = pk2(o[4], o[5]); wv.w = pk2(o[6], o[7]); \
            *(LAS u32x4*)((DST) + (rb + i) * SQK_STRIDE + ch * 2) = wv; } } while (0)
        M1_CONV(KPRE, 1024, 0.0625f, sK);
        if (is_lat) M1_CONV(QPRE, 0, 1.0f, sQ);
#undef M1_CONV
    }
    if (w < 2) {
        const int dir = w; const float* G = (const float*)(p.ws + WS_GATES);
        const int i0 = 2 * lane, i1 = 2 * lane + 1, ta = dir ? 127 - i0 : i0, tb = dir ? 127 - i1 : i1;
        const float li0 = G[(size_t)(rowbase + t0 + ta) * 16 + dir * 8 + h], li1 = G[(size_t)(rowbase + t0 + tb) * 16 + dir * 8 + h];
        const float lf0 = logsigmoidf_(G[(size_t)(rowbase + t0 + ta) * 16 + dir * 8 + 4 + h]), lf1 = logsigmoidf_(G[(size_t)(rowbase + t0 + tb) * 16 + dir * 8 + 4 + h]);
        float ps = lf0 + lf1;
#pragma unroll
        for (int o = 1; o < 64; o <<= 1) { const float v = __shfl_up(ps, o); if (lane >= o) ps += v; }
        const float ex = ps - (lf0 + lf1), b0 = ex + lf0, b1 = ex + lf0 + lf1;
        const float r0 = li0 - b0, r1 = li1 - b1;
        float pm = fmaxf(r0, r1);
#pragma unroll
        for (int o = 1; o < 64; o <<= 1) { const float v = __shfl_up(pm, o); if (lane >= o) pm = fmaxf(pm, v); }
        const float pmex = __shfl_up(pm, 1); const float m0 = lane ? fmaxf(pmex, r0) : r0, m1 = pm;
        LAS float* tb_ = tab + dir * 384;
        tb_[ta] = b0; tb_[128 + ta] = r0; tb_[256 + ta] = m0; tb_[tb] = b1; tb_[128 + tb] = r1; tb_[256 + tb] = m1;
        float* TS = (float*)(p.ws + WS_TOKSC) + ((size_t)(dir * 16 + bh) * PLEN + pbase) * 4;
        TS[ta * 4 + 0] = b0; TS[ta * 4 + 1] = li0; TS[ta * 4 + 2] = b0 + m0; TS[tb * 4 + 0] = b1; TS[tb * 4 + 1] = li1; TS[tb * 4 + 2] = b1 + m1;
        if (lane == 63) { float* CS = (float*)(p.ws + WS_CHSC) + ((size_t)(dir * 16 + bh) * NCHK + cp) * 2; CS[0] = b1; CS[1] = b1 + m1; }
    }
    __syncthreads();
    {
        u32x4* KT = (u32x4*)(p.ws + WS_KT) + ((size_t)bh * NCHK + cp) * 4096;
        const int d = F.tid & 255, sgp = F.tid >> 8;
#pragma unroll
        for (int it = 0; it < 8; ++it) { const int sg = 2 * it + sgp; unsigned short e[8];
#pragma unroll
            for (int j = 0; j < 8; ++j) e[j] = *(const LAS unsigned short*)(sK + (8 * sg + j) * SQK_STRIDE + d * 2);
            u32x4 o; o.x = e[0] | ((unsigned)e[1] << 16); o.y = e[2] | ((unsigned)e[3] << 16); o.z = e[4] | ((unsigned)e[5] << 16); o.w = e[6] | ((unsigned)e[7] << 16);
            KT[((((d >> 5) * 2 + ((d >> 4) & 1)) * 4 + (sg >> 2)) * 64) + (sg & 3) * 16 + (d & 15)] = o; }
        if (is_lat) { u32x4* Q = (u32x4*)(p.ws + WS_Q) + ((size_t)bh * 32 + (cp - 2)) * 4096;
#pragma unroll
            for (int it = 0; it < 8; ++it) { const int piece = F.tid + 512 * it, row = piece >> 5, c16 = piece & 31;
                Q[((row >> 4) * 8 + (c16 >> 2)) * 64 + (c16 & 3) * 16 + (row & 15)] = *(const LAS u32x4*)(sQ + row * SQK_STRIDE + c16 * 16); } }
    }
    if (is_lat) {
        bf16x8 bq[8];
#pragma unroll
        for (int k = 0; k < 8; ++k) bq[k] = *(const LAS bf16x8*)(sQ + (16 * w + fr) * SQK_STRIDE + (32 * k + 8 * fq) * 2);
        f32x4 acc[8];
        { bf16x8 ac[8], an[8];
#pragma unroll
          for (int k = 0; k < 8; ++k) ac[k] = *(const LAS bf16x8*)(sK + fr * SQK_STRIDE + (32 * k + 8 * fq) * 2);
#pragma unroll
          for (int mt = 0; mt < 8; ++mt) { acc[mt] = (f32x4){0.f, 0.f, 0.f, 0.f};
            if (mt < 7) {
#pragma unroll
                for (int k = 0; k < 8; ++k) an[k] = *(const LAS bf16x8*)(sK + (16 * (mt + 1) + fr) * SQK_STRIDE + (32 * k + 8 * fq) * 2); }
#pragma unroll
            for (int k = 0; k < 8; ++k) acc[mt] = __builtin_amdgcn_mfma_f32_16x16x32_bf16(ac[k], bq[k], acc[mt], 0, 0, 0);
#pragma unroll
            for (int k = 0; k < 8; ++k) ac[k] = an[k]; } }
        const int t = 16 * w + fr, c = cp - 2;
        bf16* P = (bf16*)((unsigned char*)p.out + DO_P);
#pragma unroll
        for (int dir = 0; dir < 2; ++dir) {
            const LAS float* tb_ = tab + dir * 384; const float mx = tb_[256 + t]; float dsum = 0.f;
            unsigned char* pblk = (unsigned char*)(P + ((size_t)(dir * 16 + bh) * 32 + c) * 128 * 128);
#pragma unroll
            for (int mt = 0; mt < 8; ++mt) { const int s0 = 16 * mt + 4 * fq; const f32x4 rs = *(const LAS f32x4*)(tb_ + 128 + s0); float pv[4];
#pragma unroll
                for (int r = 0; r < 4; ++r) { const int s = s0 + r; const bool valid = dir ? (s >= t) : (s <= t);
                    const float wgt = valid ? __expf(fminf(rs[r] - mx, 0.f)) : 0.f; pv[r] = bf2f(f2bf(acc[mt][r] * wgt)); dsum += pv[r]; }
                u32x2 o; o.x = pk2(pv[0], pv[1]); o.y = pk2(pv[2], pv[3]); const int s8 = 2 * mt + (fq >> 1);
                *(u32x2*)(pblk + ((w * 4 + (s8 >> 2)) * 64 + (s8 & 3) * 16 + fr) * 16 + (fq & 1) * 8) = o; }
            dsum += __shfl_xor(dsum, 16); dsum += __shfl_xor(dsum, 32);
            if (fq == 0) ((float*)(p.ws + WS_TOKSC))[((size_t)(dir * 16 + bh) * PLEN + pbase + t) * 4 + 3] = dsum;
        }
    }
    __syncthreads();
}

constexpr int FO_TAB = 131072;
__device__ __forceinline__ int fo_off(int R, int r) { return R * 128 + ((((r >> 3) ^ ((R >> 1) & 7))) << 4) + (r & 7) * 2; }
__device__ __forceinline__ void fourier_item(const Frame& F, const Params& p, int item) {
    const int b = item >> 6, i = item & 63; const int lane = F.lane, w = F.wave, fr = lane & 15, fq = lane >> 4;
    LAS unsigned char* sPQ = F.lds; LAS float* ct = (LAS float*)(F.lds + FO_TAB);
    if (F.tid < 64) ct[F.tid] = cosf((float)F.tid * (6.283185307179586f / 64.0f));
    __syncthreads();
    const bf16* XT = (const bf16*)(p.ws + WS_XFT);
    {
        const bf16* xrow_ = XT + (size_t)(8 * i + w) * TLAT + b * SEQ;
        bf16x8 xv[4][2];
#pragma unroll
        for (int nt = 0; nt < 4; ++nt) { const int r = 16 * nt + fr; xv[nt][0] = *(const bf16x8*)(xrow_ + r * 64 + 8 * fq); xv[nt][1] = *(const bf16x8*)(xrow_ + r * 64 + 32 + 8 * fq); }
#pragma unroll 1
        for (int mt = 0; mt < 8; ++mt) {
            bf16x8 WA[2];
#pragma unroll
            for (int k = 0; k < 2; ++k) { const int kc = (16 * mt + fr) & 63, sh = (mt >> 2) * 48; bf16x8 v;
#pragma unroll
                for (int j = 0; j < 8; ++j) { const int c = 32 * k + 8 * fq + j; v[j] = (short)f2bf(ct[(kc * c + sh) & 63]); }
                WA[k] = v; }
#pragma unroll
            for (int nt = 0; nt < 4; ++nt) { const int r = 16 * nt + fr; f32x4 a = (f32x4){0.f, 0.f, 0.f, 0.f};
                a = __builtin_amdgcn_mfma_f32_16x16x32_bf16(WA[0], xv[nt][0], a, 0, 0, 0); a = __builtin_amdgcn_mfma_f32_16x16x32_bf16(WA[1], xv[nt][1], a, 0, 0, 0);
#pragma unroll
                for (int rg = 0; rg < 4; ++rg) { const int kcp = 16 * mt + 4 * fq + rg; *(LAS unsigned short*)(sPQ + fo_off(kcp * 8 + w, r)) = (unsigned short)f2bf(a[rg]); } } }
    }
    __syncthreads();
    {
        bf16x8 WB[4];
        const int kr = (16 * w + fr) & 63, half = w >> 2;
#pragma unroll
        for (int ks = 0; ks < 4; ++ks) { const int pq = ks >> 1; unsigned short e[8];
#pragma unroll
            for (int j = 0; j < 8; ++j) { const int r = 32 * (ks & 1) + 8 * fq + j;
                float v; if (half == pq) v = ct[(kr * r) & 63]; else { v = ct[(kr * r + 48) & 63]; if (half == 0) v = -v; }
                e[j] = (unsigned short)f2bf(v * 0.015625f); }
            bf16x8 v; v[0] = (short)e[0]; v[1] = (short)e[1]; v[2] = (short)e[2]; v[3] = (short)e[3]; v[4] = (short)e[4]; v[5] = (short)e[5]; v[6] = (short)e[6]; v[7] = (short)e[7]; WB[ks] = v; }
        bf16* UF = (bf16*)(p.ws + WS_UF) + (size_t)(b * SEQ + (16 * (w & 3) + fr) * 64) * D + 16 * i + 8 * half + 4 * (fq & 1);
#pragma unroll 4
        for (int nt = 0; nt < 32; ++nt) { f32x4 a = (f32x4){0.f, 0.f, 0.f, 0.f};
#pragma unroll
            for (int ks = 0; ks < 4; ++ks) { const int R = (ks >> 1) * 512 + 16 * nt + fr, q = 4 * (ks & 1) + fq;
                const bf16x8 bb = *(const LAS bf16x8*)(sPQ + R * 128 + ((q ^ ((R >> 1) & 7)) << 4));
                a = __builtin_amdgcn_mfma_f32_16x16x32_bf16(bb, WB[ks], a, 0, 0, 0); }
            u32x2 o; o.x = pk2(a[0], a[1]); o.y = pk2(a[2], a[3]);
            *(u32x2*)(UF + (size_t)(2 * nt + (fq >> 1)) * D) = o; }
    }
    __syncthreads();
}

constexpr int M2_CT = 0, M2_CTB = 48 * 544, M2_VT = 2 * M2_CTB, M2_VTB = 32 * 288, M2_VW = M2_VT + 2 * M2_VTB, M2_VWB = 48 * 288, M2_TAB = M2_VW + 2 * M2_VWB, M2_TABB = 5 * 512, M2_SC = M2_TAB + 3 * M2_TABB, M2_HS = M2_SC + 1024;
struct M2Step { int cp, is_lat, p0, tl0, tokrow0; };
__device__ __forceinline__ M2Step m2_step(int dir, int b, int j) {
    M2Step s; const int jj = j < NCHK ? j : NCHK - 1;
    s.cp = dir ? (jj == 0 ? 1 : (jj == 1 ? 0 : 35 - jj)) : jj; s.is_lat = s.cp >= 2; s.p0 = CH * s.cp; s.tl0 = s.is_lat ? CH * (s.cp - 2) : 0;
    s.tokrow0 = s.is_lat ? b * SEQ + s.tl0 : TLAT + b * CTXL + CH * s.cp; return s;
}
__device__ __forceinline__ void m2_stream(const Frame& F, const Params& p, int sid) {
    const int x = sid & 7, jj_ = sid >> 3, gl = jj_ >> 3, slice = jj_ & 7, g = x + 8 * gl, dir = g >> 4, bh = g & 15, b = bh >> 2, h = bh & 3;
    int tid = F.tid; asm volatile("" : "+v"(tid)); const int lane = tid & 63, w = F.wave, fr = lane & 15, fq = lane >> 4, wa = w & 3, tr = tid & 255;
    const bool roleA = w < 4;
    LAS unsigned char* L = F.lds;
    LAS float* smst = (LAS float*)(L + M2_SC); LAS float* smnw = smst + 34; LAS float* sdec = smst + 68; LAS float* scs = smst + 102;
    const float* TS = (const float*)(p.ws + WS_TOKSC) + (size_t)(dir * 16 + bh) * PLEN * 4;
    const float* CS = (const float*)(p.ws + WS_CHSC) + (size_t)(dir * 16 + bh) * NCHK * 2;
    const bf16* VT = (const bf16*)(p.ws + WS_VT) + (size_t)(h * 256 + slice * 32 + (tr >> 4)) * MTOK + 8 * (tr & 15);
    const bf16x8* KT = (const bf16x8*)(p.ws + WS_KT) + (size_t)bh * NCHK * 4096 + wa * 1024 + lane;
    const bf16x8* Q = (const bf16x8*)(p.ws + WS_Q) + (size_t)bh * 32 * 4096 + wa * 1024 + lane;
    const bf16x8* P = (const bf16x8*)((const unsigned char*)p.out + DO_P) + (size_t)(dir * 16 + bh) * 32 * 2048 + wa * 512 + lane;
    bf16* H = (bf16*)(p.ws + (dir ? WS_HB : WS_HF)) + (size_t)(b * SEQ) * D + h * 256 + slice * 32;
    for (int i = tid; i < M2_TAB / 4; i += NTHR) ((LAS unsigned*)L)[i] = 0u;
    if (tid < 2 * NCHK) scs[tid] = CS[tid];
    __syncthreads();
    if (tid == 0) { float m = 0.f;
        for (int j = 0; j < NCHK; ++j) { const M2Step st = m2_step(dir, b, j); const float bL = scs[st.cp * 2], gmax = scs[st.cp * 2 + 1];
            const float mn = fmaxf(bL + m, gmax); smst[j] = m; smnw[j] = mn; sdec[j] = __expf(bL + m - mn); m = mn; } }
    __syncthreads();
#define M2_TABLES(jj, stp, sc) do { if (tr < 128 && (jj) < NCHK) { LAS float* tb_ = (LAS float*)(L + M2_TAB + ((jj) % 3) * M2_TABB); const float bL = scs[(stp).cp * 2], mst_ = smst[jj], mnw_ = smnw[jj]; \
        tb_[512 + tr] = __expf(fminf(bL - (sc)[0] + (sc)[1] - mnw_, 0.f)); \
        const float mt_ = fmaxf((sc)[0] + mst_, (sc)[2]); const float c_ = __expf((sc)[2] - mt_); \
        *(LAS f32x4*)(tb_ + 4 * tr) = (f32x4){__expf((sc)[0] + mst_ - mt_), c_, c_ * (sc)[3], __expf(-mt_)}; } } while (0)
#define M2_VSTAGE(jj, va, vb) do { if ((jj) < NCHK) { const LAS float* tb_ = (const LAS float*)(L + M2_TAB + ((jj) % 3) * M2_TABB); const int e = tr >> 4, sg = tr & 15; \
        const f32x4 wa_ = *(const LAS f32x4*)(tb_ + 512 + 8 * sg), wb_ = *(const LAS f32x4*)(tb_ + 516 + 8 * sg); u32x4 o_; \
        *(LAS u32x4*)(L + M2_VT + ((jj) & 1) * M2_VTB + e * 288 + sg * 16) = (va); *(LAS u32x4*)(L + M2_VT + ((jj) & 1) * M2_VTB + (e + 16) * 288 + sg * 16) = (vb); \
        o_[0] = pk2(bflo((va)[0]) * wa_[0], bfhi((va)[0]) * wa_[1]); o_[1] = pk2(bflo((va)[1]) * wa_[2], bfhi((va)[1]) * wa_[3]); o_[2] = pk2(bflo((va)[2]) * wb_[0], bfhi((va)[2]) * wb_[1]); o_[3] = pk2(bflo((va)[3]) * wb_[2], bfhi((va)[3]) * wb_[3]); \
        *(LAS u32x4*)(L + M2_VW + ((jj) & 1) * M2_VWB + e * 288 + sg * 16) = o_; \
        o_[0] = pk2(bflo((vb)[0]) * wa_[0], bfhi((vb)[0]) * wa_[1]); o_[1] = pk2(bflo((vb)[1]) * wa_[2], bfhi((vb)[1]) * wa_[3]); o_[2] = pk2(bflo((vb)[2]) * wb_[0], bfhi((vb)[2]) * wb_[1]); o_[3] = pk2(bflo((vb)[3]) * wb_[2], bfhi((vb)[3]) * wb_[3]); \
        *(LAS u32x4*)(L + M2_VW + ((jj) & 1) * M2_VWB + (e + 16) * 288 + sg * 16) = o_; \
        if (tr < 16) { u32x4 o2; o2[0] = pk2(wa_[0], wa_[1]); o2[1] = pk2(wa_[2], wa_[3]); o2[2] = pk2(wb_[0], wb_[1]); o2[3] = pk2(wb_[2], wb_[3]); \
            *(LAS u32x4*)(L + M2_VW + ((jj) & 1) * M2_VWB + 32 * 288 + tr * 16) = o2; } } } while (0)
#define M2_LDQ(QQ, st) do { const bf16x8* q_ = Q + (size_t)((st).is_lat ? (st).cp - 2 : 0) * 4096; _Pragma("unroll") for (int k = 0; k < 8; ++k) { (QQ)[0][k] = q_[k * 64]; (QQ)[1][k] = q_[(8 + k) * 64]; } } while (0)
#define M2_LDP(st) do { const bf16x8* p_ = P + (size_t)((st).is_lat ? (st).cp - 2 : 0) * 2048; _Pragma("unroll") for (int k = 0; k < 4; ++k) { pa[0][k] = p_[k * 64]; pa[1][k] = p_[(4 + k) * 64]; } } while (0)
#define M2_LDK(KK, st) do { const bf16x8* k_ = KT + (size_t)(st).cp * 4096; _Pragma("unroll") for (int mt = 0; mt < 4; ++mt) _Pragma("unroll") for (int k = 0; k < 4; ++k) (KK)[mt][k] = k_[(mt * 4 + k) * 64]; } while (0)
    const M2Step s0 = m2_step(dir, b, 0), s1 = m2_step(dir, b, 1);
    if (!roleA) { const f32x4 t0 = *(const f32x4*)(TS + (size_t)(s0.p0 + (tr & 127)) * 4), t1 = *(const f32x4*)(TS + (size_t)(s1.p0 + (tr & 127)) * 4);
        M2_TABLES(0, s0, t0); M2_TABLES(1, s1, t1); }
    __syncthreads();
    if (!roleA) { const u32x4 v0a = *(const u32x4*)(VT + s0.tokrow0), v0b = *(const u32x4*)(VT + (size_t)16 * MTOK + s0.tokrow0); M2_VSTAGE(0, v0a, v0b); }
    if (roleA) {
        bf16x8 qa[2][2][8], pa[2][4];
        M2_LDQ(qa[0], s0); M2_LDP(s0);
        __syncthreads();
        for (int jj = 0; jj < NCHK; jj += 2) {
#pragma unroll
          for (int u = 0; u < 2; ++u) { const int j = jj + u;
            const M2Step sj = m2_step(dir, b, j), sn = m2_step(dir, b, j + 1);
            M2_LDQ(qa[u ^ 1], sn);
            if (j > 0) { const M2Step sp = m2_step(dir, b, j - 1);
                if (sp.is_lat) {
#pragma unroll
                    for (int i2 = 0; i2 < 2; ++i2) { const int pc = tr + 256 * i2; const u32x4 hv = *(const LAS u32x4*)(L + M2_HS + ((j - 1) & 1) * 8192 + pc * 16);
                        *(u32x4*)(H + (size_t)(sp.tl0 + (pc >> 2)) * D + (pc & 3) * 8) = hv; } } }
            if (sj.is_lat) {
                const LAS unsigned char* sCT = L + M2_CT + (j & 1) * M2_CTB; const LAS unsigned char* sVT = L + M2_VT + (j & 1) * M2_VTB;
                const LAS float* tb = (const LAS float*)(L + M2_TAB + (j % 3) * M2_TABB);
                f32x4 aI[2][3], aA[2][2];
#pragma unroll
                for (int mt = 0; mt < 2; ++mt) {
#pragma unroll
                    for (int nt = 0; nt < 3; ++nt) aI[mt][nt] = (f32x4){0.f, 0.f, 0.f, 0.f};
                    aA[mt][0] = (f32x4){0.f, 0.f, 0.f, 0.f}; aA[mt][1] = (f32x4){0.f, 0.f, 0.f, 0.f}; }
                bf16x8 bc[3], bn[3];
#pragma unroll
                for (int nt = 0; nt < 3; ++nt) bc[nt] = *(const LAS bf16x8*)(sCT + (16 * nt + fr) * 544 + (8 * fq) * 2);
#pragma unroll
                for (int k = 0; k < 8; ++k) {
                    if (k < 7) {
#pragma unroll
                        for (int nt = 0; nt < 3; ++nt) bn[nt] = *(const LAS bf16x8*)(sCT + (16 * nt + fr) * 544 + (32 * (k + 1) + 8 * fq) * 2); }
#pragma unroll
                    for (int nt = 0; nt < 3; ++nt) {
                        aI[0][nt] = __builtin_amdgcn_mfma_f32_16x16x32_bf16(qa[u][0][k], bc[nt], aI[0][nt], 0, 0, 0);
                        aI[1][nt] = __builtin_amdgcn_mfma_f32_16x16x32_bf16(qa[u][1][k], bc[nt], aI[1][nt], 0, 0, 0); }
#pragma unroll
                    for (int nt = 0; nt < 3; ++nt) bc[nt] = bn[nt]; }
                { bf16x8 vc[2], vn2[2];
#pragma unroll
                  for (int nt = 0; nt < 2; ++nt) vc[nt] = *(const LAS bf16x8*)(sVT + (16 * nt + fr) * 288 + (8 * fq) * 2);
#pragma unroll
                  for (int k = 0; k < 4; ++k) {
                    if (k < 3) {
#pragma unroll
                        for (int nt = 0; nt < 2; ++nt) vn2[nt] = *(const LAS bf16x8*)(sVT + (16 * nt + fr) * 288 + (32 * (k + 1) + 8 * fq) * 2); }
#pragma unroll
                    for (int nt = 0; nt < 2; ++nt) {
                        aA[0][nt] = __builtin_amdgcn_mfma_f32_16x16x32_bf16(pa[0][k], vc[nt], aA[0][nt], 0, 0, 0);
                        aA[1][nt] = __builtin_amdgcn_mfma_f32_16x16x32_bf16(pa[1][k], vc[nt], aA[1][nt], 0, 0, 0); }
                    vc[0] = vn2[0]; vc[1] = vn2[1]; } }
                M2_LDP(sn);
                LAS unsigned short* sH = (LAS unsigned short*)(L + M2_HS + (j & 1) * 8192);
#pragma unroll
                for (int mt = 0; mt < 2; ++mt)
#pragma unroll
                    for (int rg = 0; rg < 4; ++rg) { const int t = 32 * wa + 16 * mt + 4 * fq + rg;
                        const float qn_ = __shfl(aI[mt][2][rg], lane & 48);
                        const f32x4 tv = *(const LAS f32x4*)(tb + 4 * t);
                        const float inv = __builtin_amdgcn_rcpf(fmaxf(fabsf(tv[0] * qn_ + tv[2]), tv[3]));
                        const unsigned hp = pk2((tv[0] * aI[mt][0][rg] + tv[1] * aA[mt][0][rg]) * inv, (tv[0] * aI[mt][1][rg] + tv[1] * aA[mt][1][rg]) * inv);
                        sH[t * 32 + fr] = (unsigned short)hp; sH[t * 32 + 16 + fr] = (unsigned short)(hp >> 16); }
            } else { M2_LDP(sn); }
            __syncthreads();
          }
        }
        { const M2Step sp = m2_step(dir, b, NCHK - 1);
          if (sp.is_lat) {
#pragma unroll
            for (int i2 = 0; i2 < 2; ++i2) { const int pc = tr + 256 * i2; const u32x4 hv = *(const LAS u32x4*)(L + M2_HS + ((NCHK - 1) & 1) * 8192 + pc * 16);
                *(u32x4*)(H + (size_t)(sp.tl0 + (pc >> 2)) * D + (pc & 3) * 8) = hv; } } }
    } else {
        bf16x8 ka[2][4][4];
        f32x4 accC[4][3];
#pragma unroll
        for (int mt = 0; mt < 4; ++mt)
#pragma unroll
            for (int nt = 0; nt < 3; ++nt) accC[mt][nt] = (f32x4){0.f, 0.f, 0.f, 0.f};
        M2_LDK(ka[0], s0);
        u32x4 vna = *(const u32x4*)(VT + s1.tokrow0), vnb = *(const u32x4*)(VT + (size_t)16 * MTOK + s1.tokrow0);
        f32x4 tn2 = *(const f32x4*)(TS + (size_t)(m2_step(dir, b, 2).p0 + (tr & 127)) * 4);
        __syncthreads();
        for (int jj = 0; jj < NCHK; jj += 2) {
#pragma unroll
          for (int u = 0; u < 2; ++u) { const int j = jj + u;
            const M2Step sn = m2_step(dir, b, j + 1), sn2 = m2_step(dir, b, j + 2);
            M2_LDK(ka[u ^ 1], sn);
            const LAS unsigned char* sVW = L + M2_VW + (j & 1) * M2_VWB; const float dec = sdec[j];
            const u32x4 vxa = *(const u32x4*)(VT + sn2.tokrow0), vxb = *(const u32x4*)(VT + (size_t)16 * MTOK + sn2.tokrow0);
            const f32x4 tn3 = *(const f32x4*)(TS + (size_t)(m2_step(dir, b, j + 3).p0 + (tr & 127)) * 4);
#pragma unroll
            for (int mt = 0; mt < 4; ++mt)
#pragma unroll
                for (int nt = 0; nt < 3; ++nt) accC[mt][nt] = accC[mt][nt] * dec;
            { bf16x8 wc[3], wn[3];
#pragma unroll
              for (int nt = 0; nt < 3; ++nt) wc[nt] = *(const LAS bf16x8*)(sVW + (16 * nt + fr) * 288 + (8 * fq) * 2);
#pragma unroll
              for (int k = 0; k < 4; ++k) {
                if (k < 3) {
#pragma unroll
                    for (int nt = 0; nt < 3; ++nt) wn[nt] = *(const LAS bf16x8*)(sVW + (16 * nt + fr) * 288 + (32 * (k + 1) + 8 * fq) * 2); }
#pragma unroll
                for (int nt = 0; nt < 3; ++nt)
#pragma unroll
                    for (int mt = 0; mt < 4; ++mt) accC[mt][nt] = __builtin_amdgcn_mfma_f32_16x16x32_bf16(ka[u][mt][k], wc[nt], accC[mt][nt], 0, 0, 0);
#pragma unroll
                for (int nt = 0; nt < 3; ++nt) wc[nt] = wn[nt]; } }
            { LAS unsigned char* dCT = L + M2_CT + ((j + 1) & 1) * M2_CTB;
#pragma unroll
              for (int mt = 0; mt < 4; ++mt)
#pragma unroll
                for (int nt = 0; nt < 3; ++nt) { u32x2 o; o.x = pk2(accC[mt][nt][0], accC[mt][nt][1]); o.y = pk2(accC[mt][nt][2], accC[mt][nt][3]);
                    *(LAS u32x2*)(dCT + (16 * nt + fr) * 544 + (64 * wa + 16 * mt + 4 * fq) * 2) = o; } }
            M2_VSTAGE(j + 1, vna, vnb);
            M2_TABLES(j + 2, sn2, tn2);
            vna = vxa; vnb = vxb; tn2 = tn3;
            __syncthreads();
          }
        }
    }
    __syncthreads();
#undef M2_LDQ
#undef M2_LDP
#undef M2_LDK
#undef M2_TABLES
#undef M2_VSTAGE
}

#define XB_TMO      128
#define XB_XCNT(j)  (256  + 64 * (j))
#define XB_XSUB(j)  (1280 + 64 * (j))
#define XB_XGEN(j)  (2304 + 64 * (j))
#define XB_TOP      3328
#define XB_TOPGEN   3392
#define XB_SPIN_CAP (1u << 22)
__device__ __forceinline__ unsigned xb_ld(unsigned* p)              { return __hip_atomic_load(p, __ATOMIC_RELAXED, __HIP_MEMORY_SCOPE_AGENT); }
__device__ __forceinline__ unsigned xb_add(unsigned* p, unsigned v) { return __hip_atomic_fetch_add(p, v, __ATOMIC_RELAXED, __HIP_MEMORY_SCOPE_AGENT); }
__device__ __forceinline__ unsigned xb_xcc_id() { return (unsigned)__builtin_amdgcn_s_getreg((3 << 11) | 20) & 0xFu; }
#define XB_SPIN(cond, bar) do { unsigned _sp = 0; while (cond) { __builtin_amdgcn_s_sleep(1); \
    if ((++_sp & 255u) == 0u) { if (xb_ld(&(bar)[XB_TMO])) break; if (_sp > XB_SPIN_CAP) { atomicAdd(&(bar)[XB_TMO], 1u); break; } } } } while (0)
struct XcdBarrier { unsigned* bar; unsigned x; volatile LAS unsigned* st; };
__device__ __forceinline__ XcdBarrier xcd_barrier_post(unsigned* bar, volatile LAS unsigned* st) {
    XcdBarrier b; b.bar = bar; b.x = xb_xcc_id(); b.st = st;
    if (threadIdx.x == 0) (void)xb_add(&bar[XB_XCNT(b.x)], 1u);
    return b;
}
__device__ __forceinline__ void xcd_barrier_complete(unsigned* bar, unsigned x, unsigned& nloc, unsigned& nx) {
    const unsigned G = gridDim.x * gridDim.y * gridDim.z;
    unsigned sum, cnt, mine, sp = 0u;
    for (;;) {
        sum = 0u; cnt = 0u; mine = 0u;
#pragma unroll
        for (unsigned j = 0; j < 16; ++j) { const unsigned c = xb_ld(&bar[XB_XCNT(j)]); sum += c; cnt += (c > 0u) ? 1u : 0u; mine = (j == x) ? c : mine; }
        if (sum == G) break;
        __builtin_amdgcn_s_sleep(1);
        if ((++sp & 255u) == 0u) { if (xb_ld(&bar[XB_TMO])) break; if (sp > XB_SPIN_CAP) { atomicAdd(&bar[XB_TMO], 1u); break; } }
    }
    nloc = mine > 0u ? mine : 1u; nx = cnt > 0u ? cnt : 1u;
}
__device__ __forceinline__ void xcd_barrier(const XcdBarrier& b) {
    asm volatile("s_waitcnt vmcnt(0)" ::: "memory");
    __syncthreads();
    if (threadIdx.x == 0) {
        unsigned* bar = b.bar;
        __builtin_amdgcn_s_waitcnt(0);
        unsigned nloc = b.st[0], nx = b.st[1];
        if (nloc == 0u) { xcd_barrier_complete(bar, b.x, nloc, nx); b.st[0] = nloc; b.st[1] = nx; }
        const unsigned old = xb_add(&bar[XB_XSUB(b.x)], 1u);
        const unsigned gen = old / nloc;
        if (old + 1u == (gen + 1u) * nloc) {
            __builtin_amdgcn_fence(__ATOMIC_RELEASE, "agent");
            asm volatile("s_waitcnt vmcnt(0)" ::: "memory");
            const unsigned og = xb_add(&bar[XB_TOP], 1u);
            const unsigned tg = og / nx;
            if (og + 1u == (tg + 1u) * nx) xb_add(&bar[XB_TOPGEN], 1u);
            else XB_SPIN(xb_ld(&bar[XB_TOPGEN]) == tg, bar);
            __builtin_amdgcn_fence(__ATOMIC_ACQUIRE, "agent");
            xb_add(&bar[XB_XGEN(b.x)], 1u);
            asm volatile("s_waitcnt vmcnt(0)" ::: "memory");
        } else {
            XB_SPIN(xb_ld(&bar[XB_XGEN(b.x)]) == gen, bar);
            __builtin_amdgcn_fence(__ATOMIC_ACQUIRE, "agent");
            asm volatile("s_waitcnt vmcnt(0)" ::: "memory");
        }
    }
    __syncthreads();
}

__device__ __forceinline__ pg8::Seg mkseg(const void* A0, const void* B0, int nM, int nN, int kind, int ksplit = 1) { pg8::Seg s; s.A0 = (const char*)A0; s.B0 = (const char*)B0; s.nM = nM; s.nN = nN; s.kind = kind; s.ksplit = ksplit; return s; }
__device__ __forceinline__ pg8::Sched mksched(int K) { pg8::Sched S; S.s[0] = S.s[1] = S.s[2] = S.s[3] = mkseg(nullptr, nullptr, 0, 0, 0); S.G = gridDim.x; S.c = blockIdx.x; S.tstep = (size_t)256 * K * 2; S.ntk = K / 64; return S; }

__global__ void __launch_bounds__(NTHR) mega_fwd(Params p) {
    extern __shared__ __attribute__((aligned(16))) unsigned char lds_raw[];
    Frame F;
#define REFRAME() do { int t_ = threadIdx.x; asm volatile("" : "+v"(t_)); F.lds = (LAS unsigned char*)lds_raw; F.tid = t_; F.lane = t_ & 63; F.wave = __builtin_amdgcn_readfirstlane(t_ >> 6); \
        F.gw = blockIdx.x * NWAVE + F.wave; F.ngw = gridDim.x * NWAVE; } while (0)
    REFRAME();
    unsigned char* ws = p.ws; unsigned char* dout = (unsigned char*)p.out;
    volatile LAS unsigned* bst = (volatile LAS unsigned*)(F.lds + LDS_BYTES - 16);
    if (F.tid < 4) bst[F.tid] = 0u;
    __syncthreads();
    const XcdBarrier gbar = xcd_barrier_post((unsigned*)(ws + WS_BAR), bst);
#define GSYNC() do { xcd_barrier(gbar); REFRAME(); } while (0)

    ada_phase(F, p);
    wfour_phase(F, p);
    {
        constexpr int I13 = 16 * 176, I2 = 44 * 32, IIN = 16 * (WIN_ROWS / 32), ISQ = 16 * 32;
        Frame F2 = F; const bool extra = gridDim.x == 256 && blockIdx.x >= 144; F2.gw = (blockIdx.x - 144) * NWAVE + F.wave; F2.ngw = 112 * NWAVE;
#define CONV_SPLIT(CALL_A, CALL_B) do { CALL_A; if (gridDim.x != 256) { Frame F2 = F; CALL_B; } else if (extra) { CALL_B; } } while (0)
        { constexpr int A = I13 * 55 / 100; CONV_SPLIT(conv_w13(F, p.w13_a, (bf16*)(ws + WS_W13), 0, A), conv_w13(F2, p.w13_a, (bf16*)(ws + WS_W13), A, I13 - A)); }
        { constexpr int A = I2 * 55 / 100; CONV_SPLIT(conv_plain(F, p.w2_a, FF, D, (bf16*)(ws + WS_W2), 0, A), conv_plain(F2, p.w2_a, FF, D, (bf16*)(ws + WS_W2), A, I2 - A)); }
        { constexpr int A = IIN * 55 / 100; CONV_SPLIT(conv_win(F, p.w_in, (bf16*)(ws + WS_WIN), 0, A), conv_win(F2, p.w_in, (bf16*)(ws + WS_WIN), A, IIN - A)); }
        { constexpr int A = ISQ * 55 / 100; CONV_SPLIT(conv_plain(F, p.w_mproj, D, D, (bf16*)(ws + WS_WMPROJ), 0, A), conv_plain(F2, p.w_mproj, D, D, (bf16*)(ws + WS_WMPROJ), A, ISQ - A));
          CONV_SPLIT(conv_plain(F, p.w_out, D, D, (bf16*)(ws + WS_WOUT), 0, A), conv_plain(F2, p.w_out, D, D, (bf16*)(ws + WS_WOUT), A, ISQ - A)); }
#undef CONV_SPLIT
        { LAS float* scr = (LAS float*)(F.lds + F.wave * 16384);
          for (int it = F.gw; it < 16; it += F.ngw) transpose_item(p.w_in, D, INW, (bf16*)(ws + WS_WG), 0, COL_GATES, 64 * it, scr, F.lane);
          u32x4* z = (u32x4*)(ws + WS_WG + 32 * D * 2); for (int i = blockIdx.x * NTHR + F.tid; i < 224 * D * 2 / 16; i += gridDim.x * NTHR) z[i] = (u32x4){0u, 0u, 0u, 0u}; }
    }
    GSYNC();
    phase_u1(F, p);
    GSYNC();
    { pg8::Sched S = mksched(D); S.s[0] = mkseg(ws + WS_U, ws + WS_W13, MTOK / 256, 22, 0); EpiSwiglu E{(bf16*)(ws + WS_ACT)}; pg8::gemm_phase(F.lds, D, S, E); }
    GSYNC();
    { pg8::Sched S = mksched(FF); S.s[0] = mkseg(ws + WS_ACT, ws + WS_W2, TLAT / 256, 4, 0); S.s[1] = mkseg(ws + WS_ACT + (size_t)TLAT * FF * 2, ws + WS_W2, TCTX / 256, 4, 1, 8);
      EpiDownA E{(bf16*)(ws + WS_Y1), (float*)(ws + WS_Y1C)}; pg8::gemm_phase(F.lds, FF, S, E); }
    GSYNC();
    phase_post_ffn_a(F, p);
    GSYNC();
    { pg8::Sched S = mksched(D); const unsigned char* W = ws + WS_WIN;
      S.s[0] = mkseg(ws + WS_U2, W + (size_t)ROW_Q * D * 2, MTOK / 256, 8, 0);
      S.s[1] = mkseg(W + (size_t)ROW_V * D * 2, ws + WS_U2, 4, MTOK / 256, 2);
      S.s[2] = mkseg(W + (size_t)ROW_F * D * 2, ws + WS_U2, 2, TLAT / 256, 3);
      S.s[3] = mkseg(ws + WS_U2, ws + WS_WG, MTOK / 256, 1, 4);
      EpiProjA E{(bf16*)(ws + WS_QPRE), (bf16*)(ws + WS_KPRE), (bf16*)(ws + WS_VT), (bf16*)(ws + WS_XFT), p.b_in, (float*)(ws + WS_GATES)}; pg8::gemm_phase(F.lds, D, S, E); }
    GSYNC();
    for (int it = blockIdx.x; it < 16 * NCHK; it += gridDim.x) { if (it < 512) m1_item(F, p, it & 15, 2 + (it >> 4)); else m1_item(F, p, (it - 512) & 15, (it - 512) >> 4); }
    GSYNC();
    for (int sid = blockIdx.x; sid < 256; sid += gridDim.x) m2_stream(F, p, sid);
    GSYNC();
    { const bool swp = (blockIdx.x >> 3) & 1;
      if (swp) { for (int it = blockIdx.x; it < 256; it += gridDim.x) fourier_item(F, p, it);
                 constexpr int I13 = 16 * 176, I2 = 44 * 32; conv_w13(F, p.w13_b, (bf16*)(ws + WS_W13B), 0, I13); conv_plain(F, p.w2_b, FF, D, (bf16*)(ws + WS_W2B), 0, I2); __syncthreads(); }
      { pg8::Sched S = mksched(D); S.s[0] = mkseg(ws + WS_U2, ws + WS_WIN + (size_t)ROW_O * D * 2, TLAT / 256, 4, 0);
        EpiX E{(bf16*)(ws + WS_HM), (bf16*)(dout + DO_TF), (const bf16*)(ws + WS_HF), (const bf16*)(ws + WS_HB), p.b_in, p.head_g, (LAS float*)(F.lds + pg8::STAGE_BYTES)}; pg8::gemm_phase(F.lds, D, S, E); }
      if (!swp) { __syncthreads(); for (int it = blockIdx.x; it < 256; it += gridDim.x) fourier_item(F, p, it);
                 constexpr int I13 = 16 * 176, I2 = 44 * 32; conv_w13(F, p.w13_b, (bf16*)(ws + WS_W13B), 0, I13); conv_plain(F, p.w2_b, FF, D, (bf16*)(ws + WS_W2B), 0, I2); } }
    GSYNC();
    if (gridDim.x == 256) {
      pg8::SchedY S; S.base = mksched(D); S.base.s[0] = mkseg(ws + WS_HM, ws + WS_WMPROJ, TLAT / 256, 4, 1); S.base.s[1] = mkseg(ws + WS_UF, ws + WS_WFOUR, TLAT / 256, 4, 2); S.Ag = (const char*)(ws + WS_U2); S.Bg = (const char*)(ws + WS_WIN + (size_t)ROW_GF * D * 2);
      EpiY E{(bf16*)(dout + DO_TF), (bf16*)(ws + WS_TM), p.b_in}; pg8::gemm_phase(F.lds, D, S, E);
    } else {
      { pg8::Sched S = mksched(D); S.s[0] = mkseg(ws + WS_HM, ws + WS_WMPROJ, TLAT / 256, 4, 1); S.s[1] = mkseg(ws + WS_UF, ws + WS_WFOUR, TLAT / 256, 4, 2); EpiY E{(bf16*)(dout + DO_TF), (bf16*)(ws + WS_TM), p.b_in}; pg8::gemm_phase(F.lds, D, S, E); }
      GSYNC();
      { pg8::Sched S = mksched(D); S.s[0] = mkseg(ws + WS_U2, ws + WS_WIN + (size_t)ROW_GF * D * 2, TLAT / 256, 8, 0); EpiY E{(bf16*)(dout + DO_TF), (bf16*)(ws + WS_TM), p.b_in}; pg8::gemm_phase(F.lds, D, S, E); }
    }
    GSYNC();
    { pg8::Sched S = mksched(D); S.s[0] = mkseg(ws + WS_TM, ws + WS_WOUT, TLAT / 256, 4, 0);
      float* xb = (float*)(ws + WS_XCH); unsigned* xc = (unsigned*)(ws + WS_XCNT);
      EpiMix E{p.x, p.norm_g + 3 * D, p.norm_g + 4 * D, (const float*)(ws + WS_MOD), (const bf16*)(dout + DO_D1), (bf16*)(ws + WS_D12), (bf16*)(dout + DO_U3),
               PanelRms{xb, xc}, PanelRms{xb + 65536, xc + 64 * 64}, (LAS float*)(F.lds + pg8::STAGE_BYTES)};
      if (gridDim.x == 256) pg8::gemm_phase(F.lds, D, S, E); }
    GSYNC();
    { pg8::Sched S = mksched(D); S.s[0] = mkseg(dout + DO_U3, ws + WS_W13B, TLAT / 256, 22, 0); EpiSwiglu E{(bf16*)(ws + WS_ACT2)}; pg8::gemm_phase(F.lds, D, S, E); }
    GSYNC();
    { pg8::Sched S = mksched(FF); S.s[0] = mkseg(ws + WS_ACT2, ws + WS_W2B, TLAT / 256, 4, 0);
      EpiFinal E{p.x, p.norm_g + 5 * D, (const float*)(ws + WS_MOD), (const bf16*)(ws + WS_D12), p.out, PanelRms{(float*)(ws + WS_XCH) + 2 * 65536, (unsigned*)(ws + WS_XCNT) + 2 * 64 * 64}, (LAS float*)(F.lds + pg8::STAGE_BYTES)};
      if (gridDim.x == 256) pg8::gemm_phase(F.lds, FF, S, E); }
}

extern "C" void kernel_launch(void* const* d_in, const int* in_sizes, int n_in, void* d_out, int out_size, void* d_ws, size_t ws_size, hipStream_t stream) {
    static int grid = 0;
    if (grid == 0) {
        if (n_in != 19 || out_size != TLAT * D || ws_size < WS_NEED) { fprintf(stderr, "kernel_launch: unexpected problem (n_in %d, out %d, ws %zu)\n", n_in, out_size, ws_size); grid = -1; return; }
        int dev = 0, cus = 0, per_cu = 0;
        if (hipGetDevice(&dev) != hipSuccess || hipDeviceGetAttribute(&cus, hipDeviceAttributeMultiprocessorCount, dev) != hipSuccess) { grid = -1; return; }
        if (hipFuncSetAttribute((const void*)mega_fwd, hipFuncAttributeMaxDynamicSharedMemorySize, LDS_BYTES) != hipSuccess) { fprintf(stderr, "kernel_launch: hipFuncSetAttribute failed\n"); grid = -1; return; }
        if (hipOccupancyMaxActiveBlocksPerMultiprocessor(&per_cu, (const void*)mega_fwd, NTHR, LDS_BYTES) != hipSuccess || per_cu < 1) { fprintf(stderr, "kernel_launch: occupancy query failed (%d)\n", per_cu); (void)hipGetLastError(); grid = -1; return; }
        grid = cus * 1;
        if (grid != 256) fprintf(stderr, "kernel_launch: built for a 256-CU device (fused norm epilogues need one 256x256 unit per workgroup); got %d\n", grid);
        fprintf(stderr, "kernel_launch: %d CUs, %d blocks/CU by the occupancy query, grid %d\n", cus, per_cu, grid);
    }
    if (grid < 0) return;
    Params p{};
    const float** f = (const float**)&p;
    for (int i = 0; i < 19; ++i) f[i] = (const float*)d_in[i];
    p.out = (float*)d_out; p.ws = (unsigned char*)d_ws;
    (void)hipMemsetAsync((char*)d_ws + WS_BAR, 0, 64 * 1024, stream);
    void* args[] = {&p};
    hipError_t e = hipLaunchCooperativeKernel((const void*)mega_fwd, dim3(grid), dim3(NTHR), args, LDS_BYTES, stream);
    if (e != hipSuccess) fprintf(stderr, "kernel_launch: cooperative launch failed: %s (grid %d)\n", hipGetErrorString(e), grid);
}
```

```cpp
#include <hip/hip_runtime.h>
#include <hip/hip_cooperative_groups.h>
#include <cstdio>
#include <cstdint>
namespace cg = cooperative_groups;

#define LAS __attribute__((address_space(3)))
typedef unsigned short bf16;
typedef short bf16x8 __attribute__((ext_vector_type(8)));
typedef float f32x4 __attribute__((ext_vector_type(4)));
typedef float f32x2 __attribute__((ext_vector_type(2)));
typedef unsigned u32x4 __attribute__((ext_vector_type(4)));
typedef unsigned u32x2 __attribute__((ext_vector_type(2)));

constexpr int D = 1024, NB = 4, SEQ = 4096, CTXL = 256, FF = 2816, NH = 4, DH = 256, CH = 128;
constexpr int TLAT = NB * SEQ;
constexpr int TCTX = NB * CTXL;
constexpr int MTOK = TLAT + TCTX;
constexpr int INW = 6672;
constexpr int PLEN = CTXL + SEQ;
constexpr int NCHK = PLEN / CH;
constexpr float EPS = 1e-6f;
constexpr int NTHR = 512, NWAVE = 8;
constexpr int LDS_BYTES = 147456;

constexpr size_t MiB = 1u << 20;
constexpr size_t WS_MOD = 0;
constexpr size_t WS_BAR = 256 * 1024;
constexpr size_t WS_GATES = 512 * 1024;
constexpr size_t WS_TOKSC = 2 * MiB;
constexpr size_t WS_CHSC = 5 * MiB;
constexpr size_t WS_WG = 7 * MiB;
constexpr size_t WS_XCH = 6 * MiB;
constexpr size_t WS_XCNT = WS_BAR + 16 * 1024;
constexpr size_t WS_XCH2 = 5 * MiB + 256 * 1024;
constexpr size_t WS_W13 = 8 * MiB, WS_W2 = 19 * MiB, WS_WIN = 25 * MiB, WS_WFOUR = 38 * MiB, WS_WMPROJ = 40 * MiB, WS_WOUT = 42 * MiB;
constexpr size_t WS_XFT = 8 * MiB;
constexpr size_t WS_U = 44 * MiB;
constexpr size_t WS_U2 = 210 * MiB;
constexpr size_t WS_ACT = 78 * MiB;
constexpr size_t WS_Y1 = 172 * MiB;
constexpr size_t WS_Y1C = 44 * MiB;
constexpr size_t WS_QPRE = 78 * MiB;
constexpr size_t WS_KPRE = 110 * MiB;
constexpr size_t WS_VT = 144 * MiB;
constexpr size_t WS_Q = 178 * MiB;
constexpr size_t WS_UF = 142 * MiB;
constexpr size_t WS_KT = 44 * MiB;
constexpr size_t WS_HF = 78 * MiB, WS_HB = 110 * MiB;
constexpr size_t WS_HM = 174 * MiB;
constexpr size_t DO_TF = 32 * MiB;
constexpr size_t WS_W13B = 244 * MiB, WS_W2B = 55 * MiB;
constexpr size_t WS_TM = 78 * MiB;
constexpr size_t WS_OUTL = 110 * MiB;
constexpr size_t WS_D12 = 110 * MiB;
constexpr size_t WS_ACT2 = 142 * MiB;
constexpr size_t WS_Y3 = 164 * MiB;
constexpr size_t WS_NEED = 256 * MiB;
constexpr size_t DO_D1 = 0, DO_P = 32 * MiB, DO_U3 = 32 * MiB;

constexpr int COL_F = 0, COL_Q = 512, COL_K = 1536, COL_V = 2560, COL_O = 3584, COL_GATES = 4608, COL_GF = 4624, COL_GM = 5648;
constexpr int ROW_Q = 0, ROW_K = 1024, ROW_V = 2048, ROW_F = 3072, ROW_O = 3584, ROW_GF = 4608, ROW_GM = 5632, WIN_ROWS = 6656;

struct Params {
    const float *x, *c, *ctx, *c_ctx, *w_ada, *b_ada, *norm_g, *w13_a, *w2_a, *w_in, *b_in, *conv_w, *conv_b, *head_g, *w_four, *w_mproj, *w_out, *w13_b, *w2_b;
    float* out; unsigned char* ws;
};

typedef __bf16 bf16x2_t __attribute__((ext_vector_type(2)));
__device__ __forceinline__ unsigned f2bf(float f) { return (unsigned)__builtin_bit_cast(unsigned short, (__bf16)f); }
__device__ __forceinline__ unsigned pk2(float lo, float hi) { bf16x2_t v; v[0] = (__bf16)lo; v[1] = (__bf16)hi; return __builtin_bit_cast(unsigned, v); }
__device__ __forceinline__ float bf2f(unsigned b) { return __builtin_bit_cast(float, b << 16); }
__device__ __forceinline__ float bflo(unsigned w) { return __builtin_bit_cast(float, w << 16); }
__device__ __forceinline__ float bfhi(unsigned w) { return __builtin_bit_cast(float, w & 0xffff0000u); }
__device__ __forceinline__ unsigned cvt_pk_bf16(float lo, float hi) { return pk2(lo, hi); }
#define DPP_F(v, ctrl) __builtin_bit_cast(float, __builtin_amdgcn_update_dpp(0, __builtin_bit_cast(int, (v)), (ctrl), 0xf, 0xf, false))
__device__ __forceinline__ float row16_sum(float v) {
    v += DPP_F(v, 0xB1);
    v += DPP_F(v, 0x4E);
    v += DPP_F(v, 0x141);
    v += DPP_F(v, 0x140);
    return v;
}
__device__ __forceinline__ float rlane(float v, int l) { return __builtin_bit_cast(float, __builtin_amdgcn_readlane(__builtin_bit_cast(int, v), l)); }
__device__ __forceinline__ float wave_sum(float v) { v = row16_sum(v); return (rlane(v, 0) + rlane(v, 16)) + (rlane(v, 32) + rlane(v, 48)); }
__device__ __forceinline__ float sigmoidf_(float x) { return __builtin_amdgcn_rcpf(1.0f + __expf(-x)); }
__device__ __forceinline__ float sigmoid2_(float xs) { return __builtin_amdgcn_rcpf(1.0f + __builtin_amdgcn_exp2f(xs)); }
__device__ __forceinline__ float sigmoid2b_(float xs, float eb) { return __builtin_amdgcn_rcpf(__builtin_fmaf(__builtin_amdgcn_exp2f(xs), eb, 1.0f)); }
__device__ __forceinline__ float siluf_(float x) { return x * __builtin_amdgcn_rcpf(1.0f + __expf(-x)); }
#define LDS_WAIT() asm volatile("s_waitcnt lgkmcnt(0)" ::: "memory")
#define VM_WAIT() asm volatile("s_waitcnt vmcnt(0)" ::: "memory")

namespace pg8 {
constexpr int BM = 256, BK = 64, HALF = 128, HTB = HALF * BK * 2, STAGE_BYTES = 8 * HTB, NXCD = 8, WGM = 8;
__host__ __device__ __forceinline__ int lds_byte(int r, int c) { const int st = (r >> 4) * 2 + (c >> 5), rr = r & 15, cc = c & 31, ob = rr * 64 + cc * 2; return st * 1024 + (ob ^ (((ob >> 9) & 1) << 5)); }
__host__ __device__ __forceinline__ void stage_rc(int b, int& R, int& C) { const int st = b / 1024, sb = b % 1024, swz = sb ^ (((sb >> 9) & 1) << 5); R = (st >> 1) * 16 + swz / 64; C = (st & 1) * 32 + (swz % 64) / 2; }
__host__ __device__ __forceinline__ int perm32(int rho) { const int n = rho >> 4, i = rho & 15; return 8 * (i >> 2) + 4 * n + (i & 3); }

struct Unit { const char* A; const char* B; int kind, pm, pn, nt, kq; };
struct Seg { const char* A0; const char* B0; int nM, nN, kind, ksplit; };
struct Sched {
    Seg s[4]; int G, c; size_t tstep;
    int ntk;
    __device__ __forceinline__ bool pick(const Seg& sg, long& L, Unit& u) const {
        const int nwg = sg.nM * sg.nN * sg.ksplit;
        if (L >= nwg) { L -= nwg; return false; }
        if (sg.ksplit > 1) { const int tiles = sg.nM * sg.nN, kq = (int)L / tiles, tl = (int)L % tiles; u.pm = tl % sg.nM; u.pn = tl / sg.nM; u.kind = sg.kind;
            const int kt0 = kq * 6 - (kq > 6 ? 2 : 0); u.nt = kq < 6 ? 6 : 4; u.kq = kq;
            u.A = sg.A0 + (size_t)u.pm * tstep + kt0 * 128; u.B = sg.B0 + (size_t)u.pn * tstep + kt0 * 128; return true; }
        u.nt = ntk; u.kq = 0;
        int wgid = (int)L; { const int q = nwg / NXCD, r = nwg % NXCD, xcd = wgid % NXCD, off = wgid / NXCD; wgid = (xcd < r ? xcd * (q + 1) : r * (q + 1) + (xcd - r) * q) + off; }
        const int nig = WGM * sg.nN, gid = wgid / nig, fm = gid * WGM, gsz = (sg.nM - fm) < WGM ? (sg.nM - fm) : WGM;
        u.pm = fm + ((wgid % nig) % gsz); u.pn = (wgid % nig) / gsz; u.kind = sg.kind;
        u.A = sg.A0 + (size_t)u.pm * tstep; u.B = sg.B0 + (size_t)u.pn * tstep; return true;
    }
    __device__ __forceinline__ bool next(int i, Unit& u) const {
        long L = (long)i * G + c;
        if (pick(s[0], L, u)) return true;
        if (pick(s[1], L, u)) return true;
        if (pick(s[2], L, u)) return true;
        if (pick(s[3], L, u)) return true;
        return false;
    }
};

struct SchedY {
    Sched base; const char* Ag; const char* Bg;
    __device__ __forceinline__ bool next(int i, Unit& u) const {
        if (i > 3) return false;
        long L = base.c; Unit t;
        if (i == 0) { base.pick(base.s[1], L, t); u = t; return true; }
        base.pick(base.s[0], L, t);
        if (i == 1) { u = t; return true; }
        u.kind = 0; u.pm = t.pm; u.pn = 2 * t.pn + (i - 2); u.nt = base.ntk; u.kq = 0;
        u.A = Ag + (size_t)u.pm * base.tstep; u.B = Bg + (size_t)u.pn * base.tstep; return true;
    }
};
template <class Epi, class SchedT>
__device__ __forceinline__ void gemm_phase(LAS unsigned char* lds, const int K, const SchedT& S, const Epi& E) {
    int tid_ = threadIdx.x; asm volatile("" : "+v"(tid_));
    const int tid = tid_, wid = __builtin_amdgcn_readfirstlane(tid >> 6), lane = tid & 63, wr = wid >> 2, wc = wid & 3, fr = lane & 15, fq = lane >> 4;
    unsigned voffA[2], voffB[2];
#pragma unroll
    for (int i = 0; i < 2; ++i) { int R, C; stage_rc(tid * 16 + i * 8192, R, C); const int Rb = (R & ~31) + perm32(R & 31);
        voffA[i] = (unsigned)(R * K + C) * 2u; voffB[i] = (unsigned)(Rb * K + C) * 2u; }
    const size_t kstep = (size_t)(BK * 2);
    const size_t hstep = (size_t)HALF * K * 2;
    const unsigned ldsw = (unsigned)wid * 1024u;
    const int aoff = lds_byte(wr * 64 + fr, fq * 8), boff = lds_byte(wc * 32 + fr, fq * 8);
#define PG8_SA(b, h) (((b) * 2 + (h)) * HTB)
#define PG8_SB(b, h) ((4 + (b) * 2 + (h)) * HTB)
#define PG8_STAGE(bufoff, gbase, voff) do { _Pragma("unroll") for (int _i = 0; _i < 2; ++_i) \
        __builtin_amdgcn_global_load_lds((const unsigned*)((const char*)(gbase) + (voff)[_i]), (LAS unsigned*)(lds + (bufoff) + ldsw + _i * 8192), 16, 0, 0); } while (0)
#define PG8_LDA(dst, b, h) do { _Pragma("unroll") for (int m = 0; m < 4; ++m) _Pragma("unroll") for (int k = 0; k < 2; ++k) dst[m][k] = *(const LAS bf16x8*)(lds + PG8_SA(b, h) + aoff + m * 2048 + k * 1024); } while (0)
#define PG8_LDB(dst, b, h) do { _Pragma("unroll") for (int n = 0; n < 2; ++n) _Pragma("unroll") for (int k = 0; k < 2; ++k) dst[n][k] = *(const LAS bf16x8*)(lds + PG8_SB(b, h) + boff + n * 2048 + k * 1024); } while (0)
#define PG8_MMA(ai, bj, At, Bt) do { __builtin_amdgcn_s_setprio(1); _Pragma("unroll") for (int m = 0; m < 4; ++m) _Pragma("unroll") for (int n = 0; n < 2; ++n) _Pragma("unroll") for (int k = 0; k < 2; ++k) \
        acc[ai][bj][m][n] = __builtin_amdgcn_mfma_f32_16x16x32_bf16(Bt[n][k], At[m][k], acc[ai][bj][m][n], 0, 0, 0); __builtin_amdgcn_s_setprio(0); } while (0)
#define PG8_WAIT_V(n) asm volatile("s_waitcnt vmcnt(" #n ")" ::: "memory")
#define PG8_WAIT_L(n) asm volatile("s_waitcnt lgkmcnt(" #n ")" ::: "memory")
#define PG8_BAR __builtin_amdgcn_s_barrier()
#define PG8_SCHED __builtin_amdgcn_sched_barrier(0)
    Unit cur, nxt; int ui = 0;
    if (!S.next(0, cur)) return;
    f32x4 acc[2][2][4][2];
#pragma unroll
    for (int a = 0; a < 2; ++a)
#pragma unroll
        for (int b = 0; b < 2; ++b)
#pragma unroll
            for (int m = 0; m < 4; ++m)
#pragma unroll
                for (int n = 0; n < 2; ++n) acc[a][b][m][n] = (f32x4){0.f, 0.f, 0.f, 0.f};
    bf16x8 At[4][2], B0[2][2], B1[2][2];
    const char* cA = cur.A; const char* cB = cur.B;
    PG8_STAGE(PG8_SB(0, 0), cB, voffB); PG8_STAGE(PG8_SB(0, 1), cB + hstep, voffB); PG8_STAGE(PG8_SA(0, 0), cA, voffA); PG8_STAGE(PG8_SA(0, 1), cA + hstep, voffA);
    if (wr == 1) PG8_BAR;
    PG8_WAIT_V(2); PG8_BAR;
    PG8_STAGE(PG8_SB(1, 0), cB + kstep, voffB); PG8_STAGE(PG8_SA(1, 0), cA + kstep, voffA); PG8_STAGE(PG8_SB(1, 1), cB + hstep + kstep, voffB);
    PG8_WAIT_V(6); PG8_BAR;
    for (;;) {
        const bool has_next = S.next(ui + 1, nxt);
        const char* nA = has_next ? nxt.A : cA; const char* nB = has_next ? nxt.B : cB;
        const int nt = cur.nt;
        for (int t = 0; t < nt; t += 2) {
            const bool last = (t == nt - 2);
            const char* a1 = cA + (size_t)(t + 1) * kstep;
            const char* a2 = last ? nA : cA + (size_t)(t + 2) * kstep; const char* b2 = last ? nB : cB + (size_t)(t + 2) * kstep;
            const char* a3 = a2 + kstep; const char* b3 = b2 + kstep;
            PG8_LDB(B0, 0, 0); PG8_LDB(B1, 0, 1); PG8_SCHED; PG8_LDA(At, 0, 0); PG8_STAGE(PG8_SA(1, 1), a1 + hstep, voffA);
            PG8_WAIT_V(8); PG8_WAIT_L(0); PG8_BAR; PG8_MMA(0, 0, At, B0); PG8_MMA(0, 1, At, B1); PG8_BAR; PG8_SCHED;
            PG8_LDA(At, 0, 1); PG8_STAGE(PG8_SB(0, 0), b2, voffB); PG8_STAGE(PG8_SB(0, 1), b2 + hstep, voffB); PG8_STAGE(PG8_SA(0, 0), a2, voffA);
            PG8_WAIT_V(8); PG8_WAIT_L(0); PG8_BAR; PG8_MMA(1, 0, At, B0); PG8_MMA(1, 1, At, B1); PG8_BAR; PG8_SCHED;
            PG8_LDB(B0, 1, 0); PG8_LDB(B1, 1, 1); PG8_SCHED; PG8_LDA(At, 1, 0); PG8_STAGE(PG8_SA(0, 1), a2 + hstep, voffA);
            PG8_WAIT_V(8); PG8_WAIT_L(0); PG8_BAR; PG8_MMA(0, 0, At, B0); PG8_MMA(0, 1, At, B1); PG8_BAR; PG8_SCHED;
            PG8_LDA(At, 1, 1); PG8_STAGE(PG8_SB(1, 0), b3, voffB); PG8_STAGE(PG8_SB(1, 1), b3 + hstep, voffB); PG8_STAGE(PG8_SA(1, 0), a3, voffA);
            PG8_WAIT_V(8); PG8_WAIT_L(0); PG8_BAR; PG8_MMA(1, 0, At, B0); PG8_MMA(1, 1, At, B1); PG8_BAR; PG8_SCHED;
        }
        if (wr == 0) PG8_BAR;
        { int fr2 = fr, fq2 = fq; asm volatile("" : "+v"(fr2), "+v"(fq2));
          E(acc, cur, wr, wc, fr2, fq2); }
        if (!has_next) break;
#pragma unroll
        for (int a = 0; a < 2; ++a)
#pragma unroll
            for (int b = 0; b < 2; ++b)
#pragma unroll
                for (int m = 0; m < 4; ++m)
#pragma unroll
                    for (int n = 0; n < 2; ++n) acc[a][b][m][n] = (f32x4){0.f, 0.f, 0.f, 0.f};
        cur = nxt; cA = nA; cB = nB; ++ui;
        if (wr == 1) PG8_BAR;
    }
    PG8_WAIT_V(0);
    PG8_BAR;
#undef PG8_SA
#undef PG8_SB
#undef PG8_STAGE
#undef PG8_LDA
#undef PG8_LDB
#undef PG8_MMA
#undef PG8_WAIT_V
#undef PG8_WAIT_L
#undef PG8_BAR
#undef PG8_SCHED
}
}

#define ACC_T const f32x4 (&acc)[2][2][4][2]
template <class T> __device__ __forceinline__ T ldg(const void* base, unsigned boff) { return *(const T*)((const char*)base + boff); }
#ifndef WT_STORES
#define WT_STORES 0
#endif
template <class T> __device__ __forceinline__ void stg(void* base, unsigned boff, const T& v) {
    static_assert(sizeof(T) == 16, "16-byte stores only");
#if WT_STORES
    const __amdgpu_buffer_rsrc_t rs = __builtin_amdgcn_make_buffer_rsrc(base, (short)0, 0x7fffffff, 0x00020000);
    __builtin_amdgcn_raw_buffer_store_b128(__builtin_bit_cast(u32x4, v), rs, boff, 0, 16);
#else
    *(T*)((char*)base + boff) = v;
#endif
}
template <class T> __device__ __forceinline__ void stgw(void* base, unsigned boff, const T& v) {
    static_assert(sizeof(T) == 16, "16-byte stores only");
    const __amdgpu_buffer_rsrc_t rs = __builtin_amdgcn_make_buffer_rsrc(base, (short)0, 0x7fffffff, 0x00020000);
    __builtin_amdgcn_raw_buffer_store_b128(__builtin_bit_cast(u32x4, v), rs, boff, 0, 16);
}
__device__ __forceinline__ u32x4 pack8(const f32x4& v0, const f32x4& v1) { u32x4 w; w.x = cvt_pk_bf16(v0[0], v0[1]); w.y = cvt_pk_bf16(v0[2], v0[3]); w.z = cvt_pk_bf16(v1[0], v1[1]); w.w = cvt_pk_bf16(v1[2], v1[3]); return w; }
#define ROWGROUPS(ai, m) _Pragma("unroll") for (int ai = 0; ai < 2; ++ai) _Pragma("unroll") for (int m = 0; m < 4; ++m)

struct EpiSwiglu {
    bf16* O;
    __device__ __forceinline__ void operator()(ACC_T, const pg8::Unit& u, int wr, int wc, int fr, int fq) const {
        const unsigned off0 = (unsigned)((u.pm * 256 + wr * 64 + fr) * FF + u.pn * 128 + wc * 32 + 8 * fq) * 2u;
        ROWGROUPS(ai, m) {
            const f32x4 a0 = acc[ai][0][m][0], a1 = acc[ai][0][m][1], b0 = acc[ai][1][m][0], b1 = acc[ai][1][m][1];
            f32x4 h0, h1;
#pragma unroll
            for (int j = 0; j < 4; ++j) { h0[j] = a0[j] * b0[j] * __builtin_amdgcn_rcpf(1.0f + __builtin_amdgcn_exp2f(-a0[j])); h1[j] = a1[j] * b1[j] * __builtin_amdgcn_rcpf(1.0f + __builtin_amdgcn_exp2f(-a1[j])); }
            stgw(O, off0 + (unsigned)((ai * 128 + m * 16) * FF * 2), pack8(h0, h1));
        }
    }
};

struct EpiProjA {
    bf16 *Oq, *Ok, *Ovt, *Oxt; const float* b_in; float* G;
    __device__ __forceinline__ void operator()(ACC_T, const pg8::Unit& u, int wr, int wc, int fr, int fq) const {
        const int row0 = u.pm * 256 + wr * 64 + fr, col0 = u.pn * 256 + wc * 32 + 8 * fq;
        if (u.kind == 4) {
            if (wc == 0 && fq < 2) { const f32x4 b0 = ldg<f32x4>(b_in, (unsigned)(COL_GATES + 8 * fq) * 4u), b1 = ldg<f32x4>(b_in, (unsigned)(COL_GATES + 8 * fq + 4) * 4u);
                const unsigned g0 = (unsigned)(row0 * 16 + 8 * fq) * 4u;
                ROWGROUPS(ai, m) { stg(G, g0 + (unsigned)((ai * 128 + m * 16) * 64), acc[ai][0][m][0] + b0); stg(G, g0 + (unsigned)((ai * 128 + m * 16) * 64) + 16, acc[ai][0][m][1] + b1); } }
            return; }
        if (u.kind == 0 || u.kind == 5) {
            const bool isk = u.kind == 5;
            bf16* O = isk ? Ok : Oq; const int colq = col0; const unsigned boff = (unsigned)((isk ? COL_K : COL_Q) + colq) * 4u;
            const unsigned off0 = (unsigned)(row0 * D + colq) * 2u;
#pragma unroll
            for (int bj = 0; bj < 2; ++bj) {
                const f32x4 bv0 = ldg<f32x4>(b_in, boff + bj * 512), bv1 = ldg<f32x4>(b_in, boff + bj * 512 + 16);
                ROWGROUPS(ai, m) stgw(O, off0 + (unsigned)((ai * 128 + m * 16) * D * 2) + bj * 256, pack8(acc[ai][bj][m][0] + bv0, acc[ai][bj][m][1] + bv1));
            }
        } else {
            bf16* O = u.kind == 2 ? Ovt : Oxt; const int ldc = u.kind == 2 ? MTOK : TLAT; const unsigned boff = (unsigned)((u.kind == 2 ? COL_V : COL_F) + row0) * 4u;
            const unsigned off0 = (unsigned)(row0 * ldc + col0) * 2u;
            ROWGROUPS(ai, m) { const float bb = ldg<float>(b_in, boff + (unsigned)((ai * 128 + m * 16) * 4)); const unsigned o = off0 + (unsigned)((ai * 128 + m * 16) * ldc * 2);
#pragma unroll
                for (int bj = 0; bj < 2; ++bj) stgw(O, o + bj * 256, pack8(acc[ai][bj][m][0] + bb, acc[ai][bj][m][1] + bb)); }
        }
    }
};
__device__ __forceinline__ void store_bf16_tile(bf16* O, ACC_T, const pg8::Unit& u, int wr, int wc, int fr, int fq) {
    const unsigned off0 = (unsigned)((u.pm * 256 + wr * 64 + fr) * D + u.pn * 256 + wc * 32 + 8 * fq) * 2u;
    ROWGROUPS(ai, m) { const unsigned o = off0 + (unsigned)((ai * 128 + m * 16) * D * 2);
#pragma unroll
        for (int bj = 0; bj < 2; ++bj) stgw(O, o + bj * 256, pack8(acc[ai][bj][m][0], acc[ai][bj][m][1])); }
}
struct EpiBf16 { bf16* O; __device__ __forceinline__ void operator()(ACC_T, const pg8::Unit& u, int wr, int wc, int fr, int fq) const { store_bf16_tile(O, acc, u, wr, wc, fr, fq); } };
struct EpiDownA { bf16* Y1; float* Y1C;
    __device__ __forceinline__ void operator()(ACC_T, const pg8::Unit& u, int wr, int wc, int fr, int fq) const {
        if (u.kind == 0) { store_bf16_tile(Y1, acc, u, wr, wc, fr, fq); return; }
        const unsigned off0 = (unsigned)(((u.kq * TCTX + u.pm * 256 + wr * 64 + fr) * D) + u.pn * 256 + wc * 32 + 8 * fq) * 4u;
        ROWGROUPS(ai, m) { const unsigned o = off0 + (unsigned)((ai * 128 + m * 16) * D * 4);
#pragma unroll
            for (int bj = 0; bj < 2; ++bj) { stg(Y1C, o + bj * 512, acc[ai][bj][m][0]); stg(Y1C, o + bj * 512 + 16, acc[ai][bj][m][1]); } }
    }
};
struct EpiX {
    bf16 *HM, *TF; const bf16 *HF, *HB; const float *b_in, *head_g; LAS float* red;
    __device__ __forceinline__ void operator()(f32x4 (&acc)[2][2][4][2], const pg8::Unit& u, int wr, int wc, int fr, int fq) const {
        if (u.kind == 1) { store_bf16_tile(TF, acc, u, wr, wc, fr, fq); return; }
        const int col0 = u.pn * 256 + wc * 32 + 8 * fq, rt0 = wr * 64 + fr;
        const unsigned off0 = (unsigned)((u.pm * 256 + rt0) * D + col0) * 2u;
        const unsigned hoff0 = (unsigned)(((((u.pm * 256) >> 12) * 4 + u.pn) * 8 + wc) * SEQ + ((u.pm * 256) & (SEQ - 1)) + rt0) * 64u + (unsigned)fq * 16u;
        f32x4 hg[2][2];
#pragma unroll
        for (int bj = 0; bj < 2; ++bj) { const unsigned cb = (unsigned)(col0 + bj * 128) * 4u;
            const f32x4 bo0 = ldg<f32x4>(b_in, COL_O * 4 + cb), bo1 = ldg<f32x4>(b_in, COL_O * 4 + cb + 16); hg[bj][0] = ldg<f32x4>(head_g, cb); hg[bj][1] = ldg<f32x4>(head_g, cb + 16);
            ROWGROUPS(ai, m) { acc[ai][bj][m][0] += bo0; acc[ai][bj][m][1] += bo1; } }
        u32x4 la[2], lb[2];
#define EPIX_LOAD(G) do { _Pragma("unroll") for (int bj = 0; bj < 2; ++bj) { \
            const unsigned ho = hoff0 + (unsigned)(((((G) >> 2) * 128 + ((G) & 3) * 16) * 64)) + (unsigned)bj * (4u * SEQ * 64u); la[bj] = ldg<u32x4>(HF, ho); lb[bj] = ldg<u32x4>(HB, ho); } } while (0)
        EPIX_LOAD(0);
#pragma unroll
        for (int gi = 0; gi < 8; ++gi) { const int ai = gi >> 2, m = gi & 3;
            u32x4 hp[2]; float s = 0.f;
#pragma unroll
            for (int bj = 0; bj < 2; ++bj) { const u32x4 a = la[bj], b = lb[bj]; u32x4 hq;
#pragma unroll
                for (int q = 0; q < 4; ++q) { const float h0 = bflo(a[q]) + bflo(b[q]), h1 = bfhi(a[q]) + bfhi(b[q]); hq[q] = pk2(h0, h1); const float g0 = bflo(hq[q]), g1 = bfhi(hq[q]); s += g0 * g0 + g1 * g1; }
                hp[bj] = hq; }
            s += __shfl_xor(s, 16); s += __shfl_xor(s, 32);
            if (fq == 0) red[(ai * 128 + m * 16 + rt0) * 4 + wc] = s;
            asm volatile("" ::: "memory");
            if (gi < 7) EPIX_LOAD(gi + 1);
            LDS_WAIT(); __builtin_amdgcn_s_barrier(); asm volatile("" ::: "memory");
            const f32x4 ps = *(const LAS f32x4*)(red + (ai * 128 + m * 16 + rt0) * 4);
            const float rstd = rsqrtf(((ps[0] + ps[1]) + (ps[2] + ps[3])) * (1.0f / 256.0f) + EPS);
#pragma unroll
            for (int bj = 0; bj < 2; ++bj) {
                const unsigned o = off0 + (unsigned)((ai * 128 + m * 16) * D * 2) + bj * 256;
                const u32x4 hq = hp[bj];
                const f32x4 v0 = acc[ai][bj][m][0], v1 = acc[ai][bj][m][1]; const f32x4 hg0 = hg[bj][0], hg1 = hg[bj][1];
                f32x4 r0, r1;
                r0[0] = sigmoidf_(v0[0]) * bflo(hq[0]) * rstd * hg0[0]; r0[1] = sigmoidf_(v0[1]) * bfhi(hq[0]) * rstd * hg0[1];
                r0[2] = sigmoidf_(v0[2]) * bflo(hq[1]) * rstd * hg0[2]; r0[3] = sigmoidf_(v0[3]) * bfhi(hq[1]) * rstd * hg0[3];
                r1[0] = sigmoidf_(v1[0]) * bflo(hq[2]) * rstd * hg1[0]; r1[1] = sigmoidf_(v1[1]) * bfhi(hq[2]) * rstd * hg1[1];
                r1[2] = sigmoidf_(v1[2]) * bflo(hq[3]) * rstd * hg1[2]; r1[3] = sigmoidf_(v1[3]) * bfhi(hq[3]) * rstd * hg1[3];
                stg(HM, o, pack8(r0, r1)); }
            asm volatile("" ::: "memory");
        }
#undef EPIX_LOAD
    }
};
struct EpiY {
    bf16 *TF, *TM; const float* b_in;
    __device__ __forceinline__ void operator()(ACC_T, const pg8::Unit& u, int wr, int wc, int fr, int fq) const {
        if (u.kind == 1) { store_bf16_tile(TM, acc, u, wr, wc, fr, fq); return; }
        if (u.kind == 2) { store_bf16_tile(TF, acc, u, wr, wc, fr, fq); return; }
        const int ch0 = u.pn * 128 + wc * 32 + 8 * fq;
        const unsigned off0 = (unsigned)((u.pm * 256 + wr * 64 + fr) * D + ch0) * 2u;
        f32x4 bf0 = ldg<f32x4>(b_in, (unsigned)(COL_GF + ch0) * 4u) * -1.4426950408889634f, bf1 = ldg<f32x4>(b_in, (unsigned)(COL_GF + ch0) * 4u + 16) * -1.4426950408889634f;
        f32x4 bm0 = ldg<f32x4>(b_in, (unsigned)(COL_GM + ch0) * 4u) * -1.4426950408889634f, bm1 = ldg<f32x4>(b_in, (unsigned)(COL_GM + ch0) * 4u + 16) * -1.4426950408889634f;
#pragma unroll
        for (int q = 0; q < 4; ++q) { bf0[q] = __builtin_amdgcn_exp2f(bf0[q]); bf1[q] = __builtin_amdgcn_exp2f(bf1[q]); bm0[q] = __builtin_amdgcn_exp2f(bm0[q]); bm1[q] = __builtin_amdgcn_exp2f(bm1[q]); }
        u32x4 nt[2], nm[2];
#define EPIY_LOAD(AM) do { _Pragma("unroll") for (int mm = 0; mm < 2; ++mm) { const unsigned o_ = off0 + (unsigned)(((((AM) >> 1) * 128 + ((((AM) & 1) * 2) + mm) * 16) * D * 2)); nt[mm] = ldg<u32x4>(TF, o_); nm[mm] = ldg<u32x4>(TM, o_); } } while (0)
        EPIY_LOAD(0);
#pragma unroll
        for (int am = 0; am < 4; ++am) { const int ai = am >> 1, mb = (am & 1) * 2;
            u32x4 tq[2], tmq[2];
#pragma unroll
            for (int mm = 0; mm < 2; ++mm) { tq[mm] = nt[mm]; tmq[mm] = nm[mm]; }
            if (am < 3) EPIY_LOAD(am + 1);
#pragma unroll
            for (int mm = 0; mm < 2; ++mm) { const int m = mb + mm; const unsigned o = off0 + (unsigned)((ai * 128 + m * 16) * D * 2);
                const u32x4 t = tq[mm], tm = tmq[mm];
                const f32x4 f0 = acc[ai][0][m][0], f1 = acc[ai][0][m][1], g0 = acc[ai][1][m][0], g1 = acc[ai][1][m][1];
                f32x4 r0, r1;
                r0[0] = sigmoid2b_(f0[0], bf0[0]) * bflo(t[0]) + sigmoid2b_(g0[0], bm0[0]) * bflo(tm[0]); r0[1] = sigmoid2b_(f0[1], bf0[1]) * bfhi(t[0]) + sigmoid2b_(g0[1], bm0[1]) * bfhi(tm[0]);
                r0[2] = sigmoid2b_(f0[2], bf0[2]) * bflo(t[1]) + sigmoid2b_(g0[2], bm0[2]) * bflo(tm[1]); r0[3] = sigmoid2b_(f0[3], bf0[3]) * bfhi(t[1]) + sigmoid2b_(g0[3], bm0[3]) * bfhi(tm[1]);
                r1[0] = sigmoid2b_(f1[0], bf1[0]) * bflo(t[2]) + sigmoid2b_(g1[0], bm1[0]) * bflo(tm[2]); r1[1] = sigmoid2b_(f1[1], bf1[1]) * bfhi(t[2]) + sigmoid2b_(g1[1], bm1[1]) * bfhi(tm[2]);
                r1[2] = sigmoid2b_(f1[2], bf1[2]) * bflo(t[3]) + sigmoid2b_(g1[2], bm1[2]) * bflo(tm[3]); r1[3] = sigmoid2b_(f1[3], bf1[3]) * bfhi(t[3]) + sigmoid2b_(g1[3], bm1[3]) * bfhi(tm[3]);
                stgw(TM, o, pack8(r0, r1)); }
            asm volatile("" ::: "memory"); }
#undef EPIY_LOAD
    }
};

struct PanelRms {
    float* xbuf; unsigned* cnt;
    __device__ __forceinline__ void run(const f32x4 (&v)[2][2][4][2], const pg8::Unit& u, int wr, int wc, int fr, int fq, LAS float* Pt, LAS float* S, int wid, int lane) const {
        ROWGROUPS(ai, m) { float s = 0.f;
#pragma unroll
            for (int bj = 0; bj < 2; ++bj)
#pragma unroll
                for (int n = 0; n < 2; ++n) { const f32x4 x = v[ai][bj][m][n]; s += (x[0] * x[0] + x[1] * x[1]) + (x[2] * x[2] + x[3] * x[3]); }
            s += __shfl_xor(s, 16); s += __shfl_xor(s, 32);
            if (fq == 0) Pt[(ai * 128 + wr * 64 + m * 16 + fr) * 4 + wc] = s; }
        LDS_WAIT(); __builtin_amdgcn_s_barrier(); asm volatile("" ::: "memory");
        const int row = wid * 32 + (lane & 31);
        if (lane < 32) { const f32x4 a = *(const LAS f32x4*)(Pt + row * 4);
            __hip_atomic_store(xbuf + (size_t)(u.pm * 256 + row) * 4 + u.pn, (a[0] + a[1]) + (a[2] + a[3]), __ATOMIC_RELAXED, __HIP_MEMORY_SCOPE_AGENT); }
        asm volatile("s_waitcnt vmcnt(0)" ::: "memory");
        if (lane == 0) __hip_atomic_fetch_add(cnt + 64 * u.pm, 1u, __ATOMIC_RELAXED, __HIP_MEMORY_SCOPE_AGENT);
        if (wid == 0) { unsigned sp = 0;
            while ((unsigned)__builtin_amdgcn_readfirstlane(__hip_atomic_load(cnt + 64 * u.pm, __ATOMIC_RELAXED, __HIP_MEMORY_SCOPE_AGENT)) < 32u) { __builtin_amdgcn_s_sleep(2); if (++sp > (1u << 22)) break; }
            __builtin_amdgcn_fence(__ATOMIC_ACQUIRE, "agent"); }
        asm volatile("s_waitcnt vmcnt(0) lgkmcnt(0)" ::: "memory"); __builtin_amdgcn_s_barrier(); asm volatile("" ::: "memory");
        if (lane < 32) { const float* sl = xbuf + (size_t)(u.pm * 256 + row) * 4; float t = 0.f;
#pragma unroll
            for (int k = 0; k < 4; ++k) t += __hip_atomic_load(sl + k, __ATOMIC_RELAXED, __HIP_MEMORY_SCOPE_AGENT);
            S[row] = rsqrtf(t * (1.0f / 1024.0f) + EPS); }
        LDS_WAIT(); __builtin_amdgcn_s_barrier(); asm volatile("" ::: "memory");
    }
};
struct EpiFinal {
    const float *g5, *mod; const bf16* D12; float* out; PanelRms st; LAS float* tab;
    __device__ __forceinline__ void operator()(ACC_T, const pg8::Unit& u, int wr, int wc, int fr, int fq) const {
        const int wid = wr * 4 + wc, lane = fq * 16 + fr; LAS float* S = tab + 1024;
        st.run(acc, u, wr, wc, fr, fq, tab, S, wid, lane);
        const int col0 = u.pn * 256 + wc * 32 + 8 * fq, rt0 = wr * 64 + fr, v = (u.pm * 256) >> 12;
        const unsigned e0 = (unsigned)((u.pm * 256 + rt0) * D + col0);
        const float* gate = mod + (size_t)v * 9216 + 8 * 1024;
#pragma unroll
        for (int bj = 0; bj < 2; ++bj) {
            const unsigned cb = (unsigned)(col0 + bj * 128) * 4u;
            f32x4 g0 = ldg<f32x4>(g5, cb), g1 = ldg<f32x4>(g5, cb + 16); const f32x4 t0 = ldg<f32x4>(gate, cb), t1 = ldg<f32x4>(gate, cb + 16);
            g0 = g0 * t0 * 0.5f; g1 = g1 * t1 * 0.5f;
            ROWGROUPS(ai, m) { const float rs = S[ai * 128 + m * 16 + rt0]; const unsigned e = e0 + (unsigned)((ai * 128 + m * 16) * D) + bj * 128;
                const u32x4 dd = ldg<u32x4>(D12, e * 2u);
                f32x4 o0, o1;
                o0[0] = bflo(dd[0]); o0[1] = bfhi(dd[0]); o0[2] = bflo(dd[1]); o0[3] = bfhi(dd[1]);
                o1[0] = bflo(dd[2]); o1[1] = bfhi(dd[2]); o1[2] = bflo(dd[3]); o1[3] = bfhi(dd[3]);
                o0 = o0 + acc[ai][bj][m][0] * rs * g0; o1 = o1 + acc[ai][bj][m][1] * rs * g1;
                stg(out, e * 4u, o0); stg(out, e * 4u + 16, o1);
                asm volatile("" ::: "memory"); } }
    }
};
template <bool XRES, int ig, int isc, int ish>
struct EpiMixT {
    const void* res; const float *ga, *gb, *mod; bf16 *Hout, *Uout; PanelRms st1, st2; LAS float* tab;
    __device__ __forceinline__ void operator()(f32x4 (&acc)[2][2][4][2], const pg8::Unit& u, int wr, int wc, int fr, int fq) const {
        const int wid = wr * 4 + wc, lane = fq * 16 + fr; LAS float* S = tab + 1024;
        st1.run(acc, u, wr, wc, fr, fq, tab, S, wid, lane);
        const int col0 = u.pn * 256 + wc * 32 + 8 * fq, rt0 = wr * 64 + fr, v = (u.pm * 256) >> 12;
        const unsigned e0 = (unsigned)((u.pm * 256 + rt0) * D + col0);
        const float* mv = mod + (size_t)v * 9216;
#pragma unroll
        for (int bj = 0; bj < 2; ++bj) {
            const unsigned cb = (unsigned)(col0 + bj * 128) * 4u;
            f32x4 g0 = ldg<f32x4>(ga, cb), g1 = ldg<f32x4>(ga, cb + 16); const f32x4 t0 = ldg<f32x4>(mv + ig * 1024, cb), t1 = ldg<f32x4>(mv + ig * 1024, cb + 16);
            g0 = g0 * t0 * (XRES ? 0.5f : 1.0f); g1 = g1 * t1 * (XRES ? 0.5f : 1.0f);
            ROWGROUPS(ai, m) { const float rs = S[ai * 128 + m * 16 + rt0]; const unsigned e = e0 + (unsigned)((ai * 128 + m * 16) * D) + bj * 128;
                f32x4 d0, d1;
                if constexpr (XRES) { d0 = ldg<f32x4>(res, e * 4u); d1 = ldg<f32x4>(res, e * 4u + 16); }
                else { const u32x4 dd = ldg<u32x4>(res, e * 2u);
                    d0[0] = bflo(dd[0]); d0[1] = bfhi(dd[0]); d0[2] = bflo(dd[1]); d0[3] = bfhi(dd[1]); d1[0] = bflo(dd[2]); d1[1] = bfhi(dd[2]); d1[2] = bflo(dd[3]); d1[3] = bfhi(dd[3]); }
                d0 = d0 + acc[ai][bj][m][0] * rs * g0; d1 = d1 + acc[ai][bj][m][1] * rs * g1;
                const u32x4 pk = pack8(d0, d1); stg(Hout, e * 2u, pk);
                f32x4 h0, h1;
                h0[0] = bflo(pk[0]); h0[1] = bfhi(pk[0]); h0[2] = bflo(pk[1]); h0[3] = bfhi(pk[1]);
                h1[0] = bflo(pk[2]); h1[1] = bfhi(pk[2]); h1[2] = bflo(pk[3]); h1[3] = bfhi(pk[3]);
                acc[ai][bj][m][0] = h0; acc[ai][bj][m][1] = h1;
                asm volatile("" ::: "memory"); } }
        st2.run(acc, u, wr, wc, fr, fq, tab, S, wid, lane);
#pragma unroll
        for (int bj = 0; bj < 2; ++bj) {
            const unsigned cb = (unsigned)(col0 + bj * 128) * 4u;
            f32x4 g0 = ldg<f32x4>(gb, cb), g1 = ldg<f32x4>(gb, cb + 16); const f32x4 c0 = ldg<f32x4>(mv + isc * 1024, cb), c1 = ldg<f32x4>(mv + isc * 1024, cb + 16);
            const f32x4 s0 = ldg<f32x4>(mv + ish * 1024, cb), s1 = ldg<f32x4>(mv + ish * 1024, cb + 16);
            g0 = g0 * (c0 + 1.0f); g1 = g1 * (c1 + 1.0f);
            ROWGROUPS(ai, m) { const float rs = S[ai * 128 + m * 16 + rt0]; const unsigned e = e0 + (unsigned)((ai * 128 + m * 16) * D) + bj * 128;
                stg(Uout, e * 2u, pack8(acc[ai][bj][m][0] * rs * g0 + s0, acc[ai][bj][m][1] * rs * g1 + s1)); } }
    }
};

struct Frame { LAS unsigned char* lds; int tid, lane, wave, gw, ngw; };

struct TrItem { const float* src; int Nsrc, dst_row0, k0; float scale; };
__device__ __forceinline__ void tr_load(float (&tv)[32], const TrItem& t, int lane) {
    const float* wp = t.src + (size_t)(lane >> 5) * t.Nsrc + (lane & 31);
#pragma unroll
    for (int i = 0; i < 32; ++i) tv[i] = __builtin_nontemporal_load(wp + (size_t)(2 * i) * t.Nsrc);
}
__device__ __forceinline__ void tr_to_lds(const float (&tv)[32], float scale, LAS float* scr, int lane) {
#pragma unroll
    for (int i = 0; i < 32; ++i) scr[(2 * i + (lane >> 5)) * 33 + (lane & 31)] = tv[i] * scale;
}
__device__ __forceinline__ void tr_store(const TrItem& t, int K, bf16* WT, LAS float* scr, int lane) {
    LDS_WAIT(); asm volatile("" ::: "memory");
    const int c = lane & 7;
#pragma unroll
    for (int j = 0; j < 4; ++j) { const int n = (lane >> 3) + 8 * j; const LAS float* s = scr + (8 * c) * 33 + n;
        u32x4 o; o.x = pk2(s[0 * 33], s[1 * 33]); o.y = pk2(s[2 * 33], s[3 * 33]); o.z = pk2(s[4 * 33], s[5 * 33]); o.w = pk2(s[6 * 33], s[7 * 33]);
        *(u32x4*)(WT + (size_t)(t.dst_row0 + n) * K + t.k0 + 8 * c) = o; }
    LDS_WAIT(); asm volatile("" ::: "memory");
}
__device__ __forceinline__ void transpose_item(const float* W, int K, int Nsrc, bf16* WT, int dst_row0, int src_col0, int k0, LAS float* scr, int lane, float scale = 1.0f) {
    float tv[32]; const TrItem t{W + (size_t)k0 * Nsrc + src_col0, Nsrc, dst_row0, k0, scale};
    tr_load(tv, t, lane); tr_to_lds(tv, scale, scr, lane); tr_store(t, K, WT, scr, lane);
}
template <class Mk>
__device__ __forceinline__ void conv_loop(const Frame& F, int it0, int its, int K, bf16* dst, const Mk& mk) {
    LAS float* scr = (LAS float*)(F.lds + F.wave * 16384);
    float tv[32]; int it = it0 + F.gw; const int end = it0 + its;
    TrItem cur = mk(it < end ? it : it0);
    if (it < end) tr_load(tv, cur, F.lane);
    while (it < end) { const int ni = it + F.ngw;
        tr_to_lds(tv, cur.scale, scr, F.lane);
        const TrItem nxt = mk(ni < end ? ni : it0);
        if (ni < end) tr_load(tv, nxt, F.lane);
        tr_store(cur, K, dst, scr, F.lane);
        cur = nxt; it = ni; }
}
__device__ __forceinline__ void conv_w13(const Frame& F, const float* w13, bf16* dst, int it0, int its) {
    conv_loop(F, it0, its, D, dst, [&](int r) { const int kb = r / 176, nb = r % 176, n0 = 32 * nb, j = n0 >> 8, s = (n0 >> 7) & 1, i0 = n0 & 127;
        return TrItem{w13 + (size_t)(64 * kb) * (2 * FF) + s * FF + 128 * j + i0, 2 * FF, n0, 64 * kb, s ? 0.6931471805599453f : 1.4426950408889634f}; });
}
__device__ __forceinline__ void conv_plain(const Frame& F, const float* W, int K, int N, bf16* dst, int it0, int its) {
    const int nblk = N / 32;
    conv_loop(F, it0, its, K, dst, [&](int r) { const int kb = r / nblk, nb = r % nblk; return TrItem{W + (size_t)(64 * kb) * N + 32 * nb, N, 32 * nb, 64 * kb, 1.0f}; });
}
__device__ __forceinline__ int win_src_col(int n0) {
    if (n0 < ROW_K) return COL_Q + n0;
    if (n0 < ROW_V) return COL_K + (n0 - ROW_K);
    if (n0 < ROW_F) return COL_V + (n0 - ROW_V);
    if (n0 < ROW_O) return COL_F + (n0 - ROW_F);
    if (n0 < ROW_GF) return COL_O + (n0 - ROW_O);
    { const int r = n0 - ROW_GF, j = r >> 8, sg = (r >> 7) & 1, i0 = r & 127; return (sg ? COL_GM : COL_GF) + 128 * j + i0; }
}
__device__ __forceinline__ void conv_win(const Frame& F, const float* w_in, bf16* dst, int it0, int its) {
    constexpr int nblk = WIN_ROWS / 32;
    conv_loop(F, it0, its, D, dst, [&](int r) { const int kb = r / nblk, nb = r % nblk; return TrItem{w_in + (size_t)(64 * kb) * INW + win_src_col(32 * nb), INW, 32 * nb, 64 * kb, (32 * nb >= ROW_GF) ? -1.4426950408889634f : 1.0f}; });
}

__device__ __forceinline__ void ada_phase(const Frame& F, const Params& p) {
    LAS float* sc = (LAS float*)F.lds;
    LAS float* part = sc + 5 * 1024;
    float* mod = (float*)(p.ws + WS_MOD);
    for (int i = F.tid; i < 5 * 1024; i += NTHR) { const int v = i >> 10, k = i & 1023; const float cv = v < 4 ? p.c[v * 1024 + k] : p.c_ctx[k]; sc[i] = siluf_(cv); }
    __syncthreads();
    for (int tile = blockIdx.x; tile < 144; tile += gridDim.x) {
        const int col = 64 * tile + F.lane;
        float a0 = 0.f, a1 = 0.f, a2 = 0.f, a3 = 0.f, a4 = 0.f;
#pragma unroll 32
        for (int it = 0; it < 128; ++it) { const int k = 128 * F.wave + it; const float w = __builtin_nontemporal_load(p.w_ada + (size_t)k * 9216 + col);
            a0 += sc[k] * w; a1 += sc[1024 + k] * w; a2 += sc[2048 + k] * w; a3 += sc[3072 + k] * w; a4 += sc[4096 + k] * w; }
        { LAS float* pp = part + F.wave * 320 + F.lane; pp[0] = a0; pp[64] = a1; pp[128] = a2; pp[192] = a3; pp[256] = a4; }
        __syncthreads();
        if (F.tid < 320) { float s = 0.f;
#pragma unroll
            for (int w = 0; w < 8; ++w) s += part[w * 320 + F.tid];
            const int v = F.tid >> 6, cc = 64 * tile + (F.tid & 63); mod[v * 9216 + cc] = s + p.b_ada[cc]; }
        __syncthreads();
    }
}
__device__ __forceinline__ void wfour_phase(const Frame& F, const Params& p, int gw, int ngw) {
    LAS float* ct = (LAS float*)(F.lds + 131072);
    if (F.tid < 128) ct[F.tid] = cosf((float)F.tid * (6.283185307179586f / 128.0f));
    __syncthreads();
    bf16* WF = (bf16*)(p.ws + WS_WFOUR);
    const int l15 = F.lane & 15, l4 = F.lane >> 4;
    for (int task = gw; task < 1024; task += ngw) {
        const int g = task >> 8, nt = (task >> 2) & 63, jq = task & 3;
        float b[32];
        { const float* wp = p.w_four + (size_t)(g * 128 + l4) * 1024 + 16 * nt + l15;
#pragma unroll
          for (int kk = 0; kk < 32; ++kk) b[kk] = wp[(size_t)(4 * kk) * 1024]; }
#pragma unroll
        for (int jt = 0; jt < 4; ++jt) {
            const int jj = 64 * jq + 16 * jt + l15, pq = (jj >> 3) & 1, ch = 8 * (jj >> 4) + (jj & 7), sh = pq ? 96 : 0;
            const float scl = pq ? -0.08838834764831845f : 0.08838834764831845f;
            f32x4 acc = {0.f, 0.f, 0.f, 0.f};
#pragma unroll
            for (int kk = 0; kk < 32; ++kk) { const float av = scl * ct[((4 * kk + l4) * ch + sh) & 127]; acc = __builtin_amdgcn_mfma_f32_16x16x4f32(av, b[kk], acc, 0, 0, 0); }
            u32x2 o; o.x = pk2(acc[0], acc[1]); o.y = pk2(acc[2], acc[3]);
            *(u32x2*)(WF + (size_t)(16 * nt + l15) * 1024 + 256 * g + 64 * jq + 16 * jt + 4 * l4) = o;
        }
    }
    __syncthreads();
}

struct Row { f32x4 v[4]; };
__device__ __forceinline__ Row ld_row_f32(const float* r, int lane) { Row o; const f32x4* q = (const f32x4*)r + lane;
#pragma unroll
    for (int j = 0; j < 4; ++j) o.v[j] = q[64 * j]; return o; }
__device__ __forceinline__ Row ld_row_bf16(const bf16* r, int lane) { Row o; const u32x2* q = (const u32x2*)r + lane;
#pragma unroll
    for (int j = 0; j < 4; ++j) { const u32x2 w = q[64 * j]; o.v[j] = (f32x4){bflo(w.x), bfhi(w.x), bflo(w.y), bfhi(w.y)}; } return o; }
__device__ __forceinline__ void st_row_bf16(bf16* r, int lane, const Row& a) { u32x2* q = (u32x2*)r + lane;
#pragma unroll
    for (int j = 0; j < 4; ++j) { u32x2 w; w.x = pk2(a.v[j][0], a.v[j][1]); w.y = pk2(a.v[j][2], a.v[j][3]); q[64 * j] = w; } }
__device__ __forceinline__ void st_row_bf16_wt(bf16* r, int lane, const Row& a) {
    const __amdgpu_buffer_rsrc_t rs = __builtin_amdgcn_make_buffer_rsrc((void*)r, (short)0, 0x7fffffff, 0x00020000);
#pragma unroll
    for (int j = 0; j < 4; ++j) { u32x2 w; w.x = pk2(a.v[j][0], a.v[j][1]); w.y = pk2(a.v[j][2], a.v[j][3]); __builtin_amdgcn_raw_buffer_store_b64(w, rs, (unsigned)(lane * 8 + j * 512), 0, 16); } }
__device__ __forceinline__ void st_row_f32(float* r, int lane, const Row& a) { f32x4* q = (f32x4*)r + lane;
#pragma unroll
    for (int j = 0; j < 4; ++j) q[64 * j] = a.v[j]; }
__device__ __forceinline__ float row_rstd(const Row& a) { float s = 0.f;
#pragma unroll
    for (int j = 0; j < 4; ++j) s += (a.v[j][0] * a.v[j][0] + a.v[j][1] * a.v[j][1]) + (a.v[j][2] * a.v[j][2] + a.v[j][3] * a.v[j][3]);
    return rsqrtf(wave_sum(s) * (1.0f / 1024.0f) + EPS); }
__device__ __forceinline__ Row round_bf16(const Row& a) { Row o;
#pragma unroll
    for (int j = 0; j < 4; ++j)
#pragma unroll
        for (int e = 0; e < 4; ++e) o.v[j][e] = bf2f(f2bf(a.v[j][e]));
    return o; }
__device__ __forceinline__ Row modnorm2(const Row& h, const Row& gs, const Row& sh) {
    const float rs = row_rstd(h); Row o;
#pragma unroll
    for (int j = 0; j < 4; ++j) o.v[j] = h.v[j] * rs * gs.v[j] + sh.v[j];
    return o; }
__device__ __forceinline__ Row gated_norm2(const Row& y, const Row& gg) {
    const float rs = row_rstd(y); Row o;
#pragma unroll
    for (int j = 0; j < 4; ++j) o.v[j] = y.v[j] * rs * gg.v[j];
    return o; }
__device__ __forceinline__ Row rmul(const Row& a, const Row& b) { Row o;
#pragma unroll
    for (int j = 0; j < 4; ++j) o.v[j] = a.v[j] * b.v[j]; return o; }
__device__ __forceinline__ Row rmul1p(const Row& g, const Row& sc) { Row o;
#pragma unroll
    for (int j = 0; j < 4; ++j) o.v[j] = g.v[j] * (sc.v[j] + 1.0f); return o; }
__device__ __forceinline__ Row rscale(const Row& a, float c) { Row o;
#pragma unroll
    for (int j = 0; j < 4; ++j) o.v[j] = a.v[j] * c; return o; }
__device__ __forceinline__ Row radd(const Row& a, const Row& b) { Row o;
#pragma unroll
    for (int j = 0; j < 4; ++j) o.v[j] = a.v[j] + b.v[j]; return o; }
__device__ __forceinline__ const float* modp(const Params& p, int v, int i) { return (const float*)(p.ws + WS_MOD) + (size_t)v * 9216 + i * 1024; }
__device__ __forceinline__ const float* xrow(const Params& p, int r) { return r < TLAT ? p.x + (size_t)r * D : p.ctx + (size_t)(r - TLAT) * D; }
__device__ __forceinline__ int rowvar(int r) { return r < TLAT ? (r >> 12) : 4; }

__device__ __forceinline__ int row_of(const Frame& F, int it) {
    const int per = F.ngw >> 2, nl = (SEQ + per - 1) / per;
    if (it < nl) { const int rl = (F.gw >> 2) + it * per; if (rl < SEQ) return (F.gw & 3) * SEQ + rl; it = nl; }
    const int rc = F.gw + (it - nl) * F.ngw; return rc < TCTX ? TLAT + rc : -1;
}
__device__ __forceinline__ int lat_row(const Frame& F, int k) { const int rl = (F.gw >> 2) + k * (F.ngw >> 2); return rl < SEQ ? (F.gw & 3) * SEQ + rl : -1; }
__device__ __forceinline__ void phase_u1(const Frame& F, const Params& p) {
    bf16* U = (bf16*)(p.ws + WS_U);
    const int v = F.gw & 3, rc0 = F.gw;
    Row xc; if (rc0 < TCTX) xc = ld_row_f32(p.ctx + (size_t)rc0 * D, F.lane);
    for (int k0 = 0; lat_row(F, k0) >= 0; k0 += 8) { Row xr[8]; int rr[8];
#pragma unroll
        for (int q = 0; q < 8; ++q) { rr[q] = lat_row(F, k0 + q); if (rr[q] >= 0) xr[q] = ld_row_f32(p.x + (size_t)rr[q] * D, F.lane); }
        const Row gs = rmul1p(ld_row_f32(p.norm_g, F.lane), ld_row_f32(modp(p, v, 1), F.lane)), sh = ld_row_f32(modp(p, v, 0), F.lane);
#pragma unroll
        for (int q = 0; q < 8; ++q) if (rr[q] >= 0) st_row_bf16_wt(U + (size_t)rr[q] * D, F.lane, modnorm2(xr[q], gs, sh)); }
    { const Row gs = rmul1p(ld_row_f32(p.norm_g, F.lane), ld_row_f32(modp(p, 4, 1), F.lane)), sh = ld_row_f32(modp(p, 4, 0), F.lane);
      if (rc0 < TCTX) st_row_bf16_wt(U + (size_t)(TLAT + rc0) * D, F.lane, modnorm2(xc, gs, sh));
      for (int rc = rc0 + F.ngw; rc < TCTX; rc += F.ngw) st_row_bf16_wt(U + (size_t)(TLAT + rc) * D, F.lane, modnorm2(ld_row_f32(p.ctx + (size_t)rc * D, F.lane), gs, sh)); }
}
__device__ __forceinline__ void gate_stage(const Frame& F, const Params& p, LAS bf16x8* wg) {
    const bf16* WG = (const bf16*)(p.ws + WS_WG);
    for (int i = F.tid; i < 2048; i += NTHR) { const int s_ = i >> 6, l = i & 63; wg[i] = ((const bf16x8*)(WG + (size_t)(l & 15) * D))[4 * s_ + (l >> 4)]; }
}
__device__ __forceinline__ void gate_tile(const Frame& F, const Params& p, const LAS bf16x8* wg, int row0) {
    const bf16* U = (const bf16*)(p.ws + WS_U2); float* G = (float*)(p.ws + WS_GATES);
    const int l = F.lane, fr = l & 15, fq = l >> 4;
    LAS unsigned char* scr = F.lds + 32768 + F.wave * 4352;
    const u32x4* gp = (const u32x4*)(U + (size_t)row0 * D) + (size_t)fq * 128 + fr;
    u32x4 a[8][4];
#pragma unroll
    for (int e8 = 0; e8 < 8; ++e8)
#pragma unroll
        for (int rg = 0; rg < 4; ++rg) a[e8][rg] = gp[(4 * rg) * 128 + 16 * e8];
    f32x4 acc = {0.f, 0.f, 0.f, 0.f};
#pragma unroll
    for (int e8 = 0; e8 < 8; ++e8) {
#pragma unroll
        for (int rg = 0; rg < 4; ++rg) *(LAS u32x4*)(scr + ((4 * rg + fq) * 17 + fr) * 16) = a[e8][rg];
        asm volatile("s_waitcnt lgkmcnt(0)" ::: "memory");
#pragma unroll
        for (int s4 = 0; s4 < 4; ++s4) { const bf16x8 av = *(const LAS bf16x8*)(scr + (fr * 17 + 4 * s4 + fq) * 16); acc = __builtin_amdgcn_mfma_f32_16x16x32_bf16(av, wg[(4 * e8 + s4) * 64 + l], acc, 0, 0, 0); }
        asm volatile("s_waitcnt lgkmcnt(0)" ::: "memory");
    }
    const float bias = p.b_in[COL_GATES + fr];
#pragma unroll
    for (int r = 0; r < 4; ++r) G[(size_t)(row0 + 4 * fq + r) * 16 + fr] = acc[r] + bias;
}
__device__ __forceinline__ void phase_post_ffn_a(const Frame& F, const Params& p) {
    bf16* U = (bf16*)(p.ws + WS_U2);
    if (F.gw < TCTX) {
      const Row gg = rscale(rmul(ld_row_f32(p.norm_g + 1 * D, F.lane), ld_row_f32(modp(p, 4, 2), F.lane)), 0.5f);
      const Row gs = rmul1p(ld_row_f32(p.norm_g + 2 * D, F.lane), ld_row_f32(modp(p, 4, 4), F.lane)), sh = ld_row_f32(modp(p, 4, 3), F.lane);
      for (int rc = F.gw; rc < TCTX; rc += F.ngw) { const float* yc = (const float*)(p.ws + WS_Y1C) + (size_t)rc * D;
          Row y = radd(radd(ld_row_f32(yc, F.lane), ld_row_f32(yc + (size_t)TCTX * D, F.lane)), radd(ld_row_f32(yc + (size_t)2 * TCTX * D, F.lane), ld_row_f32(yc + (size_t)3 * TCTX * D, F.lane)));
          y = radd(y, radd(radd(ld_row_f32(yc + (size_t)4 * TCTX * D, F.lane), ld_row_f32(yc + (size_t)5 * TCTX * D, F.lane)), radd(ld_row_f32(yc + (size_t)6 * TCTX * D, F.lane), ld_row_f32(yc + (size_t)7 * TCTX * D, F.lane))));
          const Row dl = round_bf16(gated_norm2(y, gg));
          st_row_bf16(U + (size_t)(TLAT + rc) * D, F.lane, modnorm2(radd(ld_row_f32(p.ctx + (size_t)rc * D, F.lane), dl), gs, sh)); } }
}
__device__ __forceinline__ void phase_u2_again(const Frame& F, const Params& p) {
    bf16* U = (bf16*)(p.ws + WS_U); const bf16* D1 = (const bf16*)((unsigned char*)p.out + DO_D1);
    const int v = F.gw & 3; const Row gs = rmul1p(ld_row_f32(p.norm_g + 2 * D, F.lane), ld_row_f32(modp(p, v, 4), F.lane)), sh = ld_row_f32(modp(p, v, 3), F.lane);
    for (int k0 = 0; lat_row(F, k0) >= 0; k0 += 4) { Row xr[4], dr[4]; int rr[4];
#pragma unroll
        for (int q = 0; q < 4; ++q) { rr[q] = lat_row(F, k0 + q); if (rr[q] >= 0) { xr[q] = ld_row_f32(p.x + (size_t)rr[q] * D, F.lane); dr[q] = ld_row_bf16(D1 + (size_t)rr[q] * D, F.lane); } }
#pragma unroll
        for (int q = 0; q < 4; ++q) if (rr[q] >= 0) st_row_bf16(U + (size_t)rr[q] * D, F.lane, modnorm2(radd(xr[q], dr[q]), gs, sh)); }
}

constexpr int SQK_STRIDE = 544;
constexpr int M1_SQ = 0, M1_SK = 128 * SQK_STRIDE, M1_TAB = 2 * 128 * SQK_STRIDE;
__device__ __forceinline__ float logsigmoidf_(float x) { return fminf(x, 0.f) - log1pf(__expf(-fabsf(x))); }

__device__ __forceinline__ void m1_item(const Frame& F, const Params& p, int bh, int cp) {
    const int b = bh >> 2, h = bh & 3; const bool is_lat = cp >= 2;
    const int seqlen = is_lat ? SEQ : CTXL, t0 = is_lat ? CH * (cp - 2) : CH * cp, rowbase = is_lat ? b * SEQ : TLAT + b * CTXL, pbase = CH * cp;
    const bf16* QPRE = (const bf16*)(p.ws + WS_QPRE); const bf16* KPRE = (const bf16*)(p.ws + WS_KPRE);
    LAS unsigned char* sQ = F.lds + M1_SQ; LAS unsigned char* sK = F.lds + M1_SK; LAS float* tab = (LAS float*)(F.lds + M1_TAB);
    const int lane = F.lane, w = F.wave, fr = lane & 15, fq = lane >> 4;
    {
        const int ch = 8 * (F.tid & 31), rb = 8 * (F.tid >> 5);
#define M1_CONV(SRC, CCH, SCALE, DST) do { \
        float w0[8], w1[8], w2[8], bb[8]; \
        _Pragma("unroll") for (int e = 0; e < 8; ++e) { const int cc = (CCH) + h * 256 + ch + e; w0[e] = p.conv_w[cc]; w1[e] = p.conv_w[2048 + cc]; w2[e] = p.conv_w[4096 + cc]; bb[e] = p.conv_b[cc]; } \
        u32x4 xr[10]; const bf16* base = (SRC) + (size_t)(rowbase + t0 + rb) * D + h * 256 + ch; \
        _Pragma("unroll") for (int i = 0; i < 10; ++i) { const int sq = t0 + rb + i - 1; xr[i] = (sq >= 0 && sq < seqlen) ? *(const u32x4*)(base + (ptrdiff_t)(i - 1) * D) : (u32x4){0u, 0u, 0u, 0u}; } \
        _Pragma("unroll") for (int i = 0; i < 8; ++i) { float o[8]; \
            _Pragma("unroll") for (int q = 0; q < 4; ++q) { \
                const float y0 = w0[2 * q] * bflo(xr[i][q]) + w1[2 * q] * bflo(xr[i + 1][q]) + w2[2 * q] * bflo(xr[i + 2][q]) + bb[2 * q]; \
                const float y1 = w0[2 * q + 1] * bfhi(xr[i][q]) + w1[2 * q + 1] * bfhi(xr[i + 1][q]) + w2[2 * q + 1] * bfhi(xr[i + 2][q]) + bb[2 * q + 1]; \
                o[2 * q] = siluf_(y0) * (SCALE); o[2 * q + 1] = siluf_(y1) * (SCALE); } \
            u32x4 wv; wv.x = pk2(o[0], o[1]); wv.y = pk2(o[2], o[3]); wv.z = pk2(o[4], o[5]); wv.w = pk2(o[6], o[7]); \
            *(LAS u32x4*)((DST) + (rb + i) * SQK_STRIDE + ch * 2) = wv; } } while (0)
        M1_CONV(KPRE, 1024, 0.0625f, sK);
        if (is_lat) M1_CONV(QPRE, 0, 1.0f, sQ);
#undef M1_CONV
    }
    if (w < 2) {
        const int dir = w; const float* G = (const float*)(p.ws + WS_GATES);
        const int i0 = 2 * lane, i1 = 2 * lane + 1, ta = dir ? 127 - i0 : i0, tb = dir ? 127 - i1 : i1;
        const float li0 = G[(size_t)(rowbase + t0 + ta) * 16 + dir * 8 + h], li1 = G[(size_t)(rowbase + t0 + tb) * 16 + dir * 8 + h];
        const float lf0 = logsigmoidf_(G[(size_t)(rowbase + t0 + ta) * 16 + dir * 8 + 4 + h]), lf1 = logsigmoidf_(G[(size_t)(rowbase + t0 + tb) * 16 + dir * 8 + 4 + h]);
        float ps = lf0 + lf1;
#pragma unroll
        for (int o = 1; o < 64; o <<= 1) { const float v = __shfl_up(ps, o); if (lane >= o) ps += v; }
        const float ex = ps - (lf0 + lf1), b0 = ex + lf0, b1 = ex + lf0 + lf1;
        const float r0 = li0 - b0, r1 = li1 - b1;
        float pm = fmaxf(r0, r1);
#pragma unroll
        for (int o = 1; o < 64; o <<= 1) { const float v = __shfl_up(pm, o); if (lane >= o) pm = fmaxf(pm, v); }
        const float pmex = __shfl_up(pm, 1); const float m0 = lane ? fmaxf(pmex, r0) : r0, m1 = pm;
        LAS float* tb_ = tab + dir * 384;
        tb_[ta] = b0; tb_[128 + ta] = r0; tb_[256 + ta] = m0; tb_[tb] = b1; tb_[128 + tb] = r1; tb_[256 + tb] = m1;
        float* TS = (float*)(p.ws + WS_TOKSC) + ((size_t)(dir * 16 + bh) * PLEN + pbase) * 4;
        TS[ta * 4 + 0] = b0; TS[ta * 4 + 1] = li0; TS[ta * 4 + 2] = b0 + m0; TS[tb * 4 + 0] = b1; TS[tb * 4 + 1] = li1; TS[tb * 4 + 2] = b1 + m1;
        if (lane == 63) { float* CS = (float*)(p.ws + WS_CHSC) + ((size_t)(dir * 16 + bh) * NCHK + cp) * 2; CS[0] = b1; CS[1] = b1 + m1; }
    }
    __syncthreads();
    {
        u32x4* KT = (u32x4*)(p.ws + WS_KT) + ((size_t)bh * NCHK + cp) * 4096;
        const int d = F.tid & 255, sgp = F.tid >> 8;
#pragma unroll
        for (int it = 0; it < 8; ++it) { const int sg = 2 * it + sgp; unsigned short e[8];
#pragma unroll
            for (int j = 0; j < 8; ++j) e[j] = *(const LAS unsigned short*)(sK + (8 * sg + j) * SQK_STRIDE + d * 2);
            u32x4 o; o.x = e[0] | ((unsigned)e[1] << 16); o.y = e[2] | ((unsigned)e[3] << 16); o.z = e[4] | ((unsigned)e[5] << 16); o.w = e[6] | ((unsigned)e[7] << 16);
            KT[((((d >> 5) * 2 + ((d >> 4) & 1)) * 4 + (sg >> 2)) * 64) + (sg & 3) * 16 + (d & 15)] = o; }
        if (is_lat) { u32x4* Q = (u32x4*)(p.ws + WS_Q) + ((size_t)bh * 32 + (cp - 2)) * 4096;
#pragma unroll
            for (int it = 0; it < 8; ++it) { const int piece = F.tid + 512 * it, row = piece >> 5, c16 = piece & 31;
                Q[((row >> 4) * 8 + (c16 >> 2)) * 64 + (c16 & 3) * 16 + (row & 15)] = *(const LAS u32x4*)(sQ + row * SQK_STRIDE + c16 * 16); } }
    }
    if (is_lat) {
        bf16x8 bq[8];
#pragma unroll
        for (int k = 0; k < 8; ++k) bq[k] = *(const LAS bf16x8*)(sQ + (16 * w + fr) * SQK_STRIDE + (32 * k + 8 * fq) * 2);
        f32x4 acc[8];
        { bf16x8 ac[8], an[8];
#pragma unroll
          for (int k = 0; k < 8; ++k) ac[k] = *(const LAS bf16x8*)(sK + fr * SQK_STRIDE + (32 * k + 8 * fq) * 2);
#pragma unroll
          for (int mt = 0; mt < 8; ++mt) { acc[mt] = (f32x4){0.f, 0.f, 0.f, 0.f};
            if (mt < 7) {
#pragma unroll
                for (int k = 0; k < 8; ++k) an[k] = *(const LAS bf16x8*)(sK + (16 * (mt + 1) + fr) * SQK_STRIDE + (32 * k + 8 * fq) * 2); }
#pragma unroll
            for (int k = 0; k < 8; ++k) acc[mt] = __builtin_amdgcn_mfma_f32_16x16x32_bf16(ac[k], bq[k], acc[mt], 0, 0, 0);
#pragma unroll
            for (int k = 0; k < 8; ++k) ac[k] = an[k]; } }
        const int t = 16 * w + fr, c = cp - 2;
        bf16* P = (bf16*)((unsigned char*)p.out + DO_P);
#pragma unroll
        for (int dir = 0; dir < 2; ++dir) {
            const LAS float* tb_ = tab + dir * 384; const float mx = tb_[256 + t]; float dsum = 0.f;
            unsigned char* pblk = (unsigned char*)(P + ((size_t)(dir * 16 + bh) * 32 + c) * 128 * 128);
#pragma unroll
            for (int mt = 0; mt < 8; ++mt) { const int s0 = 16 * mt + 4 * fq; const f32x4 rs = *(const LAS f32x4*)(tb_ + 128 + s0); float pv[4];
#pragma unroll
                for (int r = 0; r < 4; ++r) { const int s = s0 + r; const bool valid = dir ? (s >= t) : (s <= t);
                    const float wgt = valid ? __expf(fminf(rs[r] - mx, 0.f)) : 0.f; pv[r] = bf2f(f2bf(acc[mt][r] * wgt)); dsum += pv[r]; }
                u32x2 o; o.x = pk2(pv[0], pv[1]); o.y = pk2(pv[2], pv[3]); const int s8 = 2 * mt + (fq >> 1);
                *(u32x2*)(pblk + ((w * 4 + (s8 >> 2)) * 64 + (s8 & 3) * 16 + fr) * 16 + (fq & 1) * 8) = o; }
            dsum += __shfl_xor(dsum, 16); dsum += __shfl_xor(dsum, 32);
            if (fq == 0) ((float*)(p.ws + WS_TOKSC))[((size_t)(dir * 16 + bh) * PLEN + pbase + t) * 4 + 3] = dsum;
        }
    }
    __syncthreads();
}

constexpr int FO_TAB = 131072;
__device__ __forceinline__ int fo_off(int R, int r) { return R * 128 + ((((r >> 3) ^ ((R >> 1) & 7))) << 4) + (r & 7) * 2; }
__device__ __forceinline__ void fourier_item(const Frame& F, const Params& p, int item) {
    const int b = item >> 6, i = item & 63; const int lane = F.lane, w = F.wave, fr = lane & 15, fq = lane >> 4;
    LAS unsigned char* sPQ = F.lds; LAS float* ct = (LAS float*)(F.lds + FO_TAB);
    if (F.tid < 64) ct[F.tid] = cosf((float)F.tid * (6.283185307179586f / 64.0f));
    __syncthreads();
    const bf16* XT = (const bf16*)(p.ws + WS_XFT);
    {
        const bf16* xrow_ = XT + (size_t)(8 * i + w) * TLAT + b * SEQ;
        bf16x8 xv[4][2];
#pragma unroll
        for (int nt = 0; nt < 4; ++nt) { const int r = 16 * nt + fr; xv[nt][0] = *(const bf16x8*)(xrow_ + r * 64 + 8 * fq); xv[nt][1] = *(const bf16x8*)(xrow_ + r * 64 + 32 + 8 * fq); }
#pragma unroll 1
        for (int mt = 0; mt < 8; ++mt) {
            bf16x8 WA[2];
#pragma unroll
            for (int k = 0; k < 2; ++k) { const int kc = (16 * mt + fr) & 63, sh = (mt >> 2) * 48; bf16x8 v;
#pragma unroll
                for (int j = 0; j < 8; ++j) { const int c = 32 * k + 8 * fq + j; v[j] = (short)f2bf(ct[(kc * c + sh) & 63]); }
                WA[k] = v; }
#pragma unroll
            for (int nt = 0; nt < 4; ++nt) { const int r = 16 * nt + fr; f32x4 a = (f32x4){0.f, 0.f, 0.f, 0.f};
                a = __builtin_amdgcn_mfma_f32_16x16x32_bf16(WA[0], xv[nt][0], a, 0, 0, 0); a = __builtin_amdgcn_mfma_f32_16x16x32_bf16(WA[1], xv[nt][1], a, 0, 0, 0);
#pragma unroll
                for (int rg = 0; rg < 4; ++rg) { const int kcp = 16 * mt + 4 * fq + rg; *(LAS unsigned short*)(sPQ + fo_off(kcp * 8 + w, r)) = (unsigned short)f2bf(a[rg]); } } }
    }
    __syncthreads();
    {
        bf16x8 WB[4];
        const int kr = (16 * w + fr) & 63, half = w >> 2;
#pragma unroll
        for (int ks = 0; ks < 4; ++ks) { const int pq = ks >> 1; unsigned short e[8];
#pragma unroll
            for (int j = 0; j < 8; ++j) { const int r = 32 * (ks & 1) + 8 * fq + j;
                float v; if (half == pq) v = ct[(kr * r) & 63]; else { v = ct[(kr * r + 48) & 63]; if (half == 0) v = -v; }
                e[j] = (unsigned short)f2bf(v * 0.015625f); }
            bf16x8 v; v[0] = (short)e[0]; v[1] = (short)e[1]; v[2] = (short)e[2]; v[3] = (short)e[3]; v[4] = (short)e[4]; v[5] = (short)e[5]; v[6] = (short)e[6]; v[7] = (short)e[7]; WB[ks] = v; }
        bf16* UF = (bf16*)(p.ws + WS_UF) + (size_t)(b * SEQ + (16 * (w & 3) + fr) * 64) * D + 16 * i + 8 * half + 4 * (fq & 1);
#pragma unroll 4
        for (int nt = 0; nt < 32; ++nt) { f32x4 a = (f32x4){0.f, 0.f, 0.f, 0.f};
#pragma unroll
            for (int ks = 0; ks < 4; ++ks) { const int R = (ks >> 1) * 512 + 16 * nt + fr, q = 4 * (ks & 1) + fq;
                const bf16x8 bb = *(const LAS bf16x8*)(sPQ + R * 128 + ((q ^ ((R >> 1) & 7)) << 4));
                a = __builtin_amdgcn_mfma_f32_16x16x32_bf16(bb, WB[ks], a, 0, 0, 0); }
            u32x2 o; o.x = pk2(a[0], a[1]); o.y = pk2(a[2], a[3]);
            *(u32x2*)(UF + (size_t)(2 * nt + (fq >> 1)) * D) = o; }
    }
    __syncthreads();
}

constexpr int M2_CT = 0, M2_CTB = 48 * 544, M2_VT = 2 * M2_CTB, M2_VTB = 32 * 288, M2_VW = M2_VT + 2 * M2_VTB, M2_VWB = 48 * 288, M2_TAB = M2_VW + 2 * M2_VWB, M2_TABB = 5 * 512, M2_SC = M2_TAB + 3 * M2_TABB, M2_HS = M2_SC + 1024;
struct M2Step { int cp, is_lat, p0, tl0, tokrow0; };
__device__ __forceinline__ M2Step m2_step(int dir, int b, int j) {
    M2Step s; const int jj = j < NCHK ? j : NCHK - 1;
    s.cp = dir ? (jj == 0 ? 1 : (jj == 1 ? 0 : 35 - jj)) : jj; s.is_lat = s.cp >= 2; s.p0 = CH * s.cp; s.tl0 = s.is_lat ? CH * (s.cp - 2) : 0;
    s.tokrow0 = s.is_lat ? b * SEQ + s.tl0 : TLAT + b * CTXL + CH * s.cp; return s;
}
__device__ __forceinline__ void m2_stream(const Frame& F, const Params& p, int sid) {
    const int x = sid & 7, jj_ = sid >> 3, gl = jj_ >> 3, slice = jj_ & 7, g = x + 8 * gl, dir = g >> 4, bh = g & 15, b = bh >> 2, h = bh & 3;
    int tid = F.tid; asm volatile("" : "+v"(tid)); const int lane = tid & 63, w = F.wave, fr = lane & 15, fq = lane >> 4, wa = w & 3, tr = tid & 255;
    const bool roleA = w < 4;
    LAS unsigned char* L = F.lds;
    LAS float* smst = (LAS float*)(L + M2_SC); LAS float* smnw = smst + 34; LAS float* sdec = smst + 68; LAS float* scs = smst + 102;
    const float* TS = (const float*)(p.ws + WS_TOKSC) + (size_t)(dir * 16 + bh) * PLEN * 4;
    const float* CS = (const float*)(p.ws + WS_CHSC) + (size_t)(dir * 16 + bh) * NCHK * 2;
    const bf16* VT = (const bf16*)(p.ws + WS_VT) + (size_t)(h * 256 + slice * 32 + (tr >> 4)) * MTOK + 8 * (tr & 15);
    const bf16x8* KT = (const bf16x8*)(p.ws + WS_KT) + (size_t)bh * NCHK * 4096 + wa * 1024 + lane;
    const bf16x8* Q = (const bf16x8*)(p.ws + WS_Q) + (size_t)bh * 32 * 4096 + wa * 1024 + lane;
    const bf16x8* P = (const bf16x8*)((const unsigned char*)p.out + DO_P) + (size_t)(dir * 16 + bh) * 32 * 2048 + wa * 512 + lane;
    bf16* H = (bf16*)(p.ws + (dir ? WS_HB : WS_HF)) + (size_t)((bh * 8 + slice) * SEQ) * 32;
    for (int i = tid; i < M2_TAB / 4; i += NTHR) ((LAS unsigned*)L)[i] = 0u;
    if (tid < 2 * NCHK) scs[tid] = CS[tid];
    __syncthreads();
    if (tid == 0) { float m = 0.f;
        for (int j = 0; j < NCHK; ++j) { const M2Step st = m2_step(dir, b, j); const float bL = scs[st.cp * 2], gmax = scs[st.cp * 2 + 1];
            const float mn = fmaxf(bL + m, gmax); smst[j] = m; smnw[j] = mn; sdec[j] = __expf(bL + m - mn); m = mn; } }
    __syncthreads();
#define M2_TABLES(jj, stp, sc) do { if (tr < 128 && (jj) < NCHK) { LAS float* tb_ = (LAS float*)(L + M2_TAB + ((jj) % 3) * M2_TABB); const float bL = scs[(stp).cp * 2], mst_ = smst[jj], mnw_ = smnw[jj]; \
        tb_[512 + tr] = __expf(fminf(bL - (sc)[0] + (sc)[1] - mnw_, 0.f)); \
        const float mt_ = fmaxf((sc)[0] + mst_, (sc)[2]); const float c_ = __expf((sc)[2] - mt_); \
        *(LAS f32x4*)(tb_ + 4 * tr) = (f32x4){__expf((sc)[0] + mst_ - mt_), c_, c_ * (sc)[3], __expf(-mt_)}; } } while (0)
#define M2_VSTAGE(jj, va, vb) do { if ((jj) < NCHK) { const LAS float* tb_ = (const LAS float*)(L + M2_TAB + ((jj) % 3) * M2_TABB); const int e = tr >> 4, sg = tr & 15; \
        const f32x4 wa_ = *(const LAS f32x4*)(tb_ + 512 + 8 * sg), wb_ = *(const LAS f32x4*)(tb_ + 516 + 8 * sg); u32x4 o_; \
        *(LAS u32x4*)(L + M2_VT + ((jj) & 1) * M2_VTB + e * 288 + sg * 16) = (va); *(LAS u32x4*)(L + M2_VT + ((jj) & 1) * M2_VTB + (e + 16) * 288 + sg * 16) = (vb); \
        o_[0] = pk2(bflo((va)[0]) * wa_[0], bfhi((va)[0]) * wa_[1]); o_[1] = pk2(bflo((va)[1]) * wa_[2], bfhi((va)[1]) * wa_[3]); o_[2] = pk2(bflo((va)[2]) * wb_[0], bfhi((va)[2]) * wb_[1]); o_[3] = pk2(bflo((va)[3]) * wb_[2], bfhi((va)[3]) * wb_[3]); \
        *(LAS u32x4*)(L + M2_VW + ((jj) & 1) * M2_VWB + e * 288 + sg * 16) = o_; \
        o_[0] = pk2(bflo((vb)[0]) * wa_[0], bfhi((vb)[0]) * wa_[1]); o_[1] = pk2(bflo((vb)[1]) * wa_[2], bfhi((vb)[1]) * wa_[3]); o_[2] = pk2(bflo((vb)[2]) * wb_[0], bfhi((vb)[2]) * wb_[1]); o_[3] = pk2(bflo((vb)[3]) * wb_[2], bfhi((vb)[3]) * wb_[3]); \
        *(LAS u32x4*)(L + M2_VW + ((jj) & 1) * M2_VWB + (e + 16) * 288 + sg * 16) = o_; \
        if (tr < 16) { u32x4 o2; o2[0] = pk2(wa_[0], wa_[1]); o2[1] = pk2(wa_[2], wa_[3]); o2[2] = pk2(wb_[0], wb_[1]); o2[3] = pk2(wb_[2], wb_[3]); \
            *(LAS u32x4*)(L + M2_VW + ((jj) & 1) * M2_VWB + 32 * 288 + tr * 16) = o2; } } } while (0)
#define M2_LDQ(QQ, st) do { const bf16x8* q_ = Q + (size_t)((st).is_lat ? (st).cp - 2 : 0) * 4096; _Pragma("unroll") for (int k = 0; k < 8; ++k) { (QQ)[0][k] = q_[k * 64]; (QQ)[1][k] = q_[(8 + k) * 64]; } } while (0)
#define M2_LDP(st) do { const bf16x8* p_ = P + (size_t)((st).is_lat ? (st).cp - 2 : 0) * 2048; _Pragma("unroll") for (int k = 0; k < 4; ++k) { pa[0][k] = p_[k * 64]; pa[1][k] = p_[(4 + k) * 64]; } } while (0)
#define M2_LDK(KK, st) do { const bf16x8* k_ = KT + (size_t)(st).cp * 4096; _Pragma("unroll") for (int mt = 0; mt < 4; ++mt) _Pragma("unroll") for (int k = 0; k < 4; ++k) (KK)[mt][k] = k_[(mt * 4 + k) * 64]; } while (0)
    const M2Step s0 = m2_step(dir, b, 0), s1 = m2_step(dir, b, 1);
    if (!roleA) { const f32x4 t0 = *(const f32x4*)(TS + (size_t)(s0.p0 + (tr & 127)) * 4), t1 = *(const f32x4*)(TS + (size_t)(s1.p0 + (tr & 127)) * 4);
        M2_TABLES(0, s0, t0); M2_TABLES(1, s1, t1); }
    __syncthreads();
    if (!roleA) { const u32x4 v0a = *(const u32x4*)(VT + s0.tokrow0), v0b = *(const u32x4*)(VT + (size_t)16 * MTOK + s0.tokrow0); M2_VSTAGE(0, v0a, v0b); }
    if (roleA) {
        bf16x8 qa[2][2][8], pa[2][4];
        M2_LDQ(qa[0], s0); M2_LDP(s0);
        __syncthreads();
        for (int jj = 0; jj < NCHK; jj += 2) {
#pragma unroll
          for (int u = 0; u < 2; ++u) { const int j = jj + u;
            const M2Step sj = m2_step(dir, b, j), sn = m2_step(dir, b, j + 1);
            const bf16x8* qn_ = Q + (size_t)(sn.is_lat ? sn.cp - 2 : 0) * 4096;
            if (!sj.is_lat) { M2_LDQ(qa[u ^ 1], sn); }
            if (j > 0) { const M2Step sp = m2_step(dir, b, j - 1);
                if (sp.is_lat) {
#pragma unroll
                    for (int i2 = 0; i2 < 2; ++i2) { const int pc = tr + 256 * i2; const u32x4 hv = *(const LAS u32x4*)(L + M2_HS + ((j - 1) & 1) * 8192 + pc * 16);
                        stgw(H, (unsigned)(sp.tl0 * 64 + pc * 16), hv); } } }
            if (sj.is_lat) {
                const LAS unsigned char* sCT = L + M2_CT + (j & 1) * M2_CTB; const LAS unsigned char* sVT = L + M2_VT + (j & 1) * M2_VTB;
                const LAS float* tb = (const LAS float*)(L + M2_TAB + (j % 3) * M2_TABB);
                f32x4 aI[2][3], aA[2][2];
#pragma unroll
                for (int mt = 0; mt < 2; ++mt) {
#pragma unroll
                    for (int nt = 0; nt < 3; ++nt) aI[mt][nt] = (f32x4){0.f, 0.f, 0.f, 0.f};
                    aA[mt][0] = (f32x4){0.f, 0.f, 0.f, 0.f}; aA[mt][1] = (f32x4){0.f, 0.f, 0.f, 0.f}; }
                bf16x8 bc[3], bn[3];
#pragma unroll
                for (int nt = 0; nt < 3; ++nt) bc[nt] = *(const LAS bf16x8*)(sCT + (16 * nt + fr) * 544 + (8 * fq) * 2);
#pragma unroll
                for (int k = 0; k < 8; ++k) {
                    if (k < 7) {
#pragma unroll
                        for (int nt = 0; nt < 3; ++nt) bn[nt] = *(const LAS bf16x8*)(sCT + (16 * nt + fr) * 544 + (32 * (k + 1) + 8 * fq) * 2); }
#pragma unroll
                    for (int nt = 0; nt < 3; ++nt) {
                        aI[0][nt] = __builtin_amdgcn_mfma_f32_16x16x32_bf16(qa[u][0][k], bc[nt], aI[0][nt], 0, 0, 0);
                        aI[1][nt] = __builtin_amdgcn_mfma_f32_16x16x32_bf16(qa[u][1][k], bc[nt], aI[1][nt], 0, 0, 0); }
                    qa[u ^ 1][0][k] = qn_[k * 64]; qa[u ^ 1][1][k] = qn_[(8 + k) * 64];
                    __builtin_amdgcn_sched_barrier(0);
#pragma unroll
                    for (int nt = 0; nt < 3; ++nt) bc[nt] = bn[nt]; }
                { bf16x8 vc[2], vn2[2];
#pragma unroll
                  for (int nt = 0; nt < 2; ++nt) vc[nt] = *(const LAS bf16x8*)(sVT + (16 * nt + fr) * 288 + (8 * fq) * 2);
#pragma unroll
                  for (int k = 0; k < 4; ++k) {
                    if (k < 3) {
#pragma unroll
                        for (int nt = 0; nt < 2; ++nt) vn2[nt] = *(const LAS bf16x8*)(sVT + (16 * nt + fr) * 288 + (32 * (k + 1) + 8 * fq) * 2); }
#pragma unroll
                    for (int nt = 0; nt < 2; ++nt) {
                        aA[0][nt] = __builtin_amdgcn_mfma_f32_16x16x32_bf16(pa[0][k], vc[nt], aA[0][nt], 0, 0, 0);
                        aA[1][nt] = __builtin_amdgcn_mfma_f32_16x16x32_bf16(pa[1][k], vc[nt], aA[1][nt], 0, 0, 0); }
                    vc[0] = vn2[0]; vc[1] = vn2[1]; } }
                M2_LDP(sn);
                LAS unsigned short* sH = (LAS unsigned short*)(L + M2_HS + (j & 1) * 8192);
#pragma unroll
                for (int mt = 0; mt < 2; ++mt)
#pragma unroll
                    for (int rg = 0; rg < 4; ++rg) { const int t = 32 * wa + 16 * mt + 4 * fq + rg;
                        const float qn_ = __shfl(aI[mt][2][rg], lane & 48);
                        const f32x4 tv = *(const LAS f32x4*)(tb + 4 * t);
                        const float inv = __builtin_amdgcn_rcpf(fmaxf(fabsf(tv[0] * qn_ + tv[2]), tv[3]));
                        const unsigned hp = pk2((tv[0] * aI[mt][0][rg] + tv[1] * aA[mt][0][rg]) * inv, (tv[0] * aI[mt][1][rg] + tv[1] * aA[mt][1][rg]) * inv);
                        sH[t * 32 + fr] = (unsigned short)hp; sH[t * 32 + 16 + fr] = (unsigned short)(hp >> 16); }
            } else { M2_LDP(sn); }
            __syncthreads();
          }
        }
        { const M2Step sp = m2_step(dir, b, NCHK - 1);
          if (sp.is_lat) {
#pragma unroll
            for (int i2 = 0; i2 < 2; ++i2) { const int pc = tr + 256 * i2; const u32x4 hv = *(const LAS u32x4*)(L + M2_HS + ((NCHK - 1) & 1) * 8192 + pc * 16);
                stgw(H, (unsigned)(sp.tl0 * 64 + pc * 16), hv); } } }
    } else {
        bf16x8 ka[2][4][4];
        f32x4 accC[4][3];
#pragma unroll
        for (int mt = 0; mt < 4; ++mt)
#pragma unroll
            for (int nt = 0; nt < 3; ++nt) accC[mt][nt] = (f32x4){0.f, 0.f, 0.f, 0.f};
        M2_LDK(ka[0], s0);
        u32x4 vna = *(const u32x4*)(VT + s1.tokrow0), vnb = *(const u32x4*)(VT + (size_t)16 * MTOK + s1.tokrow0);
        f32x4 tn2 = *(const f32x4*)(TS + (size_t)(m2_step(dir, b, 2).p0 + (tr & 127)) * 4);
        __syncthreads();
        for (int jj = 0; jj < NCHK; jj += 2) {
#pragma unroll
          for (int u = 0; u < 2; ++u) { const int j = jj + u;
            const M2Step sn = m2_step(dir, b, j + 1), sn2 = m2_step(dir, b, j + 2);
            M2_VSTAGE(j + 1, vna, vnb);
            M2_TABLES(j + 2, sn2, tn2);
            const bf16x8* kn_ = KT + (size_t)sn.cp * 4096;
            const LAS unsigned char* sVW = L + M2_VW + (j & 1) * M2_VWB; const float dec = sdec[j];
            const u32x4 vxa = *(const u32x4*)(VT + sn2.tokrow0), vxb = *(const u32x4*)(VT + (size_t)16 * MTOK + sn2.tokrow0);
            const f32x4 tn3 = *(const f32x4*)(TS + (size_t)(m2_step(dir, b, j + 3).p0 + (tr & 127)) * 4);
#pragma unroll
            for (int mt = 0; mt < 4; ++mt)
#pragma unroll
                for (int nt = 0; nt < 3; ++nt) accC[mt][nt] = accC[mt][nt] * dec;
            { bf16x8 wc[3], wn[3];
#pragma unroll
              for (int nt = 0; nt < 3; ++nt) wc[nt] = *(const LAS bf16x8*)(sVW + (16 * nt + fr) * 288 + (8 * fq) * 2);
#pragma unroll
              for (int k = 0; k < 4; ++k) {
                if (k < 3) {
#pragma unroll
                    for (int nt = 0; nt < 3; ++nt) wn[nt] = *(const LAS bf16x8*)(sVW + (16 * nt + fr) * 288 + (32 * (k + 1) + 8 * fq) * 2); }
#pragma unroll
                for (int nt = 0; nt < 3; ++nt)
#pragma unroll
                    for (int mt = 0; mt < 4; ++mt) accC[mt][nt] = __builtin_amdgcn_mfma_f32_16x16x32_bf16(ka[u][mt][k], wc[nt], accC[mt][nt], 0, 0, 0);
#pragma unroll
                for (int mt = 0; mt < 4; ++mt) ka[u ^ 1][mt][k] = kn_[(mt * 4 + k) * 64];
                __builtin_amdgcn_sched_barrier(0);
#pragma unroll
                for (int nt = 0; nt < 3; ++nt) wc[nt] = wn[nt]; } }
            { LAS unsigned char* dCT = L + M2_CT + ((j + 1) & 1) * M2_CTB;
#pragma unroll
              for (int mt = 0; mt < 4; ++mt)
#pragma unroll
                for (int nt = 0; nt < 3; ++nt) { u32x2 o; o.x = pk2(accC[mt][nt][0], accC[mt][nt][1]); o.y = pk2(accC[mt][nt][2], accC[mt][nt][3]);
                    *(LAS u32x2*)(dCT + (16 * nt + fr) * 544 + (64 * wa + 16 * mt + 4 * fq) * 2) = o; } }
            vna = vxa; vnb = vxb; tn2 = tn3;
            __syncthreads();
          }
        }
    }
    __syncthreads();
#undef M2_LDQ
#undef M2_LDP
#undef M2_LDK
#undef M2_TABLES
#undef M2_VSTAGE
}

#define XB_TMO      128
#define XB_XCNT(j)  (256  + 64 * (j))
#define XB_XSUB(j)  (1280 + 64 * (j))
#define XB_XGEN(j)  (2304 + 64 * (j))
#define XB_TOP      3328
#define XB_TOPGEN   3392
#define XB_SPIN_CAP (1u << 22)
__device__ __forceinline__ unsigned xb_ld(unsigned* p)              { return __hip_atomic_load(p, __ATOMIC_RELAXED, __HIP_MEMORY_SCOPE_AGENT); }
__device__ __forceinline__ unsigned xb_add(unsigned* p, unsigned v) { return __hip_atomic_fetch_add(p, v, __ATOMIC_RELAXED, __HIP_MEMORY_SCOPE_AGENT); }
__device__ __forceinline__ unsigned xb_xcc_id() { return (unsigned)__builtin_amdgcn_s_getreg((3 << 11) | 20) & 0xFu; }
#define XB_SPIN(cond, bar) do { unsigned _sp = 0; while (cond) { __builtin_amdgcn_s_sleep(1); \
    if ((++_sp & 255u) == 0u) { if (xb_ld(&(bar)[XB_TMO])) break; if (_sp > XB_SPIN_CAP) { atomicAdd(&(bar)[XB_TMO], 1u); break; } } } } while (0)
struct XcdBarrier { unsigned* bar; unsigned x; volatile LAS unsigned* st; };
__device__ __forceinline__ XcdBarrier xcd_barrier_post(unsigned* bar, volatile LAS unsigned* st) {
    XcdBarrier b; b.bar = bar; b.x = xb_xcc_id(); b.st = st;
    if (threadIdx.x == 0) (void)xb_add(&bar[XB_XCNT(b.x)], 1u);
    return b;
}
__device__ __forceinline__ void xcd_barrier_complete(unsigned* bar, unsigned x, unsigned& nloc, unsigned& nx) {
    const unsigned G = gridDim.x * gridDim.y * gridDim.z;
    unsigned sum, cnt, mine, sp = 0u;
    for (;;) {
        sum = 0u; cnt = 0u; mine = 0u;
#pragma unroll
        for (unsigned j = 0; j < 16; ++j) { const unsigned c = xb_ld(&bar[XB_XCNT(j)]); sum += c; cnt += (c > 0u) ? 1u : 0u; mine = (j == x) ? c : mine; }
        if (sum == G) break;
        __builtin_amdgcn_s_sleep(1);
        if ((++sp & 255u) == 0u) { if (xb_ld(&bar[XB_TMO])) break; if (sp > XB_SPIN_CAP) { atomicAdd(&bar[XB_TMO], 1u); break; } }
    }
    nloc = mine > 0u ? mine : 1u; nx = cnt > 0u ? cnt : 1u;
}
__device__ __forceinline__ void xcd_barrier(const XcdBarrier& b) {
    asm volatile("s_waitcnt vmcnt(0)" ::: "memory");
    __syncthreads();
    if (threadIdx.x == 0) {
        unsigned* bar = b.bar;
        __builtin_amdgcn_s_waitcnt(0);
        unsigned nloc = b.st[0], nx = b.st[1];
        if (nloc == 0u) { xcd_barrier_complete(bar, b.x, nloc, nx); b.st[0] = nloc; b.st[1] = nx; }
        const unsigned old = xb_add(&bar[XB_XSUB(b.x)], 1u);
        const unsigned gen = old / nloc;
        if (old + 1u == (gen + 1u) * nloc) {
            __builtin_amdgcn_fence(__ATOMIC_RELEASE, "agent");
            asm volatile("s_waitcnt vmcnt(0)" ::: "memory");
            const unsigned og = xb_add(&bar[XB_TOP], 1u);
            const unsigned tg = og / nx;
            if (og + 1u == (tg + 1u) * nx) xb_add(&bar[XB_TOPGEN], 1u);
            else XB_SPIN(xb_ld(&bar[XB_TOPGEN]) == tg, bar);
            __builtin_amdgcn_fence(__ATOMIC_ACQUIRE, "agent");
            xb_add(&bar[XB_XGEN(b.x)], 1u);
            asm volatile("s_waitcnt vmcnt(0)" ::: "memory");
        } else {
            XB_SPIN(xb_ld(&bar[XB_XGEN(b.x)]) == gen, bar);
            __builtin_amdgcn_fence(__ATOMIC_ACQUIRE, "agent");
            asm volatile("s_waitcnt vmcnt(0)" ::: "memory");
        }
    }
    __syncthreads();
}

__device__ __forceinline__ pg8::Seg mkseg(const void* A0, const void* B0, int nM, int nN, int kind, int ksplit = 1) { pg8::Seg s; s.A0 = (const char*)A0; s.B0 = (const char*)B0; s.nM = nM; s.nN = nN; s.kind = kind; s.ksplit = ksplit; return s; }
__device__ __forceinline__ pg8::Sched mksched(int K) { pg8::Sched S; S.s[0] = S.s[1] = S.s[2] = S.s[3] = mkseg(nullptr, nullptr, 0, 0, 0); S.G = gridDim.x; S.c = blockIdx.x; S.tstep = (size_t)256 * K * 2; S.ntk = K / 64; return S; }

__device__ __forceinline__ int fo_map(int c) { const int x = c & 7, slot = c >> 3, j = slot & 3, G = (slot >> 2) * 8 + x; return G * 4 + j; }
__global__ void __launch_bounds__(NTHR) mega_fwd(Params p) {
    extern __shared__ __attribute__((aligned(16))) unsigned char lds_raw[];
    Frame F;
#define REFRAME() do { int t_ = threadIdx.x; asm volatile("" : "+v"(t_)); F.lds = (LAS unsigned char*)lds_raw; F.tid = t_; F.lane = t_ & 63; F.wave = __builtin_amdgcn_readfirstlane(t_ >> 6); \
        F.gw = blockIdx.x * NWAVE + F.wave; F.ngw = gridDim.x * NWAVE; } while (0)
    REFRAME();
    unsigned char* ws = p.ws; unsigned char* dout = (unsigned char*)p.out;
    volatile LAS unsigned* bst = (volatile LAS unsigned*)(F.lds + LDS_BYTES - 16);
    if (F.tid < 4) bst[F.tid] = 0u;
    __syncthreads();
    const XcdBarrier gbar = xcd_barrier_post((unsigned*)(ws + WS_BAR), bst);
#define GSYNC() do { xcd_barrier(gbar); REFRAME(); } while (0)

#define SUBF(first, count) Frame F2 = F; const bool mine = gridDim.x != 256 || (int)blockIdx.x >= (first); if (gridDim.x == 256) { F2.gw = ((int)blockIdx.x - (first)) * NWAVE + F.wave; F2.ngw = (count) * NWAVE; }
    constexpr int I13 = 16 * 176, I2 = 44 * 32, IIN = 16 * (WIN_ROWS / 32), ISQ = 16 * 32;
    ada_phase(F, p);
    { SUBF(144, 112);
      if (mine) { conv_w13(F2, p.w13_a, (bf16*)(ws + WS_W13), 0, I13);
        LAS float* scr = (LAS float*)(F.lds + F.wave * 16384);
        for (int it = F2.gw; it < 16; it += F2.ngw) transpose_item(p.w_in, D, INW, (bf16*)(ws + WS_WG), 0, COL_GATES, 64 * it, scr, F.lane);
        u32x4* z = (u32x4*)(ws + WS_WG + 32 * D * 2); for (int i = (F2.gw >> 3) * NTHR + F.tid; i < 224 * D * 2 / 16; i += (F2.ngw >> 3) * NTHR) z[i] = (u32x4){0u, 0u, 0u, 0u}; } }
    GSYNC();
    phase_u1(F, p);
    GSYNC();
    { pg8::Sched S = mksched(D); S.s[0] = mkseg(ws + WS_U, ws + WS_W13, MTOK / 256, 22, 0); EpiSwiglu E{(bf16*)(ws + WS_ACT)}; pg8::gemm_phase(F.lds, D, S, E); }
    { SUBF(216, 40); if (mine) { __syncthreads(); conv_plain(F2, p.w2_a, FF, D, (bf16*)(ws + WS_W2), 0, I2); } }
    GSYNC();
    { pg8::Sched S = mksched(FF); S.s[0] = mkseg(ws + WS_ACT, ws + WS_W2, TLAT / 256, 4, 0);
      float* xb = (float*)(ws + WS_XCH2); unsigned* xc = (unsigned*)(ws + WS_XCNT) + 3 * 64 * 64;
      EpiMixT<true, 2, 4, 3> E{p.x, p.norm_g + 1 * D, p.norm_g + 2 * D, (const float*)(ws + WS_MOD), (bf16*)(dout + DO_D1), (bf16*)(ws + WS_U2),
                      PanelRms{xb, xc}, PanelRms{xb + 65536, xc + 64 * 64}, (LAS float*)(F.lds + pg8::STAGE_BYTES)};
      if (gridDim.x == 256) pg8::gemm_phase(F.lds, FF, S, E); }
    { pg8::Sched S = mksched(FF); S.s[0] = mkseg(ws + WS_ACT + (size_t)TLAT * FF * 2, ws + WS_W2, TCTX / 256, 4, 1, 8);
      EpiDownA E{(bf16*)(ws + WS_Y1), (float*)(ws + WS_Y1C)}; pg8::gemm_phase(F.lds, FF, S, E); }
    { SUBF(128, 128); if (mine) { __syncthreads(); conv_win(F2, p.w_in, (bf16*)(ws + WS_WIN), 0, IIN); } }
    GSYNC();
    phase_post_ffn_a(F, p);
    GSYNC();
    { pg8::Sched S = mksched(D); const unsigned char* W = ws + WS_WIN;
      S.s[0] = mkseg(ws + WS_U2, W + (size_t)ROW_Q * D * 2, TLAT / 256, 4, 0);
      S.s[1] = mkseg(ws + WS_U2, W + (size_t)ROW_K * D * 2, MTOK / 256, 4, 5);
      S.s[2] = mkseg(W + (size_t)ROW_V * D * 2, ws + WS_U2, 4, MTOK / 256, 2);
      S.s[3] = mkseg(W + (size_t)ROW_F * D * 2, ws + WS_U2, 2, TLAT / 256, 3);
      EpiProjA E{(bf16*)(ws + WS_QPRE), (bf16*)(ws + WS_KPRE), (bf16*)(ws + WS_VT), (bf16*)(ws + WS_XFT), p.b_in, (float*)(ws + WS_GATES)}; pg8::gemm_phase(F.lds, D, S, E); }
    { SUBF(160, 96); if (mine) { __syncthreads(); { const float* w13 = p.w13_b; const float* wmp = p.w_mproj; const float* wou = p.w_out;
          conv_loop(F2, 0, I13 + 2 * ISQ, D, (bf16*)ws, [&](int r) {
            if (r < I13) { const int kb = r / 176, nb = r % 176, n0 = 32 * nb, j = n0 >> 8, s_ = (n0 >> 7) & 1, i0 = n0 & 127;
                return TrItem{w13 + (size_t)(64 * kb) * (2 * FF) + s_ * FF + 128 * j + i0, 2 * FF, (int)(WS_W13B / (D * 2)) + n0, 64 * kb, s_ ? 0.6931471805599453f : 1.4426950408889634f}; }
            const int q = r - I13, sel = q >= ISQ, r2 = sel ? q - ISQ : q, kb = r2 / 32, nb = r2 % 32;
            return TrItem{(sel ? wou : wmp) + (size_t)(64 * kb) * D + 32 * nb, D, (int)((sel ? WS_WOUT : WS_WMPROJ) / (D * 2)) + 32 * nb, 64 * kb, 1.0f}; }); }
        __syncthreads(); gate_stage(F, p, (LAS bf16x8*)F.lds); __syncthreads();
        for (int t = F2.gw; t < MTOK / 16; t += F2.ngw) gate_tile(F, p, (const LAS bf16x8*)F.lds, 16 * t); } }
    GSYNC();
    for (int it = blockIdx.x; it < 16 * NCHK; it += gridDim.x) { if (it < 512) m1_item(F, p, it & 15, 2 + (it >> 4)); else m1_item(F, p, (it - 512) & 15, (it - 512) >> 4); }
    { SUBF(32, 224); if (mine) { __syncthreads(); wfour_phase(F, p, F2.gw, F2.ngw); } }
    GSYNC();
    for (int sid = blockIdx.x; sid < 256; sid += gridDim.x) m2_stream(F, p, sid);
    GSYNC();
    { const bool swp = (blockIdx.x >> 5) & 1;
      if (swp) { for (int it = blockIdx.x; it < 256; it += gridDim.x) fourier_item(F, p, fo_map(it)); __syncthreads(); }
      { pg8::Sched S = mksched(D); S.s[0] = mkseg(ws + WS_U2, ws + WS_WIN + (size_t)ROW_O * D * 2, TLAT / 256, 4, 0);
        EpiX E{(bf16*)(ws + WS_HM), (bf16*)(dout + DO_TF), (const bf16*)(ws + WS_HF), (const bf16*)(ws + WS_HB), p.b_in, p.head_g, (LAS float*)(F.lds + pg8::STAGE_BYTES)}; pg8::gemm_phase(F.lds, D, S, E); }
      if (!swp) { __syncthreads(); for (int it = blockIdx.x; it < 256; it += gridDim.x) fourier_item(F, p, fo_map(it)); } }
    GSYNC();
    if (gridDim.x == 256) {
      pg8::SchedY S; S.base = mksched(D); S.base.s[0] = mkseg(ws + WS_HM, ws + WS_WMPROJ, TLAT / 256, 4, 1); S.base.s[1] = mkseg(ws + WS_UF, ws + WS_WFOUR, TLAT / 256, 4, 2); S.Ag = (const char*)(ws + WS_U2); S.Bg = (const char*)(ws + WS_WIN + (size_t)ROW_GF * D * 2);
      EpiY E{(bf16*)(dout + DO_TF), (bf16*)(ws + WS_TM), p.b_in}; pg8::gemm_phase(F.lds, D, S, E);
    } else {
      { pg8::Sched S = mksched(D); S.s[0] = mkseg(ws + WS_HM, ws + WS_WMPROJ, TLAT / 256, 4, 1); S.s[1] = mkseg(ws + WS_UF, ws + WS_WFOUR, TLAT / 256, 4, 2); EpiY E{(bf16*)(dout + DO_TF), (bf16*)(ws + WS_TM), p.b_in}; pg8::gemm_phase(F.lds, D, S, E); }
      GSYNC();
      { pg8::Sched S = mksched(D); S.s[0] = mkseg(ws + WS_U2, ws + WS_WIN + (size_t)ROW_GF * D * 2, TLAT / 256, 8, 0); EpiY E{(bf16*)(dout + DO_TF), (bf16*)(ws + WS_TM), p.b_in}; pg8::gemm_phase(F.lds, D, S, E); }
    }
    GSYNC();
    { pg8::Sched S = mksched(D); S.s[0] = mkseg(ws + WS_TM, ws + WS_WOUT, TLAT / 256, 4, 0);
      float* xb = (float*)(ws + WS_XCH); unsigned* xc = (unsigned*)(ws + WS_XCNT);
      EpiMixT<false, 5, 7, 6> E{dout + DO_D1, p.norm_g + 3 * D, p.norm_g + 4 * D, (const float*)(ws + WS_MOD), (bf16*)(ws + WS_D12), (bf16*)(dout + DO_U3),
               PanelRms{xb, xc}, PanelRms{xb + 65536, xc + 64 * 64}, (LAS float*)(F.lds + pg8::STAGE_BYTES)};
      if (gridDim.x == 256) pg8::gemm_phase(F.lds, D, S, E); }
    GSYNC();
    { pg8::Sched S = mksched(D); S.s[0] = mkseg(dout + DO_U3, ws + WS_W13B, TLAT / 256, 22, 0); EpiSwiglu E{(bf16*)(ws + WS_ACT2)}; pg8::gemm_phase(F.lds, D, S, E); }
    { SUBF(128, 128); if (mine) { __syncthreads(); conv_plain(F2, p.w2_b, FF, D, (bf16*)(ws + WS_W2B), 0, I2); } }
    GSYNC();
    { pg8::Sched S = mksched(FF); S.s[0] = mkseg(ws + WS_ACT2, ws + WS_W2B, TLAT / 256, 4, 0);
      EpiFinal E{p.norm_g + 5 * D, (const float*)(ws + WS_MOD), (const bf16*)(ws + WS_D12), p.out, PanelRms{(float*)(ws + WS_XCH) + 2 * 65536, (unsigned*)(ws + WS_XCNT) + 2 * 64 * 64}, (LAS float*)(F.lds + pg8::STAGE_BYTES)};
      if (gridDim.x == 256) pg8::gemm_phase(F.lds, FF, S, E); }
}

extern "C" void kernel_launch(void* const* d_in, const int* in_sizes, int n_in, void* d_out, int out_size, void* d_ws, size_t ws_size, hipStream_t stream) {
    static int grid = 0;
    if (grid == 0) {
        if (n_in != 19 || out_size != TLAT * D || ws_size < WS_NEED) { fprintf(stderr, "kernel_launch: unexpected problem (n_in %d, out %d, ws %zu)\n", n_in, out_size, ws_size); grid = -1; return; }
        int dev = 0, cus = 0, per_cu = 0;
        if (hipGetDevice(&dev) != hipSuccess || hipDeviceGetAttribute(&cus, hipDeviceAttributeMultiprocessorCount, dev) != hipSuccess) { grid = -1; return; }
        if (hipFuncSetAttribute((const void*)mega_fwd, hipFuncAttributeMaxDynamicSharedMemorySize, LDS_BYTES) != hipSuccess) { fprintf(stderr, "kernel_launch: hipFuncSetAttribute failed\n"); grid = -1; return; }
        if (hipOccupancyMaxActiveBlocksPerMultiprocessor(&per_cu, (const void*)mega_fwd, NTHR, LDS_BYTES) != hipSuccess || per_cu < 1) { fprintf(stderr, "kernel_launch: occupancy query failed (%d)\n", per_cu); (void)hipGetLastError(); grid = -1; return; }
        grid = cus * 1;
        if (grid != 256) fprintf(stderr, "kernel_launch: built for a 256-CU device (fused norm epilogues need one 256x256 unit per workgroup); got %d\n", grid);
        fprintf(stderr, "kernel_launch: %d CUs, %d blocks/CU by the occupancy query, grid %d\n", cus, per_cu, grid);
    }
    if (grid < 0) return;
    Params p{};
    const float** f = (const float**)&p;
    for (int i = 0; i < 19; ++i) f[i] = (const float*)d_in[i];
    p.out = (float*)d_out; p.ws = (unsigned char*)d_ws;
    (void)hipMemsetAsync((char*)d_ws + WS_BAR, 0, 128 * 1024, stream);
    void* args[] = {&p};
    hipError_t e = hipLaunchCooperativeKernel((const void*)mega_fwd, dim3(grid), dim3(NTHR), args, LDS_BYTES, stream);
    if (e != hipSuccess) fprintf(stderr, "kernel_launch: cooperative launch failed: %s (grid %d)\n", hipGetErrorString(e), grid);
}
```
